# Optimizing an MI355X kernel written in HIP

```python
import jax, jax.numpy as jnp
from jax import lax
import numpy as np

D_MODEL = 1024
BATCH = 4
SEQ = 4096
DEPTH = 1
DEC_BATCH = 32
DEC_SEQ = 8
PAST_LEN = 16384
PAGE_SIZE = 128

N_HEADS = 8
N_KV = 2
HPG = N_HEADS // N_KV
HEAD_DIM = 64
ATTN_WIDTH = N_HEADS * HEAD_DIM
POOL_WIDTH = D_MODEL - ATTN_WIDTH
POOL_WINDOWS = (2, 4, 8, 16)
N_POOL_GROUPS = len(POOL_WINDOWS)
POOL_GROUP = POOL_WIDTH // N_POOL_GROUPS
POOL_HIST = max(POOL_WINDOWS) - 1
BLK = 64
N_SELECT = 16
WINDOW = 512
CMP_HIDDEN = 2 * HEAD_DIM
D_FF = 4 * D_MODEL
Q_BLOCK = 128
KV_WIDTH = N_KV * 2 * HEAD_DIM
PROJ_WIDTH = ATTN_WIDTH + 3 * KV_WIDTH + 3 * N_HEADS + POOL_WIDTH
SPLITS = (ATTN_WIDTH, ATTN_WIDTH + KV_WIDTH, ATTN_WIDTH + 2 * KV_WIDTH,
          ATTN_WIDTH + 3 * KV_WIDTH, ATTN_WIDTH + 3 * KV_WIDTH + 3 * N_HEADS)
BLOCKS_PER_PAGE = PAGE_SIZE // BLK
SCALE = HEAD_DIM ** -0.5
FORCE_SCORE = float(HPG + 1)
NORM_EPS = 1e-6
NEG = -1e30

kernel_name = "hymba_nsa_poolformer_decoder_step"


def rms_norm(x, g):
    xf = x.astype(jnp.float32)
    y = xf * lax.rsqrt(jnp.mean(xf * xf, axis=-1, keepdims=True) + NORM_EPS)
    return (y * g.astype(jnp.float32)).astype(x.dtype)


def alibi_slopes():
    h = jnp.arange(N_HEADS, dtype=jnp.float32) + 1.0
    return jnp.exp2(-8.0 * h / N_HEADS).reshape(N_KV, HPG)


def masked_softmax(s, mask):
    s = jnp.where(mask, s, NEG)
    m = jnp.max(s, axis=-1, keepdims=True)
    p = jnp.where(mask, jnp.exp(s - m), 0.0)
    return p / jnp.maximum(jnp.sum(p, axis=-1, keepdims=True), 1e-30)


def split_proj(hp):
    B, T, _ = hp.shape
    q, kc, ks, kw, gl, u = jnp.split(hp, list(SPLITS), axis=-1)
    kvs = lambda a: a.reshape(B, T, N_KV, 2, HEAD_DIM)
    gates = jax.nn.sigmoid(gl.astype(jnp.float32)).reshape(B, T, 3, N_KV, HPG)
    return q.reshape(B, T, N_KV, HPG, HEAD_DIM), kvs(kc), kvs(ks), kvs(kw), gates, u


def compress_blocks(kv, pe, w1, w2):
    B, L = kv.shape[:2]
    blocks = kv.reshape(B, L // BLK, BLK, N_KV, 2, HEAD_DIM) + pe[:, None]
    hid = jax.nn.gelu(jnp.einsum('bnlgcd,cldh->bngch', blocks, w1))
    return jnp.einsum('bngch,chd->bngcd', hid, w2)


def cmp_attend(q, pos_q, comp, slopes):
    nb = comp.shape[1]
    end = (jnp.arange(nb) + 1) * BLK - 1
    dist = (pos_q[:, None] - end[None, :]).astype(jnp.float32)
    s = jnp.einsum('btgpd,bngd->btgpn', q, comp[..., 0, :]).astype(jnp.float32) * SCALE
    s = s - slopes[None, None, :, :, None] * dist[None, :, None, None, :]
    p = masked_softmax(s, (dist >= 0)[None, :, None, None, :])
    o = jnp.einsum('btgpn,bngd->btgpd', p.astype(comp.dtype), comp[..., 1, :])
    return o, p


def select_blocks(imp, pos_q, nb):
    jj = jnp.arange(nb)[None, :]
    cur = (pos_q // BLK)[:, None]
    forced = (jj == 0) | (jj == cur) | (jj == cur - 1)
    score = jnp.where(forced[None, :, None, :], FORCE_SCORE, imp)
    score = jnp.where((jj > cur)[None, :, None, :], -1.0, score)
    _, idx = lax.top_k(score, min(N_SELECT, nb))
    return idx


def gather_local_blocks(blocks, idx):
    B = blocks.shape[0]
    return blocks[jnp.arange(B)[:, None, None, None], jnp.arange(N_KV)[None, None, :, None], idx]


def slc_attend(q, pos_q, kv_sel, idx, slopes):
    B, Tq, G, n = idx.shape
    S = n * BLK
    k = kv_sel[..., 0, :].reshape(B, Tq, G, S, HEAD_DIM)
    v = kv_sel[..., 1, :].reshape(B, Tq, G, S, HEAD_DIM)
    pos_k = (idx[..., None] * BLK + jnp.arange(BLK)).reshape(B, Tq, G, S)
    dist = (pos_q[None, :, None, None] - pos_k).astype(jnp.float32)
    s = jnp.einsum('btgpd,btgsd->btgps', q, k).astype(jnp.float32) * SCALE
    s = s - slopes[None, None, :, :, None] * dist[:, :, :, None, :]
    p = masked_softmax(s, (dist >= 0)[:, :, :, None, :])
    return jnp.einsum('btgps,btgsd->btgpd', p.astype(v.dtype), v)


def win_attend(q, pos_q, kv, pos_k, slopes):
    dist_i = pos_q[:, None] - pos_k[None, :]
    mask = (dist_i >= 0) & (dist_i < WINDOW) & (pos_k >= 0)[None, :]
    dist = dist_i.astype(jnp.float32)
    s = jnp.einsum('btgpd,bsgd->btgps', q, kv[..., 0, :]).astype(jnp.float32) * SCALE
    s = s - slopes[None, None, :, :, None] * dist[None, :, None, None, :]
    p = masked_softmax(s, mask[None, :, None, None, :])
    return jnp.einsum('btgps,bsgd->btgpd', p.astype(kv.dtype), kv[..., 1, :])


def nsa_heads(q, pos_q, comp, gather_sel, kv_win, pos_win, gates, slopes):
    o_c, p_c = cmp_attend(q, pos_q, comp, slopes)
    idx = select_blocks(jnp.sum(p_c, axis=3), pos_q, comp.shape[1])
    o_s = slc_attend(q, pos_q, gather_sel(idx), idx, slopes)
    o_w = win_attend(q, pos_q, kv_win, pos_win, slopes)
    o = (gates[:, :, 0, :, :, None] * o_c + gates[:, :, 1, :, :, None] * o_s
         + gates[:, :, 2, :, :, None] * o_w)
    return o.astype(q.dtype)


def pool_mix(u_ext, pos, w_pool, pool_scale):
    B, L, _ = u_ext.shape
    T = pos.shape[0]
    uf = u_ext.astype(jnp.float32)
    c = jnp.pad(jnp.cumsum(uf, axis=1), ((0, 0), (1, 0), (0, 0)))
    own = uf[:, L - T:]
    outs = []
    for gi, w in enumerate(POOL_WINDOWS):
        sl = slice(gi * POOL_GROUP, (gi + 1) * POOL_GROUP)
        hi = c[:, L - T + 1:, sl]
        lo = c[:, L - T + 1 - w: L + 1 - w, sl]
        cnt = jnp.minimum(w, pos + 1).astype(jnp.float32)[None, :, None]
        outs.append((hi - lo) / cnt - own[..., sl])
    d = jnp.stack(outs, axis=2).astype(u_ext.dtype)
    y = jnp.einsum('btgc,gcd->btgd', d, w_pool).reshape(B, T, POOL_WIDTH)
    return y * pool_scale


def merge_and_mlp(x, o, pool_out, w_out, g_mlp, w_up, w_down):
    B, T, _ = x.shape
    mix = jnp.concatenate([o.reshape(B, T, ATTN_WIDTH).astype(x.dtype),
                           pool_out.astype(x.dtype)], axis=-1)
    h = x + mix @ w_out
    a = jnp.square(jax.nn.relu(rms_norm(h, g_mlp) @ w_up))
    return h + a @ w_down


def prompt_layer(x, g_attn, w_in, cmp_pe, cmp_w1, cmp_w2, w_pool, pool_scale,
                 w_out, g_mlp, w_up, w_down, slopes):
    B, T, _ = x.shape
    q, kv_c, kv_s, kv_w, gates, u = split_proj(rms_norm(x, g_attn) @ w_in)
    comp = compress_blocks(kv_c, cmp_pe, cmp_w1, cmp_w2)
    blocks_s = kv_s.reshape(B, T // BLK, BLK, N_KV, 2, HEAD_DIM).transpose(0, 3, 1, 2, 4, 5)
    kv_w_pad = jnp.pad(kv_w, ((0, 0), (WINDOW, 0), (0, 0), (0, 0), (0, 0)))
    nqb = T // Q_BLOCK
    to_blocks = lambda a: a.reshape((B, nqb, Q_BLOCK) + a.shape[2:]).swapaxes(0, 1)

    def per_block(args):
        i, qb, gb = args
        start = i * Q_BLOCK
        pos_b = start + jnp.arange(Q_BLOCK)
        kvw = lax.dynamic_slice_in_dim(kv_w_pad, start, Q_BLOCK + WINDOW, axis=1)
        pos_w = start - WINDOW + jnp.arange(Q_BLOCK + WINDOW)
        return nsa_heads(qb, pos_b, comp, lambda idx: gather_local_blocks(blocks_s, idx),
                         kvw, pos_w, gb, slopes)

    o = lax.map(per_block, (jnp.arange(nqb), to_blocks(q), to_blocks(gates)))
    o = o.swapaxes(0, 1).reshape(B, T, N_KV, HPG, HEAD_DIM)
    pos = jnp.arange(T)
    p = pool_mix(jnp.pad(u, ((0, 0), (POOL_HIST, 0), (0, 0))), pos, w_pool, pool_scale)
    h = merge_and_mlp(x, o, p, w_out, g_mlp, w_up, w_down)
    wk = min(WINDOW, T)
    return h, (kv_c, kv_s, kv_w[:, T - wk:], u[:, T - POOL_HIST:])


def sample_layer(x, cache_cmp, cache_slc, state_win, state_pool, page_table,
                 g_attn, w_in, cmp_pe, cmp_w1, cmp_w2, w_pool, pool_scale,
                 w_out, g_mlp, w_up, w_down, slopes):
    B, T, _ = x.shape
    past = page_table.shape[1] * PAGE_SIZE
    nb_past = past // BLK
    nb_new = -(-T // BLK)
    pos = past + jnp.arange(T)
    q, kv_c, kv_s, kv_w, gates, u = split_proj(rms_norm(x, g_attn) @ w_in)
    pad_new = ((0, 0), (0, nb_new * BLK - T), (0, 0), (0, 0), (0, 0))
    past_c = cache_cmp[page_table].reshape(B, past, N_KV, 2, HEAD_DIM)
    comp = jnp.concatenate([compress_blocks(past_c, cmp_pe, cmp_w1, cmp_w2),
                            compress_blocks(jnp.pad(kv_c, pad_new), cmp_pe, cmp_w1, cmp_w2)], axis=1)
    new_blocks = jnp.pad(kv_s, pad_new).reshape(B, nb_new, BLK, N_KV, 2, HEAD_DIM).transpose(0, 3, 1, 2, 4, 5)

    def gather_sel(idx):
        in_past = idx < nb_past
        jp = jnp.minimum(idx, nb_past - 1)
        phys = page_table[jnp.arange(B)[:, None, None, None], jp // BLOCKS_PER_PAGE]
        offs = ((jp % BLOCKS_PER_PAGE) * BLK)[..., None] + jnp.arange(BLK)
        rows_past = cache_slc[phys[..., None], offs, jnp.arange(N_KV)[None, None, :, None, None]]
        rows_new = gather_local_blocks(new_blocks, jnp.clip(idx - nb_past, 0, nb_new - 1))
        return jnp.where(in_past[..., None, None, None], rows_past, rows_new)

    wk = state_win.shape[1]
    kv_wext = jnp.concatenate([state_win, kv_w], axis=1)
    pos_w = past - wk + jnp.arange(wk + T)
    o = nsa_heads(q, pos, comp, gather_sel, kv_wext, pos_w, gates, slopes)
    u_ext = jnp.concatenate([state_pool, u], axis=1)
    p = pool_mix(u_ext, pos, w_pool, pool_scale)
    h = merge_and_mlp(x, o, p, w_out, g_mlp, w_up, w_down)
    return h, (kv_c, kv_s, kv_wext[:, T:], u_ext[:, T:])


def setup_inputs(seed: int = 0) -> dict:
    key = jax.random.key(seed)
    ks = jax.random.split(key, 20)
    n_pages = PAST_LEN // PAGE_SIZE
    n_used = DEC_BATCH * n_pages
    n_pool = n_used + n_used // 4
    wk = min(WINDOW, PAST_LEN)
    nrm = lambda k, shape, scale=1.0: scale * jax.random.normal(k, shape, jnp.float32)
    page_table = jax.random.permutation(ks[0], n_pool)[:n_used].reshape(DEC_BATCH, n_pages).astype(jnp.int32)
    return {
        "x_prompt": nrm(ks[1], (BATCH, SEQ, D_MODEL)),
        "x_sample": nrm(ks[2], (DEC_BATCH, DEC_SEQ, D_MODEL)),
        "cache_cmp": nrm(ks[3], (DEPTH, n_pool, PAGE_SIZE, N_KV, 2, HEAD_DIM)),
        "cache_slc": nrm(ks[4], (DEPTH, n_pool, PAGE_SIZE, N_KV, 2, HEAD_DIM)),
        "state_win": nrm(ks[5], (DEPTH, DEC_BATCH, wk, N_KV, 2, HEAD_DIM)),
        "state_pool": nrm(ks[6], (DEPTH, DEC_BATCH, POOL_HIST, POOL_WIDTH)),
        "page_table": page_table,
        "g_attn": 1.0 + nrm(ks[7], (DEPTH, D_MODEL), 0.05),
        "w_in": nrm(ks[8], (DEPTH, D_MODEL, PROJ_WIDTH), D_MODEL ** -0.5),
        "cmp_pe": nrm(ks[9], (DEPTH, BLK, 2, HEAD_DIM), 0.1),
        "cmp_w1": nrm(ks[10], (DEPTH, 2, BLK, HEAD_DIM, CMP_HIDDEN), (BLK * HEAD_DIM) ** -0.5),
        "cmp_w2": nrm(ks[11], (DEPTH, 2, CMP_HIDDEN, HEAD_DIM), (2.0 / CMP_HIDDEN) ** 0.5),
        "w_pool": nrm(ks[12], (DEPTH, N_POOL_GROUPS, POOL_GROUP, POOL_GROUP), POOL_GROUP ** -0.5),
        "pool_scale": 1.0 + nrm(ks[13], (DEPTH, POOL_WIDTH), 0.1),
        "w_out": nrm(ks[14], (DEPTH, D_MODEL, D_MODEL), D_MODEL ** -0.5),
        "g_mlp": 1.0 + nrm(ks[15], (DEPTH, D_MODEL), 0.05),
        "w_up": nrm(ks[16], (DEPTH, D_MODEL, D_FF), D_MODEL ** -0.5),
        "w_down": nrm(ks[17], (DEPTH, D_FF, D_MODEL), D_FF ** -0.5),
        "g_final": 1.0 + nrm(ks[18], (D_MODEL,), 0.05),
    }


def reference(x_prompt, x_sample, cache_cmp, cache_slc, state_win, state_pool, page_table,
              g_attn, w_in, cmp_pe, cmp_w1, cmp_w2, w_pool, pool_scale, w_out,
              g_mlp, w_up, w_down, g_final):
    slopes = alibi_slopes()
    hp, hs = x_prompt, x_sample
    st_p, st_s = [], []
    for l in range(DEPTH):
        lw = (g_attn[l], w_in[l], cmp_pe[l], cmp_w1[l], cmp_w2[l], w_pool[l], pool_scale[l],
              w_out[l], g_mlp[l], w_up[l], w_down[l])
        hp, sp = prompt_layer(hp, *lw, slopes)
        hs, ss = sample_layer(hs, cache_cmp[l], cache_slc[l], state_win[l], state_pool[l],
                              page_table, *lw, slopes)
        st_p.append(sp)
        st_s.append(ss)
    y_prompt = rms_norm(hp, g_final)
    y_sample = rms_norm(hs, g_final)
    stk = lambda states, i: jnp.stack([s[i] for s in states], axis=0)
    return (y_prompt, y_sample,
            stk(st_p, 0), stk(st_p, 1), stk(st_p, 2), stk(st_p, 3),
            stk(st_s, 0), stk(st_s, 1), stk(st_s, 2), stk(st_s, 3))
```

```cpp
#include <hip/hip_runtime.h>
#include <cstdio>
#include <cstdint>
namespace pg8 {
#define PG8_LAS __attribute__((address_space(3)))
typedef unsigned short bf16_t;
typedef short bf16x8 __attribute__((ext_vector_type(8)));
typedef float f32x4 __attribute__((ext_vector_type(4)));
typedef unsigned u32x4 __attribute__((ext_vector_type(4)));
constexpr int BM = 256, BK = 64, HALF = 128, HTB = HALF * BK * 2  , STAGE_BYTES = 8 * HTB, NXCD = 8, WGM = 8;

__host__ __device__ __forceinline__ int lds_byte(int r, int c) { const int st = (r >> 4) * 2 + (c >> 5), rr = r & 15, cc = c & 31, ob = rr * 64 + cc * 2; return st * 1024 + (ob ^ (((ob >> 9) & 1) << 5)); }
__host__ __device__ __forceinline__ void stage_rc(int b, int& R, int& C) { const int st = b / 1024, sb = b % 1024, swz = sb ^ (((sb >> 9) & 1) << 5); R = (st >> 1) * 16 + swz / 64; C = (st & 1) * 32 + (swz % 64) / 2; }
__host__ __device__ __forceinline__ int perm32(int rho) { const int n = rho >> 4, i = rho & 15; return 8 * (i >> 2) + 4 * n + (i & 3); }

struct Unit { int pm, pn; };
struct Gemm { const bf16_t* A; const bf16_t* Bt; int M, N, K; };

struct StaticOrder {
    int nM, nN, nwg, G, c;
    __host__ __device__ void init(int M, int N, int G_, int c_) { nM = M / BM; nN = N / BM; nwg = nM * nN; G = G_; c = c_; }
    __host__ __device__ bool next(int i, Unit& u) const {
        const long L = (long)i * G + c; if (L >= nwg) return false;
        int wgid = (int)L; { const int q = nwg / NXCD, r = nwg % NXCD, xcd = wgid % NXCD, off = wgid / NXCD; wgid = (xcd < r ? xcd * (q + 1) : r * (q + 1) + (xcd - r) * q) + off; }
        const int nig = WGM * nN, gid = wgid / nig, fm = gid * WGM, gsz = (nM - fm) < WGM ? (nM - fm) : WGM;
        u.pm = fm + ((wgid % nig) % gsz); u.pn = (wgid % nig) / gsz; return true;
    }
    __device__ __forceinline__ void a_ready(const Unit&) const {}
    __device__ __forceinline__ void done(const Unit&) const {}
};
struct CountedOrder : StaticOrder {
    const unsigned* ready; unsigned need; unsigned* tmo;
    __device__ __forceinline__ void a_ready(const Unit& u) const {
        if (threadIdx.x < 64) {
            const unsigned long long t0 = __builtin_amdgcn_s_memrealtime(); unsigned polls = 0;
            while ((unsigned)__builtin_amdgcn_readfirstlane(__hip_atomic_load(ready + 64 * u.pm, __ATOMIC_RELAXED, __HIP_MEMORY_SCOPE_AGENT)) < need) {
                if ((++polls & 255u) == 0u && __builtin_amdgcn_readfirstlane(__hip_atomic_load(tmo, __ATOMIC_RELAXED, __HIP_MEMORY_SCOPE_AGENT)) != 0u) break;
                if (__builtin_amdgcn_s_memrealtime() - t0 > 2000000ull) {
                    if (threadIdx.x == 0) { unsigned expect = 0u; __hip_atomic_compare_exchange_strong(tmo + 1, &expect, 0x600u | (unsigned)(u.pm & 0xff), __ATOMIC_RELAXED, __ATOMIC_RELAXED, __HIP_MEMORY_SCOPE_AGENT); __hip_atomic_store(tmo, 1u, __ATOMIC_RELAXED, __HIP_MEMORY_SCOPE_AGENT); }
                    break; }
                __builtin_amdgcn_s_sleep(2); }
            __builtin_amdgcn_fence(__ATOMIC_ACQUIRE, "agent");
            asm volatile("s_waitcnt vmcnt(0)" ::: "memory");
        }
#if !defined(BROKEN_HOOK_NO_BARRIER)
        asm volatile("" ::: "memory"); __builtin_amdgcn_s_barrier(); asm volatile("" ::: "memory");
#endif
    }
};

__device__ __forceinline__ unsigned cvt_pk_bf16(float lo, float hi) { unsigned r; asm volatile("v_cvt_pk_bf16_f32 %0, %1, %2" : "=v"(r) : "v"(lo), "v"(hi)); return r; }
struct EpiF32 {
    static constexpr bool PERM = false, AFTER_DRAIN = false;
    float* C; int ldc;
    __device__ __forceinline__ void operator()(const f32x4 (&acc)[2][2][4][2], const Unit& u, int wr, int wc, int fr, int fq) const {
        const int row0 = u.pm * BM + wr * 64 + fr, col0 = u.pn * BM + wc * 32 + 4 * fq;
#pragma unroll
        for (int ai = 0; ai < 2; ++ai)
#pragma unroll
            for (int m = 0; m < 4; ++m) { float* rowp = C + (size_t)(row0 + ai * HALF + m * 16) * ldc + col0;
#pragma unroll
                for (int bj = 0; bj < 2; ++bj)
#pragma unroll
                    for (int n = 0; n < 2; ++n) *(f32x4*)(rowp + bj * HALF + n * 16) = acc[ai][bj][m][n]; }
    }
};
struct EpiResF32 {
    static constexpr bool PERM = false, AFTER_DRAIN = false;
    const float* base0; const float* base1; int split; float* out; int ldc;
    __device__ __forceinline__ void operator()(const f32x4 (&acc)[2][2][4][2], const Unit& u, int wr, int wc, int fr, int fq) const {
        const int row0 = u.pm * BM + wr * 64 + fr, col0 = u.pn * BM + wc * 32 + 4 * fq;
        const float* bb = (u.pm < split) ? base0 : (base1 - (size_t)split * BM * ldc);
#pragma unroll
        for (int ai = 0; ai < 2; ++ai)
#pragma unroll
            for (int m = 0; m < 4; ++m) { const size_t off = (size_t)(row0 + ai * HALF + m * 16) * ldc + col0;
#pragma unroll
                for (int bj = 0; bj < 2; ++bj)
#pragma unroll
                    for (int n = 0; n < 2; ++n) { const f32x4 b = *(const f32x4*)(bb + off + bj * HALF + n * 16); *(f32x4*)(out + off + bj * HALF + n * 16) = acc[ai][bj][m][n] + b; } }
    }
};
struct EpiRelu2Bf16 {
    static constexpr bool PERM = true, AFTER_DRAIN = false;
    bf16_t* O; int ldc;
    __device__ __forceinline__ void operator()(const f32x4 (&acc)[2][2][4][2], const Unit& u, int wr, int wc, int fr, int fq) const {
        const int row0 = u.pm * BM + wr * 64 + fr, col0 = u.pn * BM + wc * 32 + 8 * fq;
#pragma unroll
        for (int ai = 0; ai < 2; ++ai)
#pragma unroll
            for (int m = 0; m < 4; ++m) { bf16_t* rowp = O + (size_t)(row0 + ai * HALF + m * 16) * ldc + col0;
#pragma unroll
                for (int bj = 0; bj < 2; ++bj) { f32x4 v0 = acc[ai][bj][m][0], v1 = acc[ai][bj][m][1];
#pragma unroll
                    for (int j = 0; j < 4; ++j) { const float a = fmaxf(v0[j], 0.f), b = fmaxf(v1[j], 0.f); v0[j] = a * a; v1[j] = b * b; }
                    u32x4 w; w.x = cvt_pk_bf16(v0[0], v0[1]); w.y = cvt_pk_bf16(v0[2], v0[3]); w.z = cvt_pk_bf16(v1[0], v1[1]); w.w = cvt_pk_bf16(v1[2], v1[3]);
                    *(u32x4*)(rowp + bj * HALF) = w; } }
    }
};
__device__ __forceinline__ float gelu_tanh(float x) {
    const float y = 0.7978845608028654f * (x + 0.044715f * x * x * x);
    const float t = 1.0f - 2.0f / (__expf(2.0f * y) + 1.0f);
    return 0.5f * x * (1.0f + t);
}
struct EpiCmpHid {
    static constexpr bool PERM = false, AFTER_DRAIN = false;
    float* H; int csplit;
    __device__ __forceinline__ void operator()(const f32x4 (&acc)[2][2][4][2], const Unit& u, int wr, int wc, int fr, int fq) const {
        const int row0 = u.pm * BM + wr * 64 + fr, col0 = wc * 32 + 4 * fq;
        const bool c1 = u.pm >= csplit;
#pragma unroll
        for (int ai = 0; ai < 2; ++ai)
#pragma unroll
            for (int m = 0; m < 4; ++m) { float* rowp = H + (size_t)(row0 + ai * HALF + m * 16) * 128 + col0;
#pragma unroll
                for (int n = 0; n < 2; ++n) { f32x4 v = c1 ? acc[ai][1][m][n] : acc[ai][0][m][n];
#pragma unroll
                    for (int j = 0; j < 4; ++j) v[j] = gelu_tanh(v[j]);
                    *(f32x4*)(rowp + n * 16) = v; } }
    }
};
template <class Epi, class Sched, bool STAMP = false>
__device__ __forceinline__ void gemm_phase(PG8_LAS unsigned char* lds, const Gemm g, const Sched& S, const Epi& E, unsigned long long* stamps) {
    const int tid = threadIdx.x, wid = __builtin_amdgcn_readfirstlane(tid >> 6), lane = tid & 63, wr = wid >> 2, wc = wid & 3, fr = lane & 15, fq = lane >> 4;
    const int K = g.K, nt = K / BK;
    int ts_lo = 0, ts_hi = 0, nts = 0; const unsigned long long rt_entry = STAMP ? (unsigned long long)wall_clock64() : 0ull;
#define PG8_STAMP() do { if (STAMP && wid == 0 && nts < 64) { const unsigned long long _c = (unsigned long long)clock64(); \
        ts_lo = (lane == nts) ? (int)(unsigned)_c : ts_lo; ts_hi = (lane == nts) ? (int)(unsigned)(_c >> 32) : ts_hi; ++nts; } } while (0)
    PG8_STAMP();
    unsigned voffA[2], voffB[2];
#pragma unroll
    for (int i = 0; i < 2; ++i) { int R, C; stage_rc(tid * 16 + i * 8192, R, C); const int Rb = Epi::PERM ? ((R & ~31) + perm32(R & 31)) : R;
        voffA[i] = (unsigned)(R * K + C) * 2u; voffB[i] = (unsigned)(Rb * K + C) * 2u; }
    const size_t kstep = (size_t)(BK * 2);
    const size_t hstep = (size_t)HALF * K * 2;
    const size_t tstep = 2 * hstep;
    const unsigned ldsw = (unsigned)wid * 1024u;
    const int aoff = lds_byte(wr * 64 + fr, fq * 8), boff = lds_byte(wc * 32 + fr, fq * 8);
#define PG8_SA(b, h) (((b) * 2 + (h)) * HTB)
#define PG8_SB(b, h) ((4 + (b) * 2 + (h)) * HTB)
#define PG8_STAGE(bufoff, gbase, voff) do { _Pragma("unroll") for (int _i = 0; _i < 2; ++_i) \
        __builtin_amdgcn_global_load_lds((const unsigned*)((const char*)(gbase) + (voff)[_i]), (PG8_LAS unsigned*)(lds + (bufoff) + ldsw + _i * 8192), 16, 0, 0); } while (0)
#define PG8_LDA(dst, b, h) do { _Pragma("unroll") for (int m = 0; m < 4; ++m) _Pragma("unroll") for (int k = 0; k < 2; ++k) dst[m][k] = *(const PG8_LAS bf16x8*)(lds + PG8_SA(b, h) + aoff + m * 2048 + k * 1024); } while (0)
#define PG8_LDB(dst, b, h) do { _Pragma("unroll") for (int n = 0; n < 2; ++n) _Pragma("unroll") for (int k = 0; k < 2; ++k) dst[n][k] = *(const PG8_LAS bf16x8*)(lds + PG8_SB(b, h) + boff + n * 2048 + k * 1024); } while (0)
#define PG8_MMA(ai, bj, At, Bt) do { __builtin_amdgcn_s_setprio(1); _Pragma("unroll") for (int m = 0; m < 4; ++m) _Pragma("unroll") for (int n = 0; n < 2; ++n) _Pragma("unroll") for (int k = 0; k < 2; ++k) \
        acc[ai][bj][m][n] = __builtin_amdgcn_mfma_f32_16x16x32_bf16(Bt[n][k], At[m][k], acc[ai][bj][m][n], 0, 0, 0); __builtin_amdgcn_s_setprio(0); } while (0)
#define PG8_WAIT_V(n) asm volatile("s_waitcnt vmcnt(" #n ")" ::: "memory")
#define PG8_WAIT_L(n) asm volatile("s_waitcnt lgkmcnt(" #n ")" ::: "memory")
#define PG8_BAR __builtin_amdgcn_s_barrier()
#define PG8_SCHED __builtin_amdgcn_sched_barrier(0)
    Unit cur, nxt; int ui = 0;
    if (!S.next(0, cur)) return;
    f32x4 acc[2][2][4][2];
#pragma unroll
    for (int a = 0; a < 2; ++a)
#pragma unroll
        for (int b = 0; b < 2; ++b)
#pragma unroll
            for (int m = 0; m < 4; ++m)
#pragma unroll
                for (int n = 0; n < 2; ++n) acc[a][b][m][n] = (f32x4){0.f, 0.f, 0.f, 0.f};
    bf16x8 At[4][2], B0[2][2], B1[2][2];
    const char* cA = (const char*)g.A + (size_t)cur.pm * tstep; const char* cB = (const char*)g.Bt + (size_t)cur.pn * tstep;
    S.a_ready(cur);
    PG8_STAGE(PG8_SB(0, 0), cB, voffB); PG8_STAGE(PG8_SA(0, 0), cA, voffA); PG8_STAGE(PG8_SB(0, 1), cB + hstep, voffB); PG8_STAGE(PG8_SA(0, 1), cA + hstep, voffA);
    if (wr == 1) PG8_BAR;
    PG8_WAIT_V(4); PG8_BAR;
    PG8_STAGE(PG8_SB(1, 0), cB + kstep, voffB); PG8_STAGE(PG8_SA(1, 0), cA + kstep, voffA); PG8_STAGE(PG8_SB(1, 1), cB + hstep + kstep, voffB);
    PG8_WAIT_V(6); PG8_BAR;
    PG8_STAMP();
    for (;;) {
        const bool has_next = S.next(ui + 1, nxt);
        const char* nA = has_next ? (const char*)g.A + (size_t)nxt.pm * tstep : cA; const char* nB = has_next ? (const char*)g.Bt + (size_t)nxt.pn * tstep : cB;
        for (int t = 0; t < nt; t += 2) {
            const bool last = (t == nt - 2);
            const char* a1 = cA + (size_t)(t + 1) * kstep;
            const char* a2 = last ? nA : cA + (size_t)(t + 2) * kstep; const char* b2 = last ? nB : cB + (size_t)(t + 2) * kstep;
            const char* a3 = a2 + kstep; const char* b3 = b2 + kstep;
            if (last && has_next) S.a_ready(nxt);
            PG8_LDB(B0, 0, 0); PG8_SCHED; PG8_LDA(At, 0, 0); PG8_STAGE(PG8_SA(1, 1), a1 + hstep, voffA);
            PG8_WAIT_L(8); PG8_BAR; PG8_WAIT_L(0); PG8_MMA(0, 0, At, B0); PG8_BAR; PG8_SCHED;
            PG8_LDB(B1, 0, 1); PG8_STAGE(PG8_SB(0, 0), b2, voffB);
            PG8_BAR; PG8_WAIT_L(0); PG8_MMA(0, 1, At, B1); PG8_BAR;
            PG8_LDA(At, 0, 1); PG8_STAGE(PG8_SA(0, 0), a2, voffA);
            PG8_BAR; PG8_WAIT_L(0); PG8_MMA(1, 0, At, B0); PG8_BAR; PG8_SCHED;
            PG8_STAGE(PG8_SB(0, 1), b2 + hstep, voffB);
            PG8_WAIT_V(6); PG8_BAR; PG8_MMA(1, 1, At, B1); PG8_BAR;
            PG8_LDB(B0, 1, 0); PG8_SCHED; PG8_LDA(At, 1, 0); PG8_STAGE(PG8_SA(0, 1), a2 + hstep, voffA);
            PG8_WAIT_L(8); PG8_BAR; PG8_WAIT_L(0); PG8_MMA(0, 0, At, B0); PG8_BAR; PG8_SCHED;
            PG8_LDB(B1, 1, 1); PG8_STAGE(PG8_SB(1, 0), b3, voffB);
            PG8_BAR; PG8_WAIT_L(0); PG8_MMA(0, 1, At, B1); PG8_BAR;
            PG8_LDA(At, 1, 1); PG8_STAGE(PG8_SA(1, 0), a3, voffA);
            PG8_BAR; PG8_WAIT_L(0); PG8_MMA(1, 0, At, B0); PG8_BAR; PG8_SCHED;
            PG8_STAGE(PG8_SB(1, 1), b3 + hstep, voffB);
            PG8_WAIT_V(6); PG8_BAR; PG8_MMA(1, 1, At, B1); PG8_BAR;
        }
        PG8_STAMP();
        if constexpr (!Epi::AFTER_DRAIN) { E(acc, cur, wr, wc, fr, fq); S.done(cur); }
        PG8_STAMP();
        if (!has_next) break;
#pragma unroll
        for (int a = 0; a < 2; ++a)
#pragma unroll
            for (int b = 0; b < 2; ++b)
#pragma unroll
                for (int m = 0; m < 4; ++m)
#pragma unroll
                    for (int n = 0; n < 2; ++n) acc[a][b][m][n] = (f32x4){0.f, 0.f, 0.f, 0.f};
        cur = nxt; cA = nA; cB = nB; ++ui;
    }
    PG8_WAIT_V(0);
    if (wr == 0) PG8_BAR;
    PG8_BAR;
    if constexpr (Epi::AFTER_DRAIN) { E.fused(acc, cur, wr, wc, fr, fq, lds, wid, lane); S.done(cur); }
    PG8_STAMP();
    if (STAMP && wid == 0) { stamps[lane] = lane < nts ? (((unsigned long long)(unsigned)ts_hi << 32) | (unsigned)ts_lo) : 0ull;
        if (lane == 62) stamps[62] = rt_entry; if (lane == 63) stamps[63] = (unsigned long long)wall_clock64(); }
#undef PG8_STAMP
#undef PG8_SA
#undef PG8_SB
#undef PG8_STAGE
#undef PG8_LDA
#undef PG8_LDB
#undef PG8_MMA
#undef PG8_WAIT_V
#undef PG8_WAIT_L
#undef PG8_BAR
#undef PG8_SCHED
}
}

constexpr int DM = 1024, NPR = 16384, NSM = 256, MTOK = NPR + NSM, SEQ = 4096, NBP = 64, PAST = 16384, NBS = 257, NPG = 128, DFF = 4096;
constexpr int PW = 2048;
constexpr int C_Q = 0, C_KC = 512, C_KS = 768, C_KW = 1024, C_U = 1280, C_G = 1792;
constexpr int CMP_SEC = 17152, CMP_ROWS = 2 * CMP_SEC;
constexpr int CMP_R_PROMPT = 16384, CMP_R_NEW = 16896, CMP_R_END = 16960;
constexpr size_t O_YP = 0, O_YS = 16777216, O_PCMP = 17039360, O_PSLC = 21233664, O_PWIN = 25427968, O_PPOOL = 25952256,
                 O_SCMP = 25982976, O_SSLC = 26048512, O_SWIN = 26114048, O_SPOOL = 30308352, O_END = 30554112;
constexpr size_t MiB = 1u << 20;
constexpr size_t WS_CTL = 0, CTL_ZERO_BYTES = 1 * MiB;
constexpr size_t WS_WIN = 2 * MiB, WS_WOUT = 6 * MiB, WS_WUP = 8 * MiB, WS_WDN = 16 * MiB, WS_W1S = 24 * MiB;
constexpr size_t WS_XN = 32 * MiB, WS_PROJ = 66 * MiB, WS_ACMP = 200 * MiB, WS_HID = 470 * MiB, WS_COMPS = 490 * MiB, WS_COMPP = 500 * MiB;
constexpr size_t WS_MIX = 502 * MiB, WS_H = 536 * MiB, WS_HB = 602 * MiB, WS_ACT = 636 * MiB, WS_END = 768 * MiB;
static_assert(WS_XN + (size_t)MTOK * DM * 2 <= WS_PROJ && WS_PROJ + (size_t)MTOK * PW * 4 <= WS_ACMP && WS_ACMP + (size_t)CMP_ROWS * 4096 * 2 <= WS_HID, "ws map 1");
static_assert(WS_HID + (size_t)CMP_ROWS * 128 * 4 <= WS_COMPS && WS_COMPS + (size_t)32 * NBS * 256 * 4 <= WS_COMPP && WS_COMPP + (size_t)4 * NBP * 256 * 4 <= WS_MIX, "ws map 2");
static_assert(WS_MIX + (size_t)MTOK * DM * 2 <= WS_H && WS_H + (size_t)MTOK * DM * 4 <= WS_HB && WS_HB + (size_t)MTOK * DM * 2 <= WS_ACT && WS_ACT + (size_t)MTOK * DFF * 2 <= WS_END, "ws map 3");
constexpr int CW_BAR = 4096;

constexpr int NWAVES = 8, NTHR = NWAVES * 64;
constexpr int RING_BYTES = 131072, LDSCTL_OFF = RING_BYTES, MISC_OFF = LDSCTL_OFF + 320, LDS_BYTES = 147456;
constexpr int NPHASES = 11;

#define GAS __attribute__((address_space(1)))
#define LAS __attribute__((address_space(3)))
typedef unsigned short bf16;
typedef unsigned v4u __attribute__((ext_vector_type(4)));
typedef unsigned v2u __attribute__((ext_vector_type(2)));
typedef float f32x4 __attribute__((ext_vector_type(4)));
#define LDS_WAIT() asm volatile("s_waitcnt lgkmcnt(0)" ::: "memory")
__device__ __forceinline__ unsigned f2bf(float f) { unsigned u = __builtin_bit_cast(unsigned, f); return (u + 0x7fffu + ((u >> 16) & 1u)) >> 16; }
__device__ __forceinline__ unsigned pk2(float lo, float hi) { return f2bf(lo) | (f2bf(hi) << 16); }
__device__ __forceinline__ float wave_sum(float v) {
#pragma unroll
    for (int o = 1; o < 64; o <<= 1) v += __shfl_xor(v, o);
    return v;
}
__device__ __forceinline__ float wave_max(float v) {
#pragma unroll
    for (int o = 1; o < 64; o <<= 1) v = fmaxf(v, __shfl_xor(v, o));
    return v;
}

#define XB_TMO      128
#define XB_XCNT(j)  (256  + 64 * (j))
#define XB_XSUB(j)  (1280 + 64 * (j))
#define XB_XGEN(j)  (2304 + 64 * (j))
#define XB_TOP      3328
#define XB_TOPGEN   3392
#define XCD_BAR_WORDS 3456
#define XB_SPIN_CAP (1u << 18)
__device__ __forceinline__ unsigned xb_ld(unsigned* p)              { return __hip_atomic_load(p, __ATOMIC_RELAXED, __HIP_MEMORY_SCOPE_AGENT); }
__device__ __forceinline__ unsigned xb_add(unsigned* p, unsigned v) { return __hip_atomic_fetch_add(p, v, __ATOMIC_RELAXED, __HIP_MEMORY_SCOPE_AGENT); }
__device__ __forceinline__ unsigned xb_xcc_id() { return (unsigned)__builtin_amdgcn_s_getreg((3 << 11) | 20) & 0xFu; }
#define XB_SPIN(cond, bar) do { unsigned _sp = 0; while (cond) { __builtin_amdgcn_s_sleep(1); \
    if ((++_sp & 255u) == 0u) { if (xb_ld(&(bar)[XB_TMO])) break; if (_sp > XB_SPIN_CAP) { atomicAdd(&(bar)[XB_TMO], 1u); break; } } } } while (0)
struct XcdBarrier { unsigned* bar; unsigned x; volatile LAS unsigned* st; };
__device__ __forceinline__ XcdBarrier xcd_barrier_post(unsigned* bar, volatile LAS unsigned* st) {
    XcdBarrier b; b.bar = bar; b.x = xb_xcc_id(); b.st = st;
    if (threadIdx.x == 0) (void)xb_add(&bar[XB_XCNT(b.x)], 1u);
    return b;
}
__device__ __forceinline__ void xcd_barrier_complete(unsigned* bar, unsigned x, unsigned& nloc, unsigned& nx) {
    const unsigned G = gridDim.x * gridDim.y * gridDim.z;
    unsigned sum, cnt, mine, sp = 0u;
    for (;;) {
        sum = 0u; cnt = 0u; mine = 0u;
#pragma unroll
        for (unsigned j = 0; j < 16; ++j) { const unsigned c = xb_ld(&bar[XB_XCNT(j)]); sum += c; cnt += (c > 0u) ? 1u : 0u; mine = (j == x) ? c : mine; }
        if (sum == G) break;
        __builtin_amdgcn_s_sleep(1);
        if ((++sp & 255u) == 0u) { if (xb_ld(&bar[XB_TMO])) break; if (sp > XB_SPIN_CAP) { atomicAdd(&bar[XB_TMO], 1u); break; } }
    }
    nloc = mine > 0u ? mine : 1u; nx = cnt > 0u ? cnt : 1u;
}
__device__ __forceinline__ void xcd_barrier(const XcdBarrier& b) {
    asm volatile("s_waitcnt vmcnt(0)" ::: "memory");
    __syncthreads();
    if (threadIdx.x == 0) {
        unsigned* bar = b.bar;
        __builtin_amdgcn_s_waitcnt(0);
        unsigned nloc = b.st[0], nx = b.st[1];
        if (nloc == 0u) { xcd_barrier_complete(bar, b.x, nloc, nx); b.st[0] = nloc; b.st[1] = nx; }
        const unsigned old = xb_add(&bar[XB_XSUB(b.x)], 1u);
        const unsigned gen = old / nloc;
        if (old + 1u == (gen + 1u) * nloc) {
            __builtin_amdgcn_fence(__ATOMIC_RELEASE, "agent");
            asm volatile("s_waitcnt vmcnt(0)" ::: "memory");
            const unsigned og = xb_add(&bar[XB_TOP], 1u);
            const unsigned tg = og / nx;
            if (og + 1u == (tg + 1u) * nx) xb_add(&bar[XB_TOPGEN], 1u);
            else XB_SPIN(xb_ld(&bar[XB_TOPGEN]) == tg, bar);
            __builtin_amdgcn_fence(__ATOMIC_ACQUIRE, "agent");
            xb_add(&bar[XB_XGEN(b.x)], 1u);
            asm volatile("s_waitcnt vmcnt(0)" ::: "memory");
        } else {
            XB_SPIN(xb_ld(&bar[XB_XGEN(b.x)]) == gen, bar);
            __builtin_amdgcn_fence(__ATOMIC_ACQUIRE, "agent");
            asm volatile("s_waitcnt vmcnt(0)" ::: "memory");
        }
    }
    __syncthreads();
}

struct Args { const float* in[19]; float* out; unsigned char* ws; int ph_lo, ph_hi; };
struct Frame {
    LAS unsigned char* lds;
    int tid, lane, wave, G, bid;
};

template <int MAP>
__device__ __forceinline__ void p0_transpose_item(const float* W, int K, int ldw, int nblk, bf16* WT, int row_off, LAS float* scr, int item, int lane) {
    const int kb = item / nblk, nb = item % nblk, k0 = 64 * kb, n0 = 32 * nb;
    const int nd = n0 + (lane & 31);
    int sc = nd;
    if (MAP == 1) { if (nd < 1280) sc = nd; else if (nd < 1792) sc = nd + 24; else if (nd < 1816) sc = nd - 512; else sc = -1; }
#pragma unroll 8
    for (int i = 0; i < 32; ++i) { const int kk = 2 * i + (lane >> 5); scr[kk * 33 + (lane & 31)] = (sc >= 0) ? W[(size_t)(k0 + kk) * ldw + sc] : 0.f; }
    LDS_WAIT(); asm volatile("" ::: "memory");
    const int c = lane & 7;
#pragma unroll
    for (int j = 0; j < 4; ++j) { const int n = (lane >> 3) + 8 * j; const LAS float* s = scr + (8 * c) * 33 + n;
        v4u o; o.x = pk2(s[0 * 33], s[1 * 33]); o.y = pk2(s[2 * 33], s[3 * 33]); o.z = pk2(s[4 * 33], s[5 * 33]); o.w = pk2(s[6 * 33], s[7 * 33]);
        *(v4u*)(WT + (size_t)(row_off + n0 + n) * K + k0 + 8 * c) = o; }
    LDS_WAIT(); asm volatile("" ::: "memory");
}
__device__ __forceinline__ void rms_row_to_bf16(const float* xrow, const float* g, bf16* orow, int lane) {
    const f32x4* xr = (const f32x4*)xrow + lane; const f32x4* gr = (const f32x4*)g + lane;
    f32x4 v[4]; float s = 0.f;
#pragma unroll
    for (int j = 0; j < 4; ++j) { v[j] = xr[64 * j]; s += (v[j].x * v[j].x + v[j].y * v[j].y) + (v[j].z * v[j].z + v[j].w * v[j].w); }
    const float rstd = 1.0f / sqrtf(wave_sum(s) * (1.f / DM) + 1e-6f);
    unsigned long long* o8 = (unsigned long long*)orow + lane;
#pragma unroll
    for (int j = 0; j < 4; ++j) { const f32x4 gg = gr[64 * j];
        o8[64 * j] = (unsigned long long)pk2(v[j].x * rstd * gg.x, v[j].y * rstd * gg.y) | ((unsigned long long)pk2(v[j].z * rstd * gg.z, v[j].w * rstd * gg.w) << 32); }
}

__device__ __forceinline__ void p0_prologue(const Frame& F, const Args& A) {
    LAS float* scr = (LAS float*)(F.lds + F.wave * 16384);
    const int gw = F.bid * NWAVES + F.wave, NGW = F.G * NWAVES;
    constexpr int I_IN = (DM / 64) * (PW / 32), I_OUT = (DM / 64) * (DM / 32), I_UP = (DM / 64) * (DFF / 32), I_DN = (DFF / 64) * (DM / 32), I_W1 = (4096 / 64) * (128 / 32);
    constexpr int NITEMS = I_IN + I_OUT + I_UP + I_DN + 2 * I_W1;
    for (int it = gw; it < NITEMS; it += NGW) {
        int r = it;
        if (r < I_IN) { p0_transpose_item<1>(A.in[8], DM, 1816, PW / 32, ((bf16*)(A.ws + WS_WIN)), 0, scr, r, F.lane); continue; } r -= I_IN;
        if (r < I_OUT) { p0_transpose_item<0>(A.in[14], DM, DM, DM / 32, ((bf16*)(A.ws + WS_WOUT)), 0, scr, r, F.lane); continue; } r -= I_OUT;
        if (r < I_UP) { p0_transpose_item<0>(A.in[16], DM, DFF, DFF / 32, ((bf16*)(A.ws + WS_WUP)), 0, scr, r, F.lane); continue; } r -= I_UP;
        if (r < I_DN) { p0_transpose_item<0>(A.in[17], DFF, DM, DM / 32, ((bf16*)(A.ws + WS_WDN)), 0, scr, r, F.lane); continue; } r -= I_DN;
        if (r < I_W1) { p0_transpose_item<0>(A.in[10], 4096, 128, 4, ((bf16*)(A.ws + WS_W1S)), 0, scr, r, F.lane); continue; } r -= I_W1;
        p0_transpose_item<0>(A.in[10] + (size_t)4096 * 128, 4096, 128, 4, ((bf16*)(A.ws + WS_W1S)), 128, scr, r, F.lane);
    }
    for (int m = gw; m < MTOK; m += NGW) {
        const float* xr = m < NPR ? A.in[0] + (size_t)m * DM : A.in[1] + (size_t)(m - NPR) * DM;
        rms_row_to_bf16(xr, A.in[7], ((bf16*)(A.ws + WS_XN)) + (size_t)m * DM, F.lane);
    }
}

__device__ __forceinline__ void p2_copies(const Frame& F, const Args& A) {
    const size_t gt = (size_t)F.bid * NTHR + F.tid, NT = (size_t)F.G * NTHR;
    const f32x4* P4 = (const f32x4*)((float*)(A.ws + WS_PROJ));
    f32x4* O4 = (f32x4*)A.out;
    for (size_t i = gt; i < (size_t)NPR * 64; i += NT) { const size_t r = i >> 6, c = i & 63;
        O4[O_PCMP / 4 + i] = P4[r * 512 + C_KC / 4 + c]; O4[O_PSLC / 4 + i] = P4[r * 512 + C_KS / 4 + c]; }
    for (size_t i = gt; i < (size_t)4 * 512 * 64; i += NT) { const size_t c = i & 63, r = (i >> 6) & 511, b = i >> 15;
        O4[O_PWIN / 4 + i] = P4[(b * SEQ + SEQ - 512 + r) * 512 + C_KW / 4 + c]; }
    for (size_t i = gt; i < (size_t)4 * 15 * 128; i += NT) { const size_t c = i & 127, r = (i >> 7) % 15, b = (i >> 7) / 15;
        O4[O_PPOOL / 4 + i] = P4[(b * SEQ + SEQ - 15 + r) * 512 + C_U / 4 + c]; }
    for (size_t i = gt; i < (size_t)NSM * 64; i += NT) { const size_t r = i >> 6, c = i & 63;
        O4[O_SCMP / 4 + i] = P4[(NPR + r) * 512 + C_KC / 4 + c]; O4[O_SSLC / 4 + i] = P4[(NPR + r) * 512 + C_KS / 4 + c]; }
    const f32x4* SW4 = (const f32x4*)A.in[4];
    for (size_t i = gt; i < (size_t)32 * 512 * 64; i += NT) { const size_t c = i & 63, r = (i >> 6) & 511, b = i >> 15;
        O4[O_SWIN / 4 + i] = (r < 504) ? SW4[(b * 512 + r + 8) * 64 + c] : P4[(NPR + b * 8 + (r - 504)) * 512 + C_KW / 4 + c]; }
    const f32x4* SP4 = (const f32x4*)A.in[5];
    for (size_t i = gt; i < (size_t)32 * 15 * 128; i += NT) { const size_t c = i & 127, r = (i >> 7) % 15, b = (i >> 7) / 15;
        O4[O_SPOOL / 4 + i] = (r < 7) ? SP4[(b * 15 + r + 8) * 128 + c] : P4[(NPR + b * 8 + (r - 7)) * 512 + C_U / 4 + c]; }
}
__device__ __forceinline__ void p2_cmp_gather(const Frame& F, const Args& A) {
    const int gw = F.bid * NWAVES + F.wave, NGW = F.G * NWAVES;
    constexpr int NBLK = 8192 + 256 + 32;
    const int lane = F.lane, gc = lane >> 4, g = gc >> 1, c = gc & 1, d0 = (lane & 15) * 4;
    for (int it = gw; it < NBLK * 64; it += NGW) {
        const int blk = it >> 6, l = it & 63;
        f32x4 v; int rsec;
        if (blk < 8192) { const int b = blk >> 8, n = blk & 255; const int page = ((const int*)A.in[6])[b * NPG + (n >> 1)];
            v = *(const f32x4*)(A.in[2] + ((size_t)page * 128 + (n & 1) * 64 + l) * 256 + lane * 4); rsec = (b * 256 + n) * 2 + g; }
        else if (blk < 8192 + 256) { const int q = blk - 8192, b = q >> 6, n = q & 63;
            v = *(const f32x4*)(((float*)(A.ws + WS_PROJ)) + ((size_t)b * SEQ + n * 64 + l) * PW + C_KC + lane * 4); rsec = CMP_R_PROMPT + (b * 64 + n) * 2 + g; }
        else { const int b = blk - 8192 - 256;
            v = (l < 8) ? *(const f32x4*)(((float*)(A.ws + WS_PROJ)) + ((size_t)NPR + b * 8 + l) * PW + C_KC + lane * 4) : (f32x4){0.f, 0.f, 0.f, 0.f}; rsec = CMP_R_NEW + b * 2 + g; }
        const f32x4 pe = *(const f32x4*)(A.in[9] + (l * 2 + c) * 64 + d0);
        v = v + pe;
        v2u o; o.x = pk2(v.x, v.y); o.y = pk2(v.z, v.w);
        *(v2u*)(((bf16*)(A.ws + WS_ACMP)) + ((size_t)c * CMP_SEC + rsec) * 4096 + l * 64 + d0) = o;
    }
}
__device__ __forceinline__ void p2_pool(const Frame& F, const Args& A) {
    LAS float* wl = (LAS float*)F.lds;
    LAS float* dl = (LAS float*)(F.lds + 65536 + F.wave * 2048);
    constexpr int NCH = MTOK / 32;
    const int lane = F.lane;
    for (int unit = F.bid; unit < 4 * NCH; unit += F.G) {
        const int gi = unit / NCH, ch = unit % NCH, w = 2 << gi;
        __syncthreads();
        for (int i = F.tid; i < 128 * 128 / 4; i += NTHR) ((LAS f32x4*)wl)[i] = ((const f32x4*)(A.in[12] + (size_t)gi * 16384))[i];
        const int tok0 = ch * 32 + F.wave * 4;
#pragma unroll
        for (int tk = 0; tk < 4; ++tk) {
            const int row = tok0 + tk;
#pragma unroll
            for (int hh = 0; hh < 2; ++hh) {
                const int cc = gi * 128 + lane + 64 * hh;
                float own, sum = 0.f, cnt;
                if (row < NPR) { const int t = row & (SEQ - 1);
                    own = ((float*)(A.ws + WS_PROJ))[(size_t)row * PW + C_U + cc];
                    for (int j = 0; j < w; ++j) if (t - j >= 0) sum += ((float*)(A.ws + WS_PROJ))[(size_t)(row - j) * PW + C_U + cc];
                    cnt = (float)((t + 1 < w) ? t + 1 : w);
                } else { const int q = row - NPR, b = q >> 3, i = q & 7;
                    own = ((float*)(A.ws + WS_PROJ))[(size_t)row * PW + C_U + cc];
                    for (int j = 0; j < w; ++j) { const int idx = 15 + i - j;
                        sum += (idx >= 15) ? ((float*)(A.ws + WS_PROJ))[(size_t)(NPR + b * 8 + idx - 15) * PW + C_U + cc] : A.in[5][((size_t)b * 15 + idx) * 512 + cc]; }
                    cnt = (float)w;
                }
                dl[(lane + 64 * hh) * 4 + tk] = sum / cnt - own;
            }
        }
        __syncthreads();
        float acc[4][2];
#pragma unroll
        for (int tk = 0; tk < 4; ++tk) { acc[tk][0] = 0.f; acc[tk][1] = 0.f; }
#pragma unroll 4
        for (int c = 0; c < 128; ++c) {
            const f32x4 dv = *(const LAS f32x4*)(dl + c * 4);
            const float w0 = wl[c * 128 + lane], w1 = wl[c * 128 + lane + 64];
            acc[0][0] += dv.x * w0; acc[0][1] += dv.x * w1; acc[1][0] += dv.y * w0; acc[1][1] += dv.y * w1;
            acc[2][0] += dv.z * w0; acc[2][1] += dv.z * w1; acc[3][0] += dv.w * w0; acc[3][1] += dv.w * w1;
        }
        const float s0 = A.in[13][gi * 128 + lane], s1 = A.in[13][gi * 128 + lane + 64];
#pragma unroll
        for (int tk = 0; tk < 4; ++tk) { bf16* o = ((bf16*)(A.ws + WS_MIX)) + (size_t)(tok0 + tk) * DM + 512 + gi * 128;
            o[lane] = (bf16)f2bf(acc[tk][0] * s0); o[lane + 64] = (bf16)f2bf(acc[tk][1] * s1); }
    }
    __syncthreads();
}

__device__ __forceinline__ void p4_cmp_w2(const Frame& F, const Args& A) {
    LAS float* w2l = (LAS float*)F.lds;
    LAS float* hl = (LAS float*)(F.lds + 65536 + F.wave * 512);
    for (int i = F.tid; i < 2 * 128 * 64 / 4; i += NTHR) ((LAS f32x4*)w2l)[i] = ((const f32x4*)A.in[11])[i];
    __syncthreads();
    const int gw = F.bid * NWAVES + F.wave, NGW = F.G * NWAVES, lane = F.lane;
    for (int it = gw; it < 2 * CMP_R_END; it += NGW) {
        const int c = it / CMP_R_END, r = it % CMP_R_END;
        const float* hrow = ((float*)(A.ws + WS_HID)) + ((size_t)c * CMP_SEC + r) * 128;
        hl[lane] = hrow[lane]; hl[lane + 64] = hrow[lane + 64];
        LDS_WAIT(); asm volatile("" ::: "memory");
        float a = 0.f;
#pragma unroll 8
        for (int h = 0; h < 128; ++h) a += hl[h] * w2l[(c * 128 + h) * 64 + lane];
        float* dst;
        if (r < CMP_R_PROMPT) { const int b = r >> 9, n = (r & 511) >> 1, g = r & 1; dst = ((float*)(A.ws + WS_COMPS)) + ((((size_t)b * NBS + n) * 2 + g) * 2 + c) * 64; }
        else if (r < CMP_R_NEW) { const int q = r - CMP_R_PROMPT, b = q >> 7, n = (q & 127) >> 1, g = q & 1; dst = ((float*)(A.ws + WS_COMPP)) + ((((size_t)b * NBP + n) * 2 + g) * 2 + c) * 64; }
        else { const int q = r - CMP_R_NEW, b = q >> 1, g = q & 1; dst = ((float*)(A.ws + WS_COMPS)) + ((((size_t)b * NBS + 256) * 2 + g) * 2 + c) * 64; }
        dst[lane] = a;
        LDS_WAIT(); asm volatile("" ::: "memory");
    }
    __syncthreads();
}

constexpr int ATT_WS = 12288;
struct AttCtx { int is_s, b, t, itok, g, qpos, cur, NB, nsel; const float* comp; };
struct KeyRef { const float* k; float dist; bool valid; };
template <int KIND>
__device__ __forceinline__ KeyRef att_key(const Frame& F, const Args& A, const AttCtx& C, const LAS int* sel, int i, int n) {
    KeyRef r; r.k = nullptr; r.dist = 0.f; r.valid = false;
    if (i >= n) return r;
    if (KIND == 0) {
        const int endp = (i + 1) * 64 - 1;
        r.valid = endp <= C.qpos; r.dist = (float)(C.qpos - endp);
        r.k = C.comp + (((size_t)C.b * C.NB + i) * 2 + C.g) * 128;
    } else if (KIND == 1) {
        const int blk = sel[i >> 6], ii = i & 63, kpos = blk * 64 + ii;
        r.valid = kpos <= C.qpos; r.dist = (float)(C.qpos - kpos);
        if (!C.is_s) r.k = ((float*)(A.ws + WS_PROJ)) + ((size_t)C.b * SEQ + kpos) * PW + C_KS + C.g * 128;
        else if (blk < 256) { const int page = ((const int*)A.in[6])[C.b * NPG + (blk >> 1)]; r.k = A.in[3] + ((size_t)page * 128 + (blk & 1) * 64 + ii) * 256 + C.g * 128; }
        else { r.k = ((float*)(A.ws + WS_PROJ)) + ((size_t)NPR + C.b * 8 + (ii & 7)) * PW + C_KS + C.g * 128; if (ii >= 8) r.valid = false; }
    } else {
        if (!C.is_s) { const int ws = C.t - 511 > 0 ? C.t - 511 : 0; const int kpos = ws + i;
            r.valid = true; r.dist = (float)(C.t - kpos); r.k = ((float*)(A.ws + WS_PROJ)) + ((size_t)C.b * SEQ + kpos) * PW + C_KW + C.g * 128; }
        else if (i < 512) { const int kpos = PAST - 512 + i; r.valid = i > C.itok; r.dist = (float)(C.qpos - kpos);
            r.k = A.in[4] + ((size_t)C.b * 512 + i) * 256 + C.g * 128; }
        else { const int ii = i - 512; r.valid = ii <= C.itok; r.dist = (float)(C.itok - ii);
            r.k = ((float*)(A.ws + WS_PROJ)) + ((size_t)NPR + C.b * 8 + ii) * PW + C_KW + C.g * 128; }
    }
    return r;
}
template <int KIND>
__device__ __forceinline__ void att_branch(const Frame& F, const Args& A, const AttCtx& C, int n, const float (&slope)[4], const LAS float* qs, LAS float* pb, LAS unsigned long long* vp, LAS float* sc, const LAS int* sel,
                                           const float (&gt)[4], float (&ot)[4], float (&mo)[4], float (&lo)[4]) {
    const int lane = F.lane;
    float m[4], l[4], o[4];
#pragma unroll
    for (int h = 0; h < 4; ++h) { m[h] = -INFINITY; l[h] = 0.f; o[h] = 0.f; }
    for (int base = 0; base < n; base += 64) {
        const KeyRef kr = att_key<KIND>(F, A, C, sel, base + lane, n);
        float s[4] = {0.f, 0.f, 0.f, 0.f};
        if (kr.valid) {
#pragma unroll 4
            for (int d4 = 0; d4 < 16; ++d4) { const f32x4 kk = *(const f32x4*)(kr.k + d4 * 4);
#pragma unroll
                for (int h = 0; h < 4; ++h) { const f32x4 qq = *(const LAS f32x4*)(qs + h * 64 + d4 * 4); s[h] += (kk.x * qq.x + kk.y * qq.y) + (kk.z * qq.z + kk.w * qq.w); } }
        }
        float p[4], alpha[4];
#pragma unroll
        for (int h = 0; h < 4; ++h) {
            const float sv = kr.valid ? s[h] * 0.125f - slope[h] * kr.dist : -INFINITY;
            if (KIND == 0) { if (base + lane < n) sc[h * 320 + base + lane] = sv; }
            const float cm = wave_max(sv), mn = fmaxf(m[h], cm);
            alpha[h] = (mn == -INFINITY) ? 1.f : __expf(m[h] - mn);
            p[h] = (kr.valid && mn != -INFINITY) ? __expf(sv - mn) : 0.f;
            l[h] = l[h] * alpha[h] + wave_sum(p[h]);
            m[h] = mn; o[h] *= alpha[h];
        }
        *(LAS f32x4*)(pb + lane * 4) = (f32x4){p[0], p[1], p[2], p[3]};
        vp[lane] = (unsigned long long)(kr.k + 64);
        LDS_WAIT(); asm volatile("" ::: "memory");
        const int cnt = (n - base) < 64 ? (n - base) : 64;
#pragma unroll 2
        for (int k = 0; k < cnt; ++k) {
            const f32x4 p4 = *(const LAS f32x4*)(pb + k * 4);
            if ((p4.x + p4.y) + (p4.z + p4.w) != 0.f) {
                const float v = ((const float*)vp[k])[lane];
                o[0] += p4.x * v; o[1] += p4.y * v; o[2] += p4.z * v; o[3] += p4.w * v;
            }
        }
        LDS_WAIT(); asm volatile("" ::: "memory");
    }
#pragma unroll
    for (int h = 0; h < 4; ++h) { ot[h] += gt[h] * o[h] / fmaxf(l[h], 1e-30f); mo[h] = m[h]; lo[h] = l[h]; }
}
__device__ __forceinline__ void p5_attn_simple(const Frame& F, const Args& A) {
    LAS unsigned char* wb = F.lds + F.wave * ATT_WS;
    LAS float* qs = (LAS float*)wb;
    LAS float* pb = (LAS float*)(wb + 1024);
    LAS unsigned long long* vp = (LAS unsigned long long*)(wb + 2048);
    LAS float* sc = (LAS float*)(wb + 2560);
    LAS float* score = (LAS float*)(wb + 2560 + 5120);
    LAS int* sel = (LAS int*)(wb + 2560 + 5120 + 1280);
    const int gw = F.bid * NWAVES + F.wave, NGW = F.G * NWAVES, lane = F.lane;
    for (int job = gw; job < MTOK * 2; job += NGW) {
        const int row = job >> 1, g = job & 1;
        AttCtx C; C.g = g;
        if (row < NPR) { C.is_s = 0; C.b = row >> 12; C.t = row & (SEQ - 1); C.itok = 0; C.qpos = C.t; C.NB = NBP; C.comp = ((float*)(A.ws + WS_COMPP)); }
        else { const int q = row - NPR; C.is_s = 1; C.b = q >> 3; C.itok = q & 7; C.t = 0; C.qpos = PAST + C.itok; C.NB = NBS; C.comp = ((float*)(A.ws + WS_COMPS)); }
        C.cur = C.qpos >> 6; C.nsel = 0;
        const float* prow = ((float*)(A.ws + WS_PROJ)) + (size_t)row * PW;
        *(LAS f32x4*)(qs + lane * 4) = *(const f32x4*)(prow + C_Q + g * 256 + lane * 4);
        float slope[4], gate[3][4];
#pragma unroll
        for (int h = 0; h < 4; ++h) { slope[h] = exp2f(-(float)(g * 4 + h + 1));
#pragma unroll
            for (int br = 0; br < 3; ++br) { const float x = prow[C_G + br * 8 + g * 4 + h]; gate[br][h] = 1.0f / (1.0f + __expf(-x)); } }
        LDS_WAIT(); asm volatile("" ::: "memory");
        float ot[4] = {0.f, 0.f, 0.f, 0.f}, mc[4], lc[4], md[4], ld[4];
        att_branch<0>(F, A, C, C.NB, slope, qs, pb, vp, sc, sel, gate[0], ot, mc, lc);
        for (int n = lane; n < C.NB; n += 64) {
            float imp = 0.f;
#pragma unroll
            for (int h = 0; h < 4; ++h) { const float sv = sc[h * 320 + n]; imp += (sv != -INFINITY) ? __expf(sv - mc[h]) / fmaxf(lc[h], 1e-30f) : 0.f; }
            float s = imp;
            if (n == 0 || n == C.cur || n == C.cur - 1) s = 5.0f;
            if (n > C.cur) s = -1.0f;
            score[n] = s;
        }
        LDS_WAIT(); asm volatile("" ::: "memory");
        int nsel = 0;
        for (int cb = 0; cb < C.NB; cb += 64) {
            const int n = cb + lane; const bool cand = n < C.NB && n <= C.cur;
            const float sn = cand ? score[n] : -2.f;
            int cnt = 0;
#pragma unroll 4
            for (int mm = 0; mm < C.NB; ++mm) { const float sm = score[mm]; cnt += (sm > sn || (sm == sn && mm < n)) ? 1 : 0; }
            const bool pick = cand && cnt < 16;
            const unsigned long long bal = __ballot(pick);
            if (pick) sel[nsel + __popcll(bal & ((1ull << lane) - 1ull))] = n;
            nsel += __popcll(bal);
        }
        LDS_WAIT(); asm volatile("" ::: "memory");
        C.nsel = nsel;
        att_branch<1>(F, A, C, nsel * 64, slope, qs, pb, vp, sc, sel, gate[1], ot, md, ld);
        const int nwin = C.is_s ? 520 : (C.t < 511 ? C.t + 1 : 512);
        att_branch<2>(F, A, C, nwin, slope, qs, pb, vp, sc, sel, gate[2], ot, md, ld);
        bf16* orow = ((bf16*)(A.ws + WS_MIX)) + (size_t)row * DM + g * 256;
#pragma unroll
        for (int h = 0; h < 4; ++h) orow[h * 64 + lane] = (bf16)f2bf(ot[h]);
    }
}

__device__ __forceinline__ void p7_hb(const Frame& F, const Args& A) {
    const int gw = F.bid * NWAVES + F.wave, NGW = F.G * NWAVES;
    for (int m = gw; m < MTOK; m += NGW) rms_row_to_bf16(((float*)(A.ws + WS_H)) + (size_t)m * DM, A.in[15], ((bf16*)(A.ws + WS_HB)) + (size_t)m * DM, F.lane);
}
__device__ __forceinline__ void p10_final(const Frame& F, const Args& A) {
    const int gw = F.bid * NWAVES + F.wave, NGW = F.G * NWAVES, lane = F.lane;
    for (int m = gw; m < MTOK; m += NGW) {
        f32x4* xr = (f32x4*)(A.out + (size_t)m * DM) + lane; const f32x4* gr = (const f32x4*)A.in[18] + lane;
        f32x4 v[4]; float s = 0.f;
#pragma unroll
        for (int j = 0; j < 4; ++j) { v[j] = xr[64 * j]; s += (v[j].x * v[j].x + v[j].y * v[j].y) + (v[j].z * v[j].z + v[j].w * v[j].w); }
        const float rstd = 1.0f / sqrtf(wave_sum(s) * (1.f / DM) + 1e-6f);
#pragma unroll
        for (int j = 0; j < 4; ++j) xr[64 * j] = v[j] * rstd * gr[64 * j];
    }
}

__global__ void __launch_bounds__(NTHR, 2) fwd_kernel(Args A) {
    extern __shared__ __attribute__((aligned(16))) unsigned char lds_raw[];
    Frame F;
    F.lds = (LAS unsigned char*)lds_raw;
    F.tid = threadIdx.x; F.lane = F.tid & 63; F.wave = __builtin_amdgcn_readfirstlane(F.tid >> 6); F.G = gridDim.x; F.bid = blockIdx.x;
    unsigned char* ws = A.ws;
    for (int u = F.tid; u < (LDS_BYTES - LDSCTL_OFF) / 4; u += NTHR) ((LAS unsigned*)(F.lds + LDSCTL_OFF))[u] = 0u;
    __syncthreads();
    const int lo = A.ph_lo, hi = A.ph_hi;
    const bool multi = (hi - lo) > 1;
    XcdBarrier bar; bar.bar = (unsigned*)(ws + WS_CTL) + CW_BAR; bar.x = 0; bar.st = nullptr;
    if (multi) bar = xcd_barrier_post((unsigned*)(ws + WS_CTL) + CW_BAR, (volatile LAS unsigned*)(F.lds + MISC_OFF));
#define IN(k) (lo <= (k) && (k) < hi)
#define SEAM(k) do { if (IN(k) && IN((k) + 1)) xcd_barrier(bar); } while (0)

    if (IN(0)) { p0_prologue(F, A); } SEAM(0);
    if (IN(1)) {
        pg8::Gemm g{((bf16*)(A.ws + WS_XN)), ((bf16*)(A.ws + WS_WIN)), MTOK, PW, DM}; pg8::StaticOrder S; S.init(MTOK, PW, F.G, F.bid);
        pg8::EpiF32 E{((float*)(A.ws + WS_PROJ)), PW};
        pg8::gemm_phase<pg8::EpiF32, pg8::StaticOrder>(F.lds, g, S, E, nullptr);
    } SEAM(1);
    if (IN(2)) { p2_copies(F, A); p2_cmp_gather(F, A); p2_pool(F, A); } SEAM(2);
    if (IN(3)) {
        pg8::Gemm g{((bf16*)(A.ws + WS_ACMP)), ((bf16*)(A.ws + WS_W1S)), CMP_ROWS, 256, 4096}; pg8::StaticOrder S; S.init(CMP_ROWS, 256, F.G, F.bid);
        pg8::EpiCmpHid E{((float*)(A.ws + WS_HID)), CMP_SEC / 256};
        pg8::gemm_phase<pg8::EpiCmpHid, pg8::StaticOrder>(F.lds, g, S, E, nullptr);
    } SEAM(3);
    if (IN(4)) { p4_cmp_w2(F, A); } SEAM(4);
    if (IN(5)) { p5_attn_simple(F, A); } SEAM(5);
    if (IN(6)) {
        pg8::Gemm g{((bf16*)(A.ws + WS_MIX)), ((bf16*)(A.ws + WS_WOUT)), MTOK, DM, DM}; pg8::StaticOrder S; S.init(MTOK, DM, F.G, F.bid);
        pg8::EpiResF32 E{A.in[0], A.in[1], NPR / 256, ((float*)(A.ws + WS_H)), DM};
        pg8::gemm_phase<pg8::EpiResF32, pg8::StaticOrder>(F.lds, g, S, E, nullptr);
    } SEAM(6);
    if (IN(7)) { p7_hb(F, A); } SEAM(7);
    if (IN(8)) {
        pg8::Gemm g{((bf16*)(A.ws + WS_HB)), ((bf16*)(A.ws + WS_WUP)), MTOK, DFF, DM}; pg8::StaticOrder S; S.init(MTOK, DFF, F.G, F.bid);
        pg8::EpiRelu2Bf16 E{((bf16*)(A.ws + WS_ACT)), DFF};
        pg8::gemm_phase<pg8::EpiRelu2Bf16, pg8::StaticOrder>(F.lds, g, S, E, nullptr);
    } SEAM(8);
    if (IN(9)) {
        pg8::Gemm g{((bf16*)(A.ws + WS_ACT)), ((bf16*)(A.ws + WS_WDN)), MTOK, DM, DFF}; pg8::StaticOrder S; S.init(MTOK, DM, F.G, F.bid);
        pg8::EpiResF32 E{((float*)(A.ws + WS_H)), ((float*)(A.ws + WS_H)), 1 << 20, A.out, DM};
        pg8::gemm_phase<pg8::EpiResF32, pg8::StaticOrder>(F.lds, g, S, E, nullptr);
    } SEAM(9);
    if (IN(10)) { p10_final(F, A); }
#undef IN
#undef SEAM
}

#ifndef MK_ONE_LAUNCH
#define MK_ONE_LAUNCH 0
#endif
extern "C" void kernel_launch(void* const* d_in, const int* in_sizes, int n_in, void* d_out, int out_size, void* d_ws, size_t ws_size, hipStream_t stream) {
    static int grid = 0;
    if (grid == 0) {
        if (n_in != 19 || (size_t)out_size != O_END || ws_size < WS_END) { fprintf(stderr, "kernel_launch: unexpected shapes n_in %d out %d ws %zu\n", n_in, out_size, ws_size); grid = -1; return; }
        int dev = 0, cus = 0, per_cu = 0;
        if (hipGetDevice(&dev) != hipSuccess || hipDeviceGetAttribute(&cus, hipDeviceAttributeMultiprocessorCount, dev) != hipSuccess) { grid = -1; return; }
        if (hipFuncSetAttribute((const void*)fwd_kernel, hipFuncAttributeMaxDynamicSharedMemorySize, LDS_BYTES) != hipSuccess) { fprintf(stderr, "kernel_launch: hipFuncSetAttribute failed\n"); grid = -1; return; }
        if (hipOccupancyMaxActiveBlocksPerMultiprocessor(&per_cu, (const void*)fwd_kernel, NTHR, LDS_BYTES) != hipSuccess || per_cu < 1) fprintf(stderr, "kernel_launch: occupancy query says %d\n", per_cu);
        (void)hipGetLastError();
        grid = cus;
    }
    if (grid < 0) return;
    if (hipMemsetAsync((char*)d_ws + WS_CTL, 0, CTL_ZERO_BYTES, stream) != hipSuccess) return;
    Args a{};
    for (int i = 0; i < 19; ++i) a.in[i] = (const float*)d_in[i];
    a.out = (float*)d_out; a.ws = (unsigned char*)d_ws;
#if MK_ONE_LAUNCH
    a.ph_lo = 0; a.ph_hi = NPHASES;
    hipLaunchKernelGGL(fwd_kernel, dim3(grid), dim3(NTHR), LDS_BYTES, stream, a);
#else
    for (int p = 0; p < NPHASES; ++p) { a.ph_lo = p; a.ph_hi = p + 1; hipLaunchKernelGGL(fwd_kernel, dim3(grid), dim3(NTHR), LDS_BYTES, stream, a); }
#endif
}
```

```cpp
#include <hip/hip_runtime.h>
#include <cstdio>
#include <cstdint>
namespace pg8 {
#define PG8_LAS __attribute__((address_space(3)))
typedef unsigned short bf16_t;
typedef short bf16x8 __attribute__((ext_vector_type(8)));
typedef float f32x4 __attribute__((ext_vector_type(4)));
typedef unsigned u32x4 __attribute__((ext_vector_type(4)));
constexpr int BM = 256, BK = 64, HALF = 128, HTB = HALF * BK * 2  , STAGE_BYTES = 8 * HTB, NXCD = 8, WGM = 8;

__host__ __device__ __forceinline__ int lds_byte(int r, int c) { const int st = (r >> 4) * 2 + (c >> 5), rr = r & 15, cc = c & 31, ob = rr * 64 + cc * 2; return st * 1024 + (ob ^ (((ob >> 9) & 1) << 5)); }
__host__ __device__ __forceinline__ void stage_rc(int b, int& R, int& C) { const int st = b / 1024, sb = b % 1024, swz = sb ^ (((sb >> 9) & 1) << 5); R = (st >> 1) * 16 + swz / 64; C = (st & 1) * 32 + (swz % 64) / 2; }
__host__ __device__ __forceinline__ int perm32(int rho) { const int n = rho >> 4, i = rho & 15; return 8 * (i >> 2) + 4 * n + (i & 3); }

struct Unit { int pm, pn; };
struct Gemm { const bf16_t* A; const bf16_t* Bt; int M, N, K; };

struct StaticOrder {
    int nM, nN, nwg, G, c;
    __host__ __device__ void init(int M, int N, int G_, int c_) { nM = M / BM; nN = N / BM; nwg = nM * nN; G = G_; c = c_; }
    __host__ __device__ bool next(int i, Unit& u) const {
        const long L = (long)i * G + c; if (L >= nwg) return false;
        int wgid = (int)L; { const int q = nwg / NXCD, r = nwg % NXCD, xcd = wgid % NXCD, off = wgid / NXCD; wgid = (xcd < r ? xcd * (q + 1) : r * (q + 1) + (xcd - r) * q) + off; }
        const int nig = WGM * nN, gid = wgid / nig, fm = gid * WGM, gsz = (nM - fm) < WGM ? (nM - fm) : WGM;
        u.pm = fm + ((wgid % nig) % gsz); u.pn = (wgid % nig) / gsz; return true;
    }
    __device__ __forceinline__ void a_ready(const Unit&) const {}
    __device__ __forceinline__ void done(const Unit&) const {}
};
struct CountedOrder : StaticOrder {
    const unsigned* ready; unsigned need; unsigned* tmo;
    __device__ __forceinline__ void a_ready(const Unit& u) const {
        if (threadIdx.x < 64) {
            const unsigned long long t0 = __builtin_amdgcn_s_memrealtime(); unsigned polls = 0;
            while ((unsigned)__builtin_amdgcn_readfirstlane(__hip_atomic_load(ready + 64 * u.pm, __ATOMIC_RELAXED, __HIP_MEMORY_SCOPE_AGENT)) < need) {
                if ((++polls & 255u) == 0u && __builtin_amdgcn_readfirstlane(__hip_atomic_load(tmo, __ATOMIC_RELAXED, __HIP_MEMORY_SCOPE_AGENT)) != 0u) break;
                if (__builtin_amdgcn_s_memrealtime() - t0 > 2000000ull) {
                    if (threadIdx.x == 0) { unsigned expect = 0u; __hip_atomic_compare_exchange_strong(tmo + 1, &expect, 0x600u | (unsigned)(u.pm & 0xff), __ATOMIC_RELAXED, __ATOMIC_RELAXED, __HIP_MEMORY_SCOPE_AGENT); __hip_atomic_store(tmo, 1u, __ATOMIC_RELAXED, __HIP_MEMORY_SCOPE_AGENT); }
                    break; }
                __builtin_amdgcn_s_sleep(2); }
            __builtin_amdgcn_fence(__ATOMIC_ACQUIRE, "agent");
            asm volatile("s_waitcnt vmcnt(0)" ::: "memory");
        }
#if !defined(BROKEN_HOOK_NO_BARRIER)
        asm volatile("" ::: "memory"); __builtin_amdgcn_s_barrier(); asm volatile("" ::: "memory");
#endif
    }
};

__device__ __forceinline__ unsigned cvt_pk_bf16(float lo, float hi) { unsigned r; asm volatile("v_cvt_pk_bf16_f32 %0, %1, %2" : "=v"(r) : "v"(lo), "v"(hi)); return r; }
struct EpiF32 {
    static constexpr bool PERM = false, AFTER_DRAIN = false;
    float* C; int ldc;
    __device__ __forceinline__ void operator()(const f32x4 (&acc)[2][2][4][2], const Unit& u, int wr, int wc, int fr, int fq) const {
        const int row0 = u.pm * BM + wr * 64 + fr, col0 = u.pn * BM + wc * 32 + 4 * fq;
#pragma unroll
        for (int ai = 0; ai < 2; ++ai)
#pragma unroll
            for (int m = 0; m < 4; ++m) { float* rowp = C + (size_t)(row0 + ai * HALF + m * 16) * ldc + col0;
#pragma unroll
                for (int bj = 0; bj < 2; ++bj)
#pragma unroll
                    for (int n = 0; n < 2; ++n) *(f32x4*)(rowp + bj * HALF + n * 16) = acc[ai][bj][m][n]; }
    }
};
struct EpiResF32 {
    static constexpr bool PERM = false, AFTER_DRAIN = false;
    const float* base0; const float* base1; int split; float* out; int ldc;
    __device__ __forceinline__ void operator()(const f32x4 (&acc)[2][2][4][2], const Unit& u, int wr, int wc, int fr, int fq) const {
        const int row0 = u.pm * BM + wr * 64 + fr, col0 = u.pn * BM + wc * 32 + 4 * fq;
        const float* bb = (u.pm < split) ? base0 : (base1 - (size_t)split * BM * ldc);
#pragma unroll
        for (int ai = 0; ai < 2; ++ai)
#pragma unroll
            for (int m = 0; m < 4; ++m) { const size_t off = (size_t)(row0 + ai * HALF + m * 16) * ldc + col0;
#pragma unroll
                for (int bj = 0; bj < 2; ++bj)
#pragma unroll
                    for (int n = 0; n < 2; ++n) { const f32x4 b = *(const f32x4*)(bb + off + bj * HALF + n * 16); *(f32x4*)(out + off + bj * HALF + n * 16) = acc[ai][bj][m][n] + b; } }
    }
};
struct EpiRelu2Bf16 {
    static constexpr bool PERM = true, AFTER_DRAIN = false;
    bf16_t* O; int ldc;
    __device__ __forceinline__ void operator()(const f32x4 (&acc)[2][2][4][2], const Unit& u, int wr, int wc, int fr, int fq) const {
        const int row0 = u.pm * BM + wr * 64 + fr, col0 = u.pn * BM + wc * 32 + 8 * fq;
#pragma unroll
        for (int ai = 0; ai < 2; ++ai)
#pragma unroll
            for (int m = 0; m < 4; ++m) { bf16_t* rowp = O + (size_t)(row0 + ai * HALF + m * 16) * ldc + col0;
#pragma unroll
                for (int bj = 0; bj < 2; ++bj) { f32x4 v0 = acc[ai][bj][m][0], v1 = acc[ai][bj][m][1];
#pragma unroll
                    for (int j = 0; j < 4; ++j) { const float a = fmaxf(v0[j], 0.f), b = fmaxf(v1[j], 0.f); v0[j] = a * a; v1[j] = b * b; }
                    u32x4 w; w.x = cvt_pk_bf16(v0[0], v0[1]); w.y = cvt_pk_bf16(v0[2], v0[3]); w.z = cvt_pk_bf16(v1[0], v1[1]); w.w = cvt_pk_bf16(v1[2], v1[3]);
                    *(u32x4*)(rowp + bj * HALF) = w; } }
    }
};
__device__ __forceinline__ float gelu_tanh(float x) {
    const float y = 0.7978845608028654f * (x + 0.044715f * x * x * x);
    const float t = 1.0f - 2.0f / (__expf(2.0f * y) + 1.0f);
    return 0.5f * x * (1.0f + t);
}
struct EpiCmpHid {
    static constexpr bool PERM = false, AFTER_DRAIN = false;
    float* H; int csplit;
    __device__ __forceinline__ void operator()(const f32x4 (&acc)[2][2][4][2], const Unit& u, int wr, int wc, int fr, int fq) const {
        const int row0 = u.pm * BM + wr * 64 + fr, col0 = wc * 32 + 4 * fq;
        const bool c1 = u.pm >= csplit;
#pragma unroll
        for (int ai = 0; ai < 2; ++ai)
#pragma unroll
            for (int m = 0; m < 4; ++m) { float* rowp = H + (size_t)(row0 + ai * HALF + m * 16) * 128 + col0;
#pragma unroll
                for (int n = 0; n < 2; ++n) { f32x4 v = c1 ? acc[ai][1][m][n] : acc[ai][0][m][n];
#pragma unroll
                    for (int j = 0; j < 4; ++j) v[j] = gelu_tanh(v[j]);
                    *(f32x4*)(rowp + n * 16) = v; } }
    }
};
template <class Epi, class Sched, bool STAMP = false>
__device__ __forceinline__ void gemm_phase(PG8_LAS unsigned char* lds, const Gemm g, const Sched& S, const Epi& E, unsigned long long* stamps) {
    const int tid = threadIdx.x, wid = __builtin_amdgcn_readfirstlane(tid >> 6), lane = tid & 63, wr = wid >> 2, wc = wid & 3, fr = lane & 15, fq = lane >> 4;
    const int K = g.K, nt = K / BK;
    int ts_lo = 0, ts_hi = 0, nts = 0; const unsigned long long rt_entry = STAMP ? (unsigned long long)wall_clock64() : 0ull;
#define PG8_STAMP() do { if (STAMP && wid == 0 && nts < 64) { const unsigned long long _c = (unsigned long long)clock64(); \
        ts_lo = (lane == nts) ? (int)(unsigned)_c : ts_lo; ts_hi = (lane == nts) ? (int)(unsigned)(_c >> 32) : ts_hi; ++nts; } } while (0)
    PG8_STAMP();
    unsigned voffA[2], voffB[2];
#pragma unroll
    for (int i = 0; i < 2; ++i) { int R, C; stage_rc(tid * 16 + i * 8192, R, C); const int Rb = Epi::PERM ? ((R & ~31) + perm32(R & 31)) : R;
        voffA[i] = (unsigned)(R * K + C) * 2u; voffB[i] = (unsigned)(Rb * K + C) * 2u; }
    const size_t kstep = (size_t)(BK * 2);
    const size_t hstep = (size_t)HALF * K * 2;
    const size_t tstep = 2 * hstep;
    const unsigned ldsw = (unsigned)wid * 1024u;
    const int aoff = lds_byte(wr * 64 + fr, fq * 8), boff = lds_byte(wc * 32 + fr, fq * 8);
#define PG8_SA(b, h) (((b) * 2 + (h)) * HTB)
#define PG8_SB(b, h) ((4 + (b) * 2 + (h)) * HTB)
#define PG8_STAGE(bufoff, gbase, voff) do { _Pragma("unroll") for (int _i = 0; _i < 2; ++_i) \
        __builtin_amdgcn_global_load_lds((const unsigned*)((const char*)(gbase) + (voff)[_i]), (PG8_LAS unsigned*)(lds + (bufoff) + ldsw + _i * 8192), 16, 0, 0); } while (0)
#define PG8_LDA(dst, b, h) do { _Pragma("unroll") for (int m = 0; m < 4; ++m) _Pragma("unroll") for (int k = 0; k < 2; ++k) dst[m][k] = *(const PG8_LAS bf16x8*)(lds + PG8_SA(b, h) + aoff + m * 2048 + k * 1024); } while (0)
#define PG8_LDB(dst, b, h) do { _Pragma("unroll") for (int n = 0; n < 2; ++n) _Pragma("unroll") for (int k = 0; k < 2; ++k) dst[n][k] = *(const PG8_LAS bf16x8*)(lds + PG8_SB(b, h) + boff + n * 2048 + k * 1024); } while (0)
#define PG8_MMA(ai, bj, At, Bt) do { __builtin_amdgcn_s_setprio(1); _Pragma("unroll") for (int m = 0; m < 4; ++m) _Pragma("unroll") for (int n = 0; n < 2; ++n) _Pragma("unroll") for (int k = 0; k < 2; ++k) \
        acc[ai][bj][m][n] = __builtin_amdgcn_mfma_f32_16x16x32_bf16(Bt[n][k], At[m][k], acc[ai][bj][m][n], 0, 0, 0); __builtin_amdgcn_s_setprio(0); } while (0)
#define PG8_WAIT_V(n) asm volatile("s_waitcnt vmcnt(" #n ")" ::: "memory")
#define PG8_WAIT_L(n) asm volatile("s_waitcnt lgkmcnt(" #n ")" ::: "memory")
#define PG8_BAR __builtin_amdgcn_s_barrier()
#define PG8_SCHED __builtin_amdgcn_sched_barrier(0)
    Unit cur, nxt; int ui = 0;
    if (!S.next(0, cur)) return;
    f32x4 acc[2][2][4][2];
#pragma unroll
    for (int a = 0; a < 2; ++a)
#pragma unroll
        for (int b = 0; b < 2; ++b)
#pragma unroll
            for (int m = 0; m < 4; ++m)
#pragma unroll
                for (int n = 0; n < 2; ++n) acc[a][b][m][n] = (f32x4){0.f, 0.f, 0.f, 0.f};
    bf16x8 At[4][2], B0[2][2], B1[2][2];
    const char* cA = (const char*)g.A + (size_t)cur.pm * tstep; const char* cB = (const char*)g.Bt + (size_t)cur.pn * tstep;
    S.a_ready(cur);
    PG8_STAGE(PG8_SB(0, 0), cB, voffB); PG8_STAGE(PG8_SA(0, 0), cA, voffA); PG8_STAGE(PG8_SB(0, 1), cB + hstep, voffB); PG8_STAGE(PG8_SA(0, 1), cA + hstep, voffA);
    if (wr == 1) PG8_BAR;
    PG8_WAIT_V(4); PG8_BAR;
    PG8_STAGE(PG8_SB(1, 0), cB + kstep, voffB); PG8_STAGE(PG8_SA(1, 0), cA + kstep, voffA); PG8_STAGE(PG8_SB(1, 1), cB + hstep + kstep, voffB);
    PG8_WAIT_V(6); PG8_BAR;
    PG8_STAMP();
    for (;;) {
        const bool has_next = S.next(ui + 1, nxt);
        const char* nA = has_next ? (const char*)g.A + (size_t)nxt.pm * tstep : cA; const char* nB = has_next ? (const char*)g.Bt + (size_t)nxt.pn * tstep : cB;
        for (int t = 0; t < nt; t += 2) {
            const bool last = (t == nt - 2);
            const char* a1 = cA + (size_t)(t + 1) * kstep;
            const char* a2 = last ? nA : cA + (size_t)(t + 2) * kstep; const char* b2 = last ? nB : cB + (size_t)(t + 2) * kstep;
            const char* a3 = a2 + kstep; const char* b3 = b2 + kstep;
            if (last && has_next) S.a_ready(nxt);
            PG8_LDB(B0, 0, 0); PG8_SCHED; PG8_LDA(At, 0, 0); PG8_STAGE(PG8_SA(1, 1), a1 + hstep, voffA);
            PG8_WAIT_L(8); PG8_BAR; PG8_WAIT_L(0); PG8_MMA(0, 0, At, B0); PG8_BAR; PG8_SCHED;
            PG8_LDB(B1, 0, 1); PG8_STAGE(PG8_SB(0, 0), b2, voffB);
            PG8_BAR; PG8_WAIT_L(0); PG8_MMA(0, 1, At, B1); PG8_BAR;
            PG8_LDA(At, 0, 1); PG8_STAGE(PG8_SA(0, 0), a2, voffA);
            PG8_BAR; PG8_WAIT_L(0); PG8_MMA(1, 0, At, B0); PG8_BAR; PG8_SCHED;
            PG8_STAGE(PG8_SB(0, 1), b2 + hstep, voffB);
            PG8_WAIT_V(6); PG8_BAR; PG8_MMA(1, 1, At, B1); PG8_BAR;
            PG8_LDB(B0, 1, 0); PG8_SCHED; PG8_LDA(At, 1, 0); PG8_STAGE(PG8_SA(0, 1), a2 + hstep, voffA);
            PG8_WAIT_L(8); PG8_BAR; PG8_WAIT_L(0); PG8_MMA(0, 0, At, B0); PG8_BAR; PG8_SCHED;
            PG8_LDB(B1, 1, 1); PG8_STAGE(PG8_SB(1, 0), b3, voffB);
            PG8_BAR; PG8_WAIT_L(0); PG8_MMA(0, 1, At, B1); PG8_BAR;
            PG8_LDA(At, 1, 1); PG8_STAGE(PG8_SA(1, 0), a3, voffA);
            PG8_BAR; PG8_WAIT_L(0); PG8_MMA(1, 0, At, B0); PG8_BAR; PG8_SCHED;
            PG8_STAGE(PG8_SB(1, 1), b3 + hstep, voffB);
            PG8_WAIT_V(6); PG8_BAR; PG8_MMA(1, 1, At, B1); PG8_BAR;
        }
        PG8_STAMP();
        if constexpr (!Epi::AFTER_DRAIN) { E(acc, cur, wr, wc, fr, fq); S.done(cur); }
        PG8_STAMP();
        if (!has_next) break;
#pragma unroll
        for (int a = 0; a < 2; ++a)
#pragma unroll
            for (int b = 0; b < 2; ++b)
#pragma unroll
                for (int m = 0; m < 4; ++m)
#pragma unroll
                    for (int n = 0; n < 2; ++n) acc[a][b][m][n] = (f32x4){0.f, 0.f, 0.f, 0.f};
        cur = nxt; cA = nA; cB = nB; ++ui;
    }
    PG8_WAIT_V(0);
    if (wr == 0) PG8_BAR;
    PG8_BAR;
    if constexpr (Epi::AFTER_DRAIN) { E.fused(acc, cur, wr, wc, fr, fq, lds, wid, lane); S.done(cur); }
    PG8_STAMP();
    if (STAMP && wid == 0) { stamps[lane] = lane < nts ? (((unsigned long long)(unsigned)ts_hi << 32) | (unsigned)ts_lo) : 0ull;
        if (lane == 62) stamps[62] = rt_entry; if (lane == 63) stamps[63] = (unsigned long long)wall_clock64(); }
#undef PG8_STAMP
#undef PG8_SA
#undef PG8_SB
#undef PG8_STAGE
#undef PG8_LDA
#undef PG8_LDB
#undef PG8_MMA
#undef PG8_WAIT_V
#undef PG8_WAIT_L
#undef PG8_BAR
#undef PG8_SCHED
}
}

constexpr int DM = 1024, NPR = 16384, NSM = 256, MTOK = NPR + NSM, SEQ = 4096, NBP = 64, PAST = 16384, NBS = 257, NPG = 128, DFF = 4096;
constexpr int PW = 2048;
constexpr int C_Q = 0, C_KC = 512, C_KS = 768, C_KW = 1024, C_U = 1280, C_G = 1792;
constexpr int CMP_SEC = 17152, CMP_ROWS = 2 * CMP_SEC;
constexpr int CMP_R_PROMPT = 16384, CMP_R_NEW = 16896, CMP_R_END = 16960;
constexpr size_t O_YP = 0, O_YS = 16777216, O_PCMP = 17039360, O_PSLC = 21233664, O_PWIN = 25427968, O_PPOOL = 25952256,
                 O_SCMP = 25982976, O_SSLC = 26048512, O_SWIN = 26114048, O_SPOOL = 30308352, O_END = 30554112;
constexpr size_t MiB = 1u << 20;
constexpr size_t WS_CTL = 0, CTL_ZERO_BYTES = 1 * MiB;
constexpr size_t WS_WIN = 2 * MiB, WS_WOUT = 6 * MiB, WS_WUP = 8 * MiB, WS_WDN = 16 * MiB, WS_W1S = 24 * MiB;
constexpr size_t WS_XN = 32 * MiB, WS_PROJ = 66 * MiB, WS_ACMP = 200 * MiB, WS_HID = 470 * MiB, WS_COMPS = 490 * MiB, WS_COMPP = 500 * MiB;
constexpr size_t WS_MIX = 502 * MiB, WS_H = 536 * MiB, WS_HB = 602 * MiB, WS_ACT = 636 * MiB, WS_END = 768 * MiB;
static_assert(WS_XN + (size_t)MTOK * DM * 2 <= WS_PROJ && WS_PROJ + (size_t)MTOK * PW * 4 <= WS_ACMP && WS_ACMP + (size_t)CMP_ROWS * 4096 * 2 <= WS_HID, "ws map 1");
static_assert(WS_HID + (size_t)CMP_ROWS * 128 * 4 <= WS_COMPS && WS_COMPS + (size_t)32 * NBS * 256 * 4 <= WS_COMPP && WS_COMPP + (size_t)4 * NBP * 256 * 4 <= WS_MIX, "ws map 2");
static_assert(WS_MIX + (size_t)MTOK * DM * 2 <= WS_H && WS_H + (size_t)MTOK * DM * 4 <= WS_HB && WS_HB + (size_t)MTOK * DM * 2 <= WS_ACT && WS_ACT + (size_t)MTOK * DFF * 2 <= WS_END, "ws map 3");
constexpr int CW_BAR = 4096;

constexpr int NWAVES = 8, NTHR = NWAVES * 64;
constexpr int RING_BYTES = 131072, LDSCTL_OFF = RING_BYTES, MISC_OFF = LDSCTL_OFF + 320, LDS_BYTES = 147456;
constexpr int NPHASES = 11;

#define GAS __attribute__((address_space(1)))
#define LAS __attribute__((address_space(3)))
typedef unsigned short bf16;
typedef unsigned v4u __attribute__((ext_vector_type(4)));
typedef unsigned v2u __attribute__((ext_vector_type(2)));
typedef float f32x4 __attribute__((ext_vector_type(4)));
#define LDS_WAIT() asm volatile("s_waitcnt lgkmcnt(0)" ::: "memory")
__device__ __forceinline__ unsigned f2bf(float f) { unsigned u = __builtin_bit_cast(unsigned, f); return (u + 0x7fffu + ((u >> 16) & 1u)) >> 16; }
__device__ __forceinline__ unsigned pk2(float lo, float hi) { return f2bf(lo) | (f2bf(hi) << 16); }
__device__ __forceinline__ float wave_sum(float v) {
#pragma unroll
    for (int o = 1; o < 64; o <<= 1) v += __shfl_xor(v, o);
    return v;
}
__device__ __forceinline__ float wave_max(float v) {
#pragma unroll
    for (int o = 1; o < 64; o <<= 1) v = fmaxf(v, __shfl_xor(v, o));
    return v;
}

#define XB_TMO      128
#define XB_XCNT(j)  (256  + 64 * (j))
#define XB_XSUB(j)  (1280 + 64 * (j))
#define XB_XGEN(j)  (2304 + 64 * (j))
#define XB_TOP      3328
#define XB_TOPGEN   3392
#define XCD_BAR_WORDS 3456
#define XB_SPIN_CAP (1u << 18)
__device__ __forceinline__ unsigned xb_ld(unsigned* p)              { return __hip_atomic_load(p, __ATOMIC_RELAXED, __HIP_MEMORY_SCOPE_AGENT); }
__device__ __forceinline__ unsigned xb_add(unsigned* p, unsigned v) { return __hip_atomic_fetch_add(p, v, __ATOMIC_RELAXED, __HIP_MEMORY_SCOPE_AGENT); }
__device__ __forceinline__ unsigned xb_xcc_id() { return (unsigned)__builtin_amdgcn_s_getreg((3 << 11) | 20) & 0xFu; }
#define XB_SPIN(cond, bar) do { unsigned _sp = 0; while (cond) { __builtin_amdgcn_s_sleep(1); \
    if ((++_sp & 255u) == 0u) { if (xb_ld(&(bar)[XB_TMO])) break; if (_sp > XB_SPIN_CAP) { atomicAdd(&(bar)[XB_TMO], 1u); break; } } } } while (0)
struct XcdBarrier { unsigned* bar; unsigned x; volatile LAS unsigned* st; };
__device__ __forceinline__ XcdBarrier xcd_barrier_post(unsigned* bar, volatile LAS unsigned* st) {
    XcdBarrier b; b.bar = bar; b.x = xb_xcc_id(); b.st = st;
    if (threadIdx.x == 0) (void)xb_add(&bar[XB_XCNT(b.x)], 1u);
    return b;
}
__device__ __forceinline__ void xcd_barrier_complete(unsigned* bar, unsigned x, unsigned& nloc, unsigned& nx) {
    const unsigned G = gridDim.x * gridDim.y * gridDim.z;
    unsigned sum, cnt, mine, sp = 0u;
    for (;;) {
        sum = 0u; cnt = 0u; mine = 0u;
#pragma unroll
        for (unsigned j = 0; j < 16; ++j) { const unsigned c = xb_ld(&bar[XB_XCNT(j)]); sum += c; cnt += (c > 0u) ? 1u : 0u; mine = (j == x) ? c : mine; }
        if (sum == G) break;
        __builtin_amdgcn_s_sleep(1);
        if ((++sp & 255u) == 0u) { if (xb_ld(&bar[XB_TMO])) break; if (sp > XB_SPIN_CAP) { atomicAdd(&bar[XB_TMO], 1u); break; } }
    }
    nloc = mine > 0u ? mine : 1u; nx = cnt > 0u ? cnt : 1u;
}
__device__ __forceinline__ void xcd_barrier(const XcdBarrier& b) {
    asm volatile("s_waitcnt vmcnt(0)" ::: "memory");
    __syncthreads();
    if (threadIdx.x == 0) {
        unsigned* bar = b.bar;
        __builtin_amdgcn_s_waitcnt(0);
        unsigned nloc = b.st[0], nx = b.st[1];
        if (nloc == 0u) { xcd_barrier_complete(bar, b.x, nloc, nx); b.st[0] = nloc; b.st[1] = nx; }
        const unsigned old = xb_add(&bar[XB_XSUB(b.x)], 1u);
        const unsigned gen = old / nloc;
        if (old + 1u == (gen + 1u) * nloc) {
            __builtin_amdgcn_fence(__ATOMIC_RELEASE, "agent");
            asm volatile("s_waitcnt vmcnt(0)" ::: "memory");
            const unsigned og = xb_add(&bar[XB_TOP], 1u);
            const unsigned tg = og / nx;
            if (og + 1u == (tg + 1u) * nx) xb_add(&bar[XB_TOPGEN], 1u);
            else XB_SPIN(xb_ld(&bar[XB_TOPGEN]) == tg, bar);
            __builtin_amdgcn_fence(__ATOMIC_ACQUIRE, "agent");
            xb_add(&bar[XB_XGEN(b.x)], 1u);
            asm volatile("s_waitcnt vmcnt(0)" ::: "memory");
        } else {
            XB_SPIN(xb_ld(&bar[XB_XGEN(b.x)]) == gen, bar);
            __builtin_amdgcn_fence(__ATOMIC_ACQUIRE, "agent");
            asm volatile("s_waitcnt vmcnt(0)" ::: "memory");
        }
    }
    __syncthreads();
}

struct Args { const float* in[19]; float* out; unsigned char* ws; int ph_lo, ph_hi; };
struct Frame {
    LAS unsigned char* lds;
    int tid, lane, wave, G, bid;
};

template <int MAP>
__device__ __forceinline__ void p0_transpose_item(const float* W, int K, int ldw, int nblk, bf16* WT, int row_off, LAS float* scr, int item, int lane) {
    const int kb = item / nblk, nb = item % nblk, k0 = 64 * kb, n0 = 32 * nb;
    const int nd = n0 + (lane & 31);
    int sc = nd;
    if (MAP == 1) { if (nd < 1280) sc = nd; else if (nd < 1792) sc = nd + 24; else if (nd < 1816) sc = nd - 512; else sc = -1; }
#pragma unroll 8
    for (int i = 0; i < 32; ++i) { const int kk = 2 * i + (lane >> 5); scr[kk * 33 + (lane & 31)] = (sc >= 0) ? W[(size_t)(k0 + kk) * ldw + sc] : 0.f; }
    LDS_WAIT(); asm volatile("" ::: "memory");
    const int c = lane & 7;
#pragma unroll
    for (int j = 0; j < 4; ++j) { const int n = (lane >> 3) + 8 * j; const LAS float* s = scr + (8 * c) * 33 + n;
        v4u o; o.x = pk2(s[0 * 33], s[1 * 33]); o.y = pk2(s[2 * 33], s[3 * 33]); o.z = pk2(s[4 * 33], s[5 * 33]); o.w = pk2(s[6 * 33], s[7 * 33]);
        *(v4u*)(WT + (size_t)(row_off + n0 + n) * K + k0 + 8 * c) = o; }
    LDS_WAIT(); asm volatile("" ::: "memory");
}
__device__ __forceinline__ void rms_row_to_bf16(const float* xrow, const float* g, bf16* orow, int lane) {
    const f32x4* xr = (const f32x4*)xrow + lane; const f32x4* gr = (const f32x4*)g + lane;
    f32x4 v[4]; float s = 0.f;
#pragma unroll
    for (int j = 0; j < 4; ++j) { v[j] = xr[64 * j]; s += (v[j].x * v[j].x + v[j].y * v[j].y) + (v[j].z * v[j].z + v[j].w * v[j].w); }
    const float rstd = 1.0f / sqrtf(wave_sum(s) * (1.f / DM) + 1e-6f);
    unsigned long long* o8 = (unsigned long long*)orow + lane;
#pragma unroll
    for (int j = 0; j < 4; ++j) { const f32x4 gg = gr[64 * j];
        o8[64 * j] = (unsigned long long)pk2(v[j].x * rstd * gg.x, v[j].y * rstd * gg.y) | ((unsigned long long)pk2(v[j].z * rstd * gg.z, v[j].w * rstd * gg.w) << 32); }
}

__device__ __forceinline__ void p0_prologue(const Frame& F, const Args& A) {
    LAS float* scr = (LAS float*)(F.lds + F.wave * 16384);
    const int gw = F.bid * NWAVES + F.wave, NGW = F.G * NWAVES;
    constexpr int I_IN = (DM / 64) * (PW / 32), I_OUT = (DM / 64) * (DM / 32), I_UP = (DM / 64) * (DFF / 32), I_DN = (DFF / 64) * (DM / 32), I_W1 = (4096 / 64) * (128 / 32);
    constexpr int NITEMS = I_IN + I_OUT + I_UP + I_DN + 2 * I_W1;
    for (int it = gw; it < NITEMS; it += NGW) {
        int r = it;
        if (r < I_IN) { p0_transpose_item<1>(A.in[8], DM, 1816, PW / 32, ((bf16*)(A.ws + WS_WIN)), 0, scr, r, F.lane); continue; } r -= I_IN;
        if (r < I_OUT) { p0_transpose_item<0>(A.in[14], DM, DM, DM / 32, ((bf16*)(A.ws + WS_WOUT)), 0, scr, r, F.lane); continue; } r -= I_OUT;
        if (r < I_UP) { p0_transpose_item<0>(A.in[16], DM, DFF, DFF / 32, ((bf16*)(A.ws + WS_WUP)), 0, scr, r, F.lane); continue; } r -= I_UP;
        if (r < I_DN) { p0_transpose_item<0>(A.in[17], DFF, DM, DM / 32, ((bf16*)(A.ws + WS_WDN)), 0, scr, r, F.lane); continue; } r -= I_DN;
        if (r < I_W1) { p0_transpose_item<0>(A.in[10], 4096, 128, 4, ((bf16*)(A.ws + WS_W1S)), 0, scr, r, F.lane); continue; } r -= I_W1;
        p0_transpose_item<0>(A.in[10] + (size_t)4096 * 128, 4096, 128, 4, ((bf16*)(A.ws + WS_W1S)), 128, scr, r, F.lane);
    }
    for (int m = gw; m < MTOK; m += NGW) {
        const float* xr = m < NPR ? A.in[0] + (size_t)m * DM : A.in[1] + (size_t)(m - NPR) * DM;
        rms_row_to_bf16(xr, A.in[7], ((bf16*)(A.ws + WS_XN)) + (size_t)m * DM, F.lane);
    }
}

__device__ __forceinline__ void p2_copies(const Frame& F, const Args& A) {
    const size_t gt = (size_t)F.bid * NTHR + F.tid, NT = (size_t)F.G * NTHR;
    const f32x4* P4 = (const f32x4*)((float*)(A.ws + WS_PROJ));
    f32x4* O4 = (f32x4*)A.out;
    for (size_t i = gt; i < (size_t)NPR * 64; i += NT) { const size_t r = i >> 6, c = i & 63;
        O4[O_PCMP / 4 + i] = P4[r * 512 + C_KC / 4 + c]; O4[O_PSLC / 4 + i] = P4[r * 512 + C_KS / 4 + c]; }
    for (size_t i = gt; i < (size_t)4 * 512 * 64; i += NT) { const size_t c = i & 63, r = (i >> 6) & 511, b = i >> 15;
        O4[O_PWIN / 4 + i] = P4[(b * SEQ + SEQ - 512 + r) * 512 + C_KW / 4 + c]; }
    for (size_t i = gt; i < (size_t)4 * 15 * 128; i += NT) { const size_t c = i & 127, r = (i >> 7) % 15, b = (i >> 7) / 15;
        O4[O_PPOOL / 4 + i] = P4[(b * SEQ + SEQ - 15 + r) * 512 + C_U / 4 + c]; }
    for (size_t i = gt; i < (size_t)NSM * 64; i += NT) { const size_t r = i >> 6, c = i & 63;
        O4[O_SCMP / 4 + i] = P4[(NPR + r) * 512 + C_KC / 4 + c]; O4[O_SSLC / 4 + i] = P4[(NPR + r) * 512 + C_KS / 4 + c]; }
    const f32x4* SW4 = (const f32x4*)A.in[4];
    for (size_t i = gt; i < (size_t)32 * 512 * 64; i += NT) { const size_t c = i & 63, r = (i >> 6) & 511, b = i >> 15;
        O4[O_SWIN / 4 + i] = (r < 504) ? SW4[(b * 512 + r + 8) * 64 + c] : P4[(NPR + b * 8 + (r - 504)) * 512 + C_KW / 4 + c]; }
    const f32x4* SP4 = (const f32x4*)A.in[5];
    for (size_t i = gt; i < (size_t)32 * 15 * 128; i += NT) { const size_t c = i & 127, r = (i >> 7) % 15, b = (i >> 7) / 15;
        O4[O_SPOOL / 4 + i] = (r < 7) ? SP4[(b * 15 + r + 8) * 128 + c] : P4[(NPR + b * 8 + (r - 7)) * 512 + C_U / 4 + c]; }
}
__device__ __forceinline__ void p2_cmp_gather(const Frame& F, const Args& A) {
    const int gw = F.bid * NWAVES + F.wave, NGW = F.G * NWAVES;
    constexpr int NBLK = 8192 + 256 + 32;
    const int lane = F.lane, gc = lane >> 4, g = gc >> 1, c = gc & 1, d0 = (lane & 15) * 4;
    for (int it = gw; it < NBLK * 64; it += NGW) {
        const int blk = it >> 6, l = it & 63;
        f32x4 v; int rsec;
        if (blk < 8192) { const int b = blk >> 8, n = blk & 255; const int page = ((const int*)A.in[6])[b * NPG + (n >> 1)];
            v = *(const f32x4*)(A.in[2] + ((size_t)page * 128 + (n & 1) * 64 + l) * 256 + lane * 4); rsec = (b * 256 + n) * 2 + g; }
        else if (blk < 8192 + 256) { const int q = blk - 8192, b = q >> 6, n = q & 63;
            v = *(const f32x4*)(((float*)(A.ws + WS_PROJ)) + ((size_t)b * SEQ + n * 64 + l) * PW + C_KC + lane * 4); rsec = CMP_R_PROMPT + (b * 64 + n) * 2 + g; }
        else { const int b = blk - 8192 - 256;
            v = (l < 8) ? *(const f32x4*)(((float*)(A.ws + WS_PROJ)) + ((size_t)NPR + b * 8 + l) * PW + C_KC + lane * 4) : (f32x4){0.f, 0.f, 0.f, 0.f}; rsec = CMP_R_NEW + b * 2 + g; }
        const f32x4 pe = *(const f32x4*)(A.in[9] + (l * 2 + c) * 64 + d0);
        v = v + pe;
        v2u o; o.x = pk2(v.x, v.y); o.y = pk2(v.z, v.w);
        *(v2u*)(((bf16*)(A.ws + WS_ACMP)) + ((size_t)c * CMP_SEC + rsec) * 4096 + l * 64 + d0) = o;
    }
}
__device__ __forceinline__ void p2_pool(const Frame& F, const Args& A) {
    LAS float* wl = (LAS float*)F.lds;
    LAS float* dl = (LAS float*)(F.lds + 65536 + F.wave * 2048);
    constexpr int NCH = MTOK / 32;
    const int lane = F.lane;
    for (int unit = F.bid; unit < 4 * NCH; unit += F.G) {
        const int gi = unit / NCH, ch = unit % NCH, w = 2 << gi;
        __syncthreads();
        for (int i = F.tid; i < 128 * 128 / 4; i += NTHR) ((LAS f32x4*)wl)[i] = ((const f32x4*)(A.in[12] + (size_t)gi * 16384))[i];
        const int tok0 = ch * 32 + F.wave * 4;
#pragma unroll
        for (int tk = 0; tk < 4; ++tk) {
            const int row = tok0 + tk;
#pragma unroll
            for (int hh = 0; hh < 2; ++hh) {
                const int cc = gi * 128 + lane + 64 * hh;
                float own, sum = 0.f, cnt;
                if (row < NPR) { const int t = row & (SEQ - 1);
                    own = ((float*)(A.ws + WS_PROJ))[(size_t)row * PW + C_U + cc];
                    for (int j = 0; j < w; ++j) if (t - j >= 0) sum += ((float*)(A.ws + WS_PROJ))[(size_t)(row - j) * PW + C_U + cc];
                    cnt = (float)((t + 1 < w) ? t + 1 : w);
                } else { const int q = row - NPR, b = q >> 3, i = q & 7;
                    own = ((float*)(A.ws + WS_PROJ))[(size_t)row * PW + C_U + cc];
                    for (int j = 0; j < w; ++j) { const int idx = 15 + i - j;
                        sum += (idx >= 15) ? ((float*)(A.ws + WS_PROJ))[(size_t)(NPR + b * 8 + idx - 15) * PW + C_U + cc] : A.in[5][((size_t)b * 15 + idx) * 512 + cc]; }
                    cnt = (float)w;
                }
                dl[(lane + 64 * hh) * 4 + tk] = sum / cnt - own;
            }
        }
        __syncthreads();
        float acc[4][2];
#pragma unroll
        for (int tk = 0; tk < 4; ++tk) { acc[tk][0] = 0.f; acc[tk][1] = 0.f; }
#pragma unroll 4
        for (int c = 0; c < 128; ++c) {
            const f32x4 dv = *(const LAS f32x4*)(dl + c * 4);
            const float w0 = wl[c * 128 + lane], w1 = wl[c * 128 + lane + 64];
            acc[0][0] += dv.x * w0; acc[0][1] += dv.x * w1; acc[1][0] += dv.y * w0; acc[1][1] += dv.y * w1;
            acc[2][0] += dv.z * w0; acc[2][1] += dv.z * w1; acc[3][0] += dv.w * w0; acc[3][1] += dv.w * w1;
        }
        const float s0 = A.in[13][gi * 128 + lane], s1 = A.in[13][gi * 128 + lane + 64];
#pragma unroll
        for (int tk = 0; tk < 4; ++tk) { bf16* o = ((bf16*)(A.ws + WS_MIX)) + (size_t)(tok0 + tk) * DM + 512 + gi * 128;
            o[lane] = (bf16)f2bf(acc[tk][0] * s0); o[lane + 64] = (bf16)f2bf(acc[tk][1] * s1); }
    }
    __syncthreads();
}

__device__ __forceinline__ void p4_cmp_w2(const Frame& F, const Args& A) {
    LAS float* w2l = (LAS float*)F.lds;
    LAS float* hl = (LAS float*)(F.lds + 65536 + F.wave * 512);
    for (int i = F.tid; i < 2 * 128 * 64 / 4; i += NTHR) ((LAS f32x4*)w2l)[i] = ((const f32x4*)A.in[11])[i];
    __syncthreads();
    const int gw = F.bid * NWAVES + F.wave, NGW = F.G * NWAVES, lane = F.lane;
    for (int it = gw; it < 2 * CMP_R_END; it += NGW) {
        const int c = it / CMP_R_END, r = it % CMP_R_END;
        const float* hrow = ((float*)(A.ws + WS_HID)) + ((size_t)c * CMP_SEC + r) * 128;
        hl[lane] = hrow[lane]; hl[lane + 64] = hrow[lane + 64];
        LDS_WAIT(); asm volatile("" ::: "memory");
        float a = 0.f;
#pragma unroll 8
        for (int h = 0; h < 128; ++h) a += hl[h] * w2l[(c * 128 + h) * 64 + lane];
        float* dst;
        if (r < CMP_R_PROMPT) { const int b = r >> 9, n = (r & 511) >> 1, g = r & 1; dst = ((float*)(A.ws + WS_COMPS)) + ((((size_t)b * NBS + n) * 2 + g) * 2 + c) * 64; }
        else if (r < CMP_R_NEW) { const int q = r - CMP_R_PROMPT, b = q >> 7, n = (q & 127) >> 1, g = q & 1; dst = ((float*)(A.ws + WS_COMPP)) + ((((size_t)b * NBP + n) * 2 + g) * 2 + c) * 64; }
        else { const int q = r - CMP_R_NEW, b = q >> 1, g = q & 1; dst = ((float*)(A.ws + WS_COMPS)) + ((((size_t)b * NBS + 256) * 2 + g) * 2 + c) * 64; }
        dst[lane] = a;
        LDS_WAIT(); asm volatile("" ::: "memory");
    }
    __syncthreads();
}

constexpr int ATT_WS = 12288;
struct AttCtx { int is_s, b, t, itok, g, qpos, cur, NB, nsel; const float* comp; };
struct KeyRef { const float* k; float dist; bool valid; };
template <int KIND>
__device__ __forceinline__ KeyRef att_key(const Frame& F, const Args& A, const AttCtx& C, const LAS int* sel, int i, int n) {
    KeyRef r; r.k = nullptr; r.dist = 0.f; r.valid = false;
    if (i >= n) return r;
    if (KIND == 0) {
        const int endp = (i + 1) * 64 - 1;
        r.valid = endp <= C.qpos; r.dist = (float)(C.qpos - endp);
        r.k = C.comp + (((size_t)C.b * C.NB + i) * 2 + C.g) * 128;
    } else if (KIND == 1) {
        const int blk = sel[i >> 6], ii = i & 63, kpos = blk * 64 + ii;
        r.valid = kpos <= C.qpos; r.dist = (float)(C.qpos - kpos);
        if (!C.is_s) r.k = ((float*)(A.ws + WS_PROJ)) + ((size_t)C.b * SEQ + kpos) * PW + C_KS + C.g * 128;
        else if (blk < 256) { const int page = ((const int*)A.in[6])[C.b * NPG + (blk >> 1)]; r.k = A.in[3] + ((size_t)page * 128 + (blk & 1) * 64 + ii) * 256 + C.g * 128; }
        else { r.k = ((float*)(A.ws + WS_PROJ)) + ((size_t)NPR + C.b * 8 + (ii & 7)) * PW + C_KS + C.g * 128; if (ii >= 8) r.valid = false; }
    } else {
        if (!C.is_s) { const int ws = C.t - 511 > 0 ? C.t - 511 : 0; const int kpos = ws + i;
            r.valid = true; r.dist = (float)(C.t - kpos); r.k = ((float*)(A.ws + WS_PROJ)) + ((size_t)C.b * SEQ + kpos) * PW + C_KW + C.g * 128; }
        else if (i < 512) { const int kpos = PAST - 512 + i; r.valid = i > C.itok; r.dist = (float)(C.qpos - kpos);
            r.k = A.in[4] + ((size_t)C.b * 512 + i) * 256 + C.g * 128; }
        else { const int ii = i - 512; r.valid = ii <= C.itok; r.dist = (float)(C.itok - ii);
            r.k = ((float*)(A.ws + WS_PROJ)) + ((size_t)NPR + C.b * 8 + ii) * PW + C_KW + C.g * 128; }
    }
    return r;
}
template <int KIND>
__device__ __forceinline__ void att_branch(const Frame& F, const Args& A, const AttCtx& C, int n, const float (&slope)[4], const LAS float* qs, LAS float* pb, LAS unsigned long long* vp, LAS float* sc, const LAS int* sel,
                                           const float (&gt)[4], float (&ot)[4], float (&mo)[4], float (&lo)[4]) {
    const int lane = F.lane;
    float m[4], l[4], o[4];
#pragma unroll
    for (int h = 0; h < 4; ++h) { m[h] = -INFINITY; l[h] = 0.f; o[h] = 0.f; }
    for (int base = 0; base < n; base += 64) {
        const KeyRef kr = att_key<KIND>(F, A, C, sel, base + lane, n);
        float s[4] = {0.f, 0.f, 0.f, 0.f};
        if (kr.valid) {
#pragma unroll 4
            for (int d4 = 0; d4 < 16; ++d4) { const f32x4 kk = *(const f32x4*)(kr.k + d4 * 4);
#pragma unroll
                for (int h = 0; h < 4; ++h) { const f32x4 qq = *(const LAS f32x4*)(qs + h * 64 + d4 * 4); s[h] += (kk.x * qq.x + kk.y * qq.y) + (kk.z * qq.z + kk.w * qq.w); } }
        }
        float p[4], alpha[4];
#pragma unroll
        for (int h = 0; h < 4; ++h) {
            const float sv = kr.valid ? s[h] * 0.125f - slope[h] * kr.dist : -INFINITY;
            if (KIND == 0) { if (base + lane < n) sc[h * 320 + base + lane] = sv; }
            const float cm = wave_max(sv), mn = fmaxf(m[h], cm);
            alpha[h] = (mn == -INFINITY) ? 1.f : __expf(m[h] - mn);
            p[h] = (kr.valid && mn != -INFINITY) ? __expf(sv - mn) : 0.f;
            l[h] = l[h] * alpha[h] + wave_sum(p[h]);
            m[h] = mn; o[h] *= alpha[h];
        }
        *(LAS f32x4*)(pb + lane * 4) = (f32x4){p[0], p[1], p[2], p[3]};
        vp[lane] = (unsigned long long)(kr.k + 64);
        LDS_WAIT(); asm volatile("" ::: "memory");
        const int cnt = (n - base) < 64 ? (n - base) : 64;
#pragma unroll 2
        for (int k = 0; k < cnt; ++k) {
            const f32x4 p4 = *(const LAS f32x4*)(pb + k * 4);
            if ((p4.x + p4.y) + (p4.z + p4.w) != 0.f) {
                const float v = ((const float*)vp[k])[lane];
                o[0] += p4.x * v; o[1] += p4.y * v; o[2] += p4.z * v; o[3] += p4.w * v;
            }
        }
        LDS_WAIT(); asm volatile("" ::: "memory");
    }
#pragma unroll
    for (int h = 0; h < 4; ++h) { ot[h] += gt[h] * o[h] / fmaxf(l[h], 1e-30f); mo[h] = m[h]; lo[h] = l[h]; }
}
__device__ __forceinline__ void p5_attn_simple(const Frame& F, const Args& A) {
    LAS unsigned char* wb = F.lds + F.wave * ATT_WS;
    LAS float* qs = (LAS float*)wb;
    LAS float* pb = (LAS float*)(wb + 1024);
    LAS unsigned long long* vp = (LAS unsigned long long*)(wb + 2048);
    LAS float* sc = (LAS float*)(wb + 2560);
    LAS float* score = (LAS float*)(wb + 2560 + 5120);
    LAS int* sel = (LAS int*)(wb + 2560 + 5120 + 1280);
    const int gw = F.bid * NWAVES + F.wave, NGW = F.G * NWAVES, lane = F.lane;
    for (int job = gw; job < MTOK * 2; job += NGW) {
        const int row = job >> 1, g = job & 1;
        AttCtx C; C.g = g;
        if (row < NPR) { C.is_s = 0; C.b = row >> 12; C.t = row & (SEQ - 1); C.itok = 0; C.qpos = C.t; C.NB = NBP; C.comp = ((float*)(A.ws + WS_COMPP)); }
        else { const int q = row - NPR; C.is_s = 1; C.b = q >> 3; C.itok = q & 7; C.t = 0; C.qpos = PAST + C.itok; C.NB = NBS; C.comp = ((float*)(A.ws + WS_COMPS)); }
        C.cur = C.qpos >> 6; C.nsel = 0;
        const float* prow = ((float*)(A.ws + WS_PROJ)) + (size_t)row * PW;
        *(LAS f32x4*)(qs + lane * 4) = *(const f32x4*)(prow + C_Q + g * 256 + lane * 4);
        float slope[4], gate[3][4];
#pragma unroll
        for (int h = 0; h < 4; ++h) { slope[h] = exp2f(-(float)(g * 4 + h + 1));
#pragma unroll
            for (int br = 0; br < 3; ++br) { const float x = prow[C_G + br * 8 + g * 4 + h]; gate[br][h] = 1.0f / (1.0f + __expf(-x)); } }
        LDS_WAIT(); asm volatile("" ::: "memory");
        float ot[4] = {0.f, 0.f, 0.f, 0.f}, mc[4], lc[4], md[4], ld[4];
        att_branch<0>(F, A, C, C.NB, slope, qs, pb, vp, sc, sel, gate[0], ot, mc, lc);
        for (int n = lane; n < C.NB; n += 64) {
            float imp = 0.f;
#pragma unroll
            for (int h = 0; h < 4; ++h) { const float sv = sc[h * 320 + n]; imp += (sv != -INFINITY) ? __expf(sv - mc[h]) / fmaxf(lc[h], 1e-30f) : 0.f; }
            float s = imp;
            if (n == 0 || n == C.cur || n == C.cur - 1) s = 5.0f;
            if (n > C.cur) s = -1.0f;
            score[n] = s;
        }
        LDS_WAIT(); asm volatile("" ::: "memory");
        int nsel = 0;
        for (int cb = 0; cb < C.NB; cb += 64) {
            const int n = cb + lane; const bool cand = n < C.NB && n <= C.cur;
            const float sn = cand ? score[n] : -2.f;
            int cnt = 0;
#pragma unroll 4
            for (int mm = 0; mm < C.NB; ++mm) { const float sm = score[mm]; cnt += (sm > sn || (sm == sn && mm < n)) ? 1 : 0; }
            const bool pick = cand && cnt < 16;
            const unsigned long long bal = __ballot(pick);
            if (pick) sel[nsel + __popcll(bal & ((1ull << lane) - 1ull))] = n;
            nsel += __popcll(bal);
        }
        LDS_WAIT(); asm volatile("" ::: "memory");
        C.nsel = nsel;
        att_branch<1>(F, A, C, nsel * 64, slope, qs, pb, vp, sc, sel, gate[1], ot, md, ld);
        const int nwin = C.is_s ? 520 : (C.t < 511 ? C.t + 1 : 512);
        att_branch<2>(F, A, C, nwin, slope, qs, pb, vp, sc, sel, gate[2], ot, md, ld);
        bf16* orow = ((bf16*)(A.ws + WS_MIX)) + (size_t)row * DM + g * 256;
#pragma unroll
        for (int h = 0; h < 4; ++h) orow[h * 64 + lane] = (bf16)f2bf(ot[h]);
    }
}

__device__ __forceinline__ void p7_hb(const Frame& F, const Args& A) {
    const int gw = F.bid * NWAVES + F.wave, NGW = F.G * NWAVES;
    for (int m = gw; m < MTOK; m += NGW) rms_row_to_bf16(((float*)(A.ws + WS_H)) + (size_t)m * DM, A.in[15], ((bf16*)(A.ws + WS_HB)) + (size_t)m * DM, F.lane);
}
__device__ __forceinline__ void p10_final(const Frame& F, const Args& A) {
    const int gw = F.bid * NWAVES + F.wave, NGW = F.G * NWAVES, lane = F.lane;
    for (int m = gw; m < MTOK; m += NGW) {
        f32x4* xr = (f32x4*)(A.out + (size_t)m * DM) + lane; const f32x4* gr = (const f32x4*)A.in[18] + lane;
        f32x4 v[4]; float s = 0.f;
#pragma unroll
        for (int j = 0; j < 4; ++j) { v[j] = xr[64 * j]; s += (v[j].x * v[j].x + v[j].y * v[j].y) + (v[j].z * v[j].z + v[j].w * v[j].w); }
        const float rstd = 1.0f / sqrtf(wave_sum(s) * (1.f / DM) + 1e-6f);
#pragma unroll
        for (int j = 0; j < 4; ++j) xr[64 * j] = v[j] * rstd * gr[64 * j];
    }
}

__global__ void __launch_bounds__(NTHR, 2) fwd_kernel(Args A) {
    extern __shared__ __attribute__((aligned(16))) unsigned char lds_raw[];
    Frame F;
    F.lds = (LAS unsigned char*)lds_raw;
    F.tid = threadIdx.x; F.lane = F.tid & 63; F.wave = __builtin_amdgcn_readfirstlane(F.tid >> 6); F.G = gridDim.x; F.bid = blockIdx.x;
    unsigned char* ws = A.ws;
    for (int u = F.tid; u < (LDS_BYTES - LDSCTL_OFF) / 4; u += NTHR) ((LAS unsigned*)(F.lds + LDSCTL_OFF))[u] = 0u;
    __syncthreads();
    const int lo = A.ph_lo, hi = A.ph_hi;
    const bool multi = (hi - lo) > 1;
    XcdBarrier bar; bar.bar = (unsigned*)(ws + WS_CTL) + CW_BAR; bar.x = 0; bar.st = nullptr;
    if (multi) bar = xcd_barrier_post((unsigned*)(ws + WS_CTL) + CW_BAR, (volatile LAS unsigned*)(F.lds + MISC_OFF));
#define IN(k) (lo <= (k) && (k) < hi)
#define SEAM(k) do { if (IN(k) && IN((k) + 1)) xcd_barrier(bar); } while (0)

    if (IN(0)) { p0_prologue(F, A); } SEAM(0);
    if (IN(1)) {
        pg8::Gemm g{((bf16*)(A.ws + WS_XN)), ((bf16*)(A.ws + WS_WIN)), MTOK, PW, DM}; pg8::StaticOrder S; S.init(MTOK, PW, F.G, F.bid);
        pg8::EpiF32 E{((float*)(A.ws + WS_PROJ)), PW};
        pg8::gemm_phase<pg8::EpiF32, pg8::StaticOrder>(F.lds, g, S, E, nullptr);
    } SEAM(1);
    if (IN(2)) { p2_copies(F, A); p2_cmp_gather(F, A); p2_pool(F, A); } SEAM(2);
    if (IN(3)) {
        pg8::Gemm g{((bf16*)(A.ws + WS_ACMP)), ((bf16*)(A.ws + WS_W1S)), CMP_ROWS, 256, 4096}; pg8::StaticOrder S; S.init(CMP_ROWS, 256, F.G, F.bid);
        pg8::EpiCmpHid E{((float*)(A.ws + WS_HID)), CMP_SEC / 256};
        pg8::gemm_phase<pg8::EpiCmpHid, pg8::StaticOrder>(F.lds, g, S, E, nullptr);
    } SEAM(3);
    if (IN(4)) { p4_cmp_w2(F, A); } SEAM(4);
    if (IN(5)) { p5_attn_simple(F, A); } SEAM(5);
    if (IN(6)) {
        pg8::Gemm g{((bf16*)(A.ws + WS_MIX)), ((bf16*)(A.ws + WS_WOUT)), MTOK, DM, DM}; pg8::StaticOrder S; S.init(MTOK, DM, F.G, F.bid);
        pg8::EpiResF32 E{A.in[0], A.in[1], NPR / 256, ((float*)(A.ws + WS_H)), DM};
        pg8::gemm_phase<pg8::EpiResF32, pg8::StaticOrder>(F.lds, g, S, E, nullptr);
    } SEAM(6);
    if (IN(7)) { p7_hb(F, A); } SEAM(7);
    if (IN(8)) {
        pg8::Gemm g{((bf16*)(A.ws + WS_HB)), ((bf16*)(A.ws + WS_WUP)), MTOK, DFF, DM}; pg8::StaticOrder S; S.init(MTOK, DFF, F.G, F.bid);
        pg8::EpiRelu2Bf16 E{((bf16*)(A.ws + WS_ACT)), DFF};
        pg8::gemm_phase<pg8::EpiRelu2Bf16, pg8::StaticOrder>(F.lds, g, S, E, nullptr);
    } SEAM(8);
    if (IN(9)) {
        pg8::Gemm g{((bf16*)(A.ws + WS_ACT)), ((bf16*)(A.ws + WS_WDN)), MTOK, DM, DFF}; pg8::StaticOrder S; S.init(MTOK, DM, F.G, F.bid);
        pg8::EpiResF32 E{((float*)(A.ws + WS_H)), ((float*)(A.ws + WS_H)), 1 << 20, A.out, DM};
        pg8::gemm_phase<pg8::EpiResF32, pg8::StaticOrder>(F.lds, g, S, E, nullptr);
    } SEAM(9);
    if (IN(10)) { p10_final(F, A); }
#undef IN
#undef SEAM
}

#ifndef MK_ONE_LAUNCH
#define MK_ONE_LAUNCH 1
#endif
extern "C" void kernel_launch(void* const* d_in, const int* in_sizes, int n_in, void* d_out, int out_size, void* d_ws, size_t ws_size, hipStream_t stream) {
    static int grid = 0;
    if (grid == 0) {
        if (n_in != 19 || (size_t)out_size != O_END || ws_size < WS_END) { fprintf(stderr, "kernel_launch: unexpected shapes n_in %d out %d ws %zu\n", n_in, out_size, ws_size); grid = -1; return; }
        int dev = 0, cus = 0, per_cu = 0;
        if (hipGetDevice(&dev) != hipSuccess || hipDeviceGetAttribute(&cus, hipDeviceAttributeMultiprocessorCount, dev) != hipSuccess) { grid = -1; return; }
        if (hipFuncSetAttribute((const void*)fwd_kernel, hipFuncAttributeMaxDynamicSharedMemorySize, LDS_BYTES) != hipSuccess) { fprintf(stderr, "kernel_launch: hipFuncSetAttribute failed\n"); grid = -1; return; }
        if (hipOccupancyMaxActiveBlocksPerMultiprocessor(&per_cu, (const void*)fwd_kernel, NTHR, LDS_BYTES) != hipSuccess || per_cu < 1) fprintf(stderr, "kernel_launch: occupancy query says %d\n", per_cu);
        (void)hipGetLastError();
        grid = cus;
    }
    if (grid < 0) return;
    if (hipMemsetAsync((char*)d_ws + WS_CTL, 0, CTL_ZERO_BYTES, stream) != hipSuccess) return;
    Args a{};
    for (int i = 0; i < 19; ++i) a.in[i] = (const float*)d_in[i];
    a.out = (float*)d_out; a.ws = (unsigned char*)d_ws;
#if MK_ONE_LAUNCH
    a.ph_lo = 0; a.ph_hi = NPHASES;
    hipLaunchKernelGGL(fwd_kernel, dim3(grid), dim3(NTHR), LDS_BYTES, stream, a);
#else
    for (int p = 0; p < NPHASES; ++p) { a.ph_lo = p; a.ph_hi = p + 1; hipLaunchKernelGGL(fwd_kernel, dim3(grid), dim3(NTHR), LDS_BYTES, stream, a); }
#endif
}
```

```cpp
#include <hip/hip_runtime.h>
#include <cstdio>
#include <cstdint>
namespace pg8 {
#define PG8_LAS __attribute__((address_space(3)))
typedef unsigned short bf16_t;
typedef short bf16x8 __attribute__((ext_vector_type(8)));
typedef float f32x4 __attribute__((ext_vector_type(4)));
typedef unsigned u32x4 __attribute__((ext_vector_type(4)));
constexpr int BM = 256, BK = 64, HALF = 128, HTB = HALF * BK * 2  , STAGE_BYTES = 8 * HTB, NXCD = 8, WGM = 8;

__host__ __device__ __forceinline__ int lds_byte(int r, int c) { const int st = (r >> 4) * 2 + (c >> 5), rr = r & 15, cc = c & 31, ob = rr * 64 + cc * 2; return st * 1024 + (ob ^ (((ob >> 9) & 1) << 5)); }
__host__ __device__ __forceinline__ void stage_rc(int b, int& R, int& C) { const int st = b / 1024, sb = b % 1024, swz = sb ^ (((sb >> 9) & 1) << 5); R = (st >> 1) * 16 + swz / 64; C = (st & 1) * 32 + (swz % 64) / 2; }
__host__ __device__ __forceinline__ int perm32(int rho) { const int n = rho >> 4, i = rho & 15; return 8 * (i >> 2) + 4 * n + (i & 3); }

struct Unit { int pm, pn; };
struct Gemm { const bf16_t* A; const bf16_t* Bt; int M, N, K; };

struct StaticOrder {
    int nM, nN, nwg, G, c;
    __host__ __device__ void init(int M, int N, int G_, int c_) { nM = M / BM; nN = N / BM; nwg = nM * nN; G = G_; c = c_; }
    __host__ __device__ bool next(int i, Unit& u) const {
        const long L = (long)i * G + c; if (L >= nwg) return false;
        int wgid = (int)L; { const int q = nwg / NXCD, r = nwg % NXCD, xcd = wgid % NXCD, off = wgid / NXCD; wgid = (xcd < r ? xcd * (q + 1) : r * (q + 1) + (xcd - r) * q) + off; }
        const int nig = WGM * nN, gid = wgid / nig, fm = gid * WGM, gsz = (nM - fm) < WGM ? (nM - fm) : WGM;
        u.pm = fm + ((wgid % nig) % gsz); u.pn = (wgid % nig) / gsz; return true;
    }
    __device__ __forceinline__ void a_ready(const Unit&) const {}
    __device__ __forceinline__ void done(const Unit&) const {}
};
struct CountedOrder : StaticOrder {
    const unsigned* ready; unsigned need; unsigned* tmo;
    __device__ __forceinline__ void a_ready(const Unit& u) const {
        if (threadIdx.x < 64) {
            const unsigned long long t0 = __builtin_amdgcn_s_memrealtime(); unsigned polls = 0;
            while ((unsigned)__builtin_amdgcn_readfirstlane(__hip_atomic_load(ready + 64 * u.pm, __ATOMIC_RELAXED, __HIP_MEMORY_SCOPE_AGENT)) < need) {
                if ((++polls & 255u) == 0u && __builtin_amdgcn_readfirstlane(__hip_atomic_load(tmo, __ATOMIC_RELAXED, __HIP_MEMORY_SCOPE_AGENT)) != 0u) break;
                if (__builtin_amdgcn_s_memrealtime() - t0 > 2000000ull) {
                    if (threadIdx.x == 0) { unsigned expect = 0u; __hip_atomic_compare_exchange_strong(tmo + 1, &expect, 0x600u | (unsigned)(u.pm & 0xff), __ATOMIC_RELAXED, __ATOMIC_RELAXED, __HIP_MEMORY_SCOPE_AGENT); __hip_atomic_store(tmo, 1u, __ATOMIC_RELAXED, __HIP_MEMORY_SCOPE_AGENT); }
                    break; }
                __builtin_amdgcn_s_sleep(2); }
            __builtin_amdgcn_fence(__ATOMIC_ACQUIRE, "agent");
            asm volatile("s_waitcnt vmcnt(0)" ::: "memory");
        }
#if !defined(BROKEN_HOOK_NO_BARRIER)
        asm volatile("" ::: "memory"); __builtin_amdgcn_s_barrier(); asm volatile("" ::: "memory");
#endif
    }
};

__device__ __forceinline__ unsigned cvt_pk_bf16(float lo, float hi) { unsigned r; asm volatile("v_cvt_pk_bf16_f32 %0, %1, %2" : "=v"(r) : "v"(lo), "v"(hi)); return r; }
struct EpiF32 {
    static constexpr bool PERM = false, AFTER_DRAIN = false;
    float* C; int ldc;
    __device__ __forceinline__ void operator()(const f32x4 (&acc)[2][2][4][2], const Unit& u, int wr, int wc, int fr, int fq) const {
        const int row0 = u.pm * BM + wr * 64 + fr, col0 = u.pn * BM + wc * 32 + 4 * fq;
#pragma unroll
        for (int ai = 0; ai < 2; ++ai)
#pragma unroll
            for (int m = 0; m < 4; ++m) { float* rowp = C + (size_t)(row0 + ai * HALF + m * 16) * ldc + col0;
#pragma unroll
                for (int bj = 0; bj < 2; ++bj)
#pragma unroll
                    for (int n = 0; n < 2; ++n) *(f32x4*)(rowp + bj * HALF + n * 16) = acc[ai][bj][m][n]; }
    }
};
struct EpiResF32 {
    static constexpr bool PERM = false, AFTER_DRAIN = false;
    const float* base0; const float* base1; int split; float* out; int ldc;
    __device__ __forceinline__ void operator()(const f32x4 (&acc)[2][2][4][2], const Unit& u, int wr, int wc, int fr, int fq) const {
        const int row0 = u.pm * BM + wr * 64 + fr, col0 = u.pn * BM + wc * 32 + 4 * fq;
        const float* bb = (u.pm < split) ? base0 : (base1 - (size_t)split * BM * ldc);
#pragma unroll
        for (int ai = 0; ai < 2; ++ai)
#pragma unroll
            for (int m = 0; m < 4; ++m) { const size_t off = (size_t)(row0 + ai * HALF + m * 16) * ldc + col0;
#pragma unroll
                for (int bj = 0; bj < 2; ++bj)
#pragma unroll
                    for (int n = 0; n < 2; ++n) { const f32x4 b = *(const f32x4*)(bb + off + bj * HALF + n * 16); *(f32x4*)(out + off + bj * HALF + n * 16) = acc[ai][bj][m][n] + b; } }
    }
};
struct EpiRelu2Bf16 {
    static constexpr bool PERM = true, AFTER_DRAIN = false;
    bf16_t* O; int ldc;
    __device__ __forceinline__ void operator()(const f32x4 (&acc)[2][2][4][2], const Unit& u, int wr, int wc, int fr, int fq) const {
        const int row0 = u.pm * BM + wr * 64 + fr, col0 = u.pn * BM + wc * 32 + 8 * fq;
#pragma unroll
        for (int ai = 0; ai < 2; ++ai)
#pragma unroll
            for (int m = 0; m < 4; ++m) { bf16_t* rowp = O + (size_t)(row0 + ai * HALF + m * 16) * ldc + col0;
#pragma unroll
                for (int bj = 0; bj < 2; ++bj) { f32x4 v0 = acc[ai][bj][m][0], v1 = acc[ai][bj][m][1];
#pragma unroll
                    for (int j = 0; j < 4; ++j) { const float a = fmaxf(v0[j], 0.f), b = fmaxf(v1[j], 0.f); v0[j] = a * a; v1[j] = b * b; }
                    u32x4 w; w.x = cvt_pk_bf16(v0[0], v0[1]); w.y = cvt_pk_bf16(v0[2], v0[3]); w.z = cvt_pk_bf16(v1[0], v1[1]); w.w = cvt_pk_bf16(v1[2], v1[3]);
                    *(u32x4*)(rowp + bj * HALF) = w; } }
    }
};
__device__ __forceinline__ float gelu_tanh(float x) {
    const float y = 0.7978845608028654f * (x + 0.044715f * x * x * x);
    const float t = 1.0f - 2.0f / (__expf(2.0f * y) + 1.0f);
    return 0.5f * x * (1.0f + t);
}
struct EpiCmpHid {
    static constexpr bool PERM = false, AFTER_DRAIN = false;
    float* H; int csplit;
    __device__ __forceinline__ void operator()(const f32x4 (&acc)[2][2][4][2], const Unit& u, int wr, int wc, int fr, int fq) const {
        const int row0 = u.pm * BM + wr * 64 + fr, col0 = wc * 32 + 4 * fq;
        const bool c1 = u.pm >= csplit;
#pragma unroll
        for (int ai = 0; ai < 2; ++ai)
#pragma unroll
            for (int m = 0; m < 4; ++m) { float* rowp = H + (size_t)(row0 + ai * HALF + m * 16) * 128 + col0;
#pragma unroll
                for (int n = 0; n < 2; ++n) { f32x4 v = c1 ? acc[ai][1][m][n] : acc[ai][0][m][n];
#pragma unroll
                    for (int j = 0; j < 4; ++j) v[j] = gelu_tanh(v[j]);
                    *(f32x4*)(rowp + n * 16) = v; } }
    }
};
template <class Epi, class Sched, bool STAMP = false>
__device__ __forceinline__ void gemm_phase(PG8_LAS unsigned char* lds, const Gemm g, const Sched& S, const Epi& E, unsigned long long* stamps) {
    const int tid = threadIdx.x, wid = __builtin_amdgcn_readfirstlane(tid >> 6), lane = tid & 63, wr = wid >> 2, wc = wid & 3, fr = lane & 15, fq = lane >> 4;
    const int K = g.K, nt = K / BK;
    int ts_lo = 0, ts_hi = 0, nts = 0; const unsigned long long rt_entry = STAMP ? (unsigned long long)wall_clock64() : 0ull;
#define PG8_STAMP() do { if (STAMP && wid == 0 && nts < 64) { const unsigned long long _c = (unsigned long long)clock64(); \
        ts_lo = (lane == nts) ? (int)(unsigned)_c : ts_lo; ts_hi = (lane == nts) ? (int)(unsigned)(_c >> 32) : ts_hi; ++nts; } } while (0)
    PG8_STAMP();
    unsigned voffA[2], voffB[2];
#pragma unroll
    for (int i = 0; i < 2; ++i) { int R, C; stage_rc(tid * 16 + i * 8192, R, C); const int Rb = Epi::PERM ? ((R & ~31) + perm32(R & 31)) : R;
        voffA[i] = (unsigned)(R * K + C) * 2u; voffB[i] = (unsigned)(Rb * K + C) * 2u; }
    const size_t kstep = (size_t)(BK * 2);
    const size_t hstep = (size_t)HALF * K * 2;
    const size_t tstep = 2 * hstep;
    const unsigned ldsw = (unsigned)wid * 1024u;
    const int aoff = lds_byte(wr * 64 + fr, fq * 8), boff = lds_byte(wc * 32 + fr, fq * 8);
#define PG8_SA(b, h) (((b) * 2 + (h)) * HTB)
#define PG8_SB(b, h) ((4 + (b) * 2 + (h)) * HTB)
#define PG8_STAGE(bufoff, gbase, voff) do { _Pragma("unroll") for (int _i = 0; _i < 2; ++_i) \
        __builtin_amdgcn_global_load_lds((const unsigned*)((const char*)(gbase) + (voff)[_i]), (PG8_LAS unsigned*)(lds + (bufoff) + ldsw + _i * 8192), 16, 0, 0); } while (0)
#define PG8_LDA(dst, b, h) do { _Pragma("unroll") for (int m = 0; m < 4; ++m) _Pragma("unroll") for (int k = 0; k < 2; ++k) dst[m][k] = *(const PG8_LAS bf16x8*)(lds + PG8_SA(b, h) + aoff + m * 2048 + k * 1024); } while (0)
#define PG8_LDB(dst, b, h) do { _Pragma("unroll") for (int n = 0; n < 2; ++n) _Pragma("unroll") for (int k = 0; k < 2; ++k) dst[n][k] = *(const PG8_LAS bf16x8*)(lds + PG8_SB(b, h) + boff + n * 2048 + k * 1024); } while (0)
#define PG8_MMA(ai, bj, At, Bt) do { __builtin_amdgcn_s_setprio(1); _Pragma("unroll") for (int m = 0; m < 4; ++m) _Pragma("unroll") for (int n = 0; n < 2; ++n) _Pragma("unroll") for (int k = 0; k < 2; ++k) \
        acc[ai][bj][m][n] = __builtin_amdgcn_mfma_f32_16x16x32_bf16(Bt[n][k], At[m][k], acc[ai][bj][m][n], 0, 0, 0); __builtin_amdgcn_s_setprio(0); } while (0)
#define PG8_WAIT_V(n) asm volatile("s_waitcnt vmcnt(" #n ")" ::: "memory")
#define PG8_WAIT_L(n) asm volatile("s_waitcnt lgkmcnt(" #n ")" ::: "memory")
#define PG8_BAR __builtin_amdgcn_s_barrier()
#define PG8_SCHED __builtin_amdgcn_sched_barrier(0)
    Unit cur, nxt; int ui = 0;
    if (!S.next(0, cur)) return;
    f32x4 acc[2][2][4][2];
#pragma unroll
    for (int a = 0; a < 2; ++a)
#pragma unroll
        for (int b = 0; b < 2; ++b)
#pragma unroll
            for (int m = 0; m < 4; ++m)
#pragma unroll
                for (int n = 0; n < 2; ++n) acc[a][b][m][n] = (f32x4){0.f, 0.f, 0.f, 0.f};
    bf16x8 At[4][2], B0[2][2], B1[2][2];
    const char* cA = (const char*)g.A + (size_t)cur.pm * tstep; const char* cB = (const char*)g.Bt + (size_t)cur.pn * tstep;
    S.a_ready(cur);
    PG8_STAGE(PG8_SB(0, 0), cB, voffB); PG8_STAGE(PG8_SA(0, 0), cA, voffA); PG8_STAGE(PG8_SB(0, 1), cB + hstep, voffB); PG8_STAGE(PG8_SA(0, 1), cA + hstep, voffA);
    if (wr == 1) PG8_BAR;
    PG8_WAIT_V(4); PG8_BAR;
    PG8_STAGE(PG8_SB(1, 0), cB + kstep, voffB); PG8_STAGE(PG8_SA(1, 0), cA + kstep, voffA); PG8_STAGE(PG8_SB(1, 1), cB + hstep + kstep, voffB);
    PG8_WAIT_V(6); PG8_BAR;
    PG8_STAMP();
    for (;;) {
        const bool has_next = S.next(ui + 1, nxt);
        const char* nA = has_next ? (const char*)g.A + (size_t)nxt.pm * tstep : cA; const char* nB = has_next ? (const char*)g.Bt + (size_t)nxt.pn * tstep : cB;
        for (int t = 0; t < nt; t += 2) {
            const bool last = (t == nt - 2);
            const char* a1 = cA + (size_t)(t + 1) * kstep;
            const char* a2 = last ? nA : cA + (size_t)(t + 2) * kstep; const char* b2 = last ? nB : cB + (size_t)(t + 2) * kstep;
            const char* a3 = a2 + kstep; const char* b3 = b2 + kstep;
            if (last && has_next) S.a_ready(nxt);
            PG8_LDB(B0, 0, 0); PG8_SCHED; PG8_LDA(At, 0, 0); PG8_STAGE(PG8_SA(1, 1), a1 + hstep, voffA);
            PG8_WAIT_L(8); PG8_BAR; PG8_WAIT_L(0); PG8_MMA(0, 0, At, B0); PG8_BAR; PG8_SCHED;
            PG8_LDB(B1, 0, 1); PG8_STAGE(PG8_SB(0, 0), b2, voffB);
            PG8_BAR; PG8_WAIT_L(0); PG8_MMA(0, 1, At, B1); PG8_BAR;
            PG8_LDA(At, 0, 1); PG8_STAGE(PG8_SA(0, 0), a2, voffA);
            PG8_BAR; PG8_WAIT_L(0); PG8_MMA(1, 0, At, B0); PG8_BAR; PG8_SCHED;
            PG8_STAGE(PG8_SB(0, 1), b2 + hstep, voffB);
            PG8_WAIT_V(6); PG8_BAR; PG8_MMA(1, 1, At, B1); PG8_BAR;
            PG8_LDB(B0, 1, 0); PG8_SCHED; PG8_LDA(At, 1, 0); PG8_STAGE(PG8_SA(0, 1), a2 + hstep, voffA);
            PG8_WAIT_L(8); PG8_BAR; PG8_WAIT_L(0); PG8_MMA(0, 0, At, B0); PG8_BAR; PG8_SCHED;
            PG8_LDB(B1, 1, 1); PG8_STAGE(PG8_SB(1, 0), b3, voffB);
            PG8_BAR; PG8_WAIT_L(0); PG8_MMA(0, 1, At, B1); PG8_BAR;
            PG8_LDA(At, 1, 1); PG8_STAGE(PG8_SA(1, 0), a3, voffA);
            PG8_BAR; PG8_WAIT_L(0); PG8_MMA(1, 0, At, B0); PG8_BAR; PG8_SCHED;
            PG8_STAGE(PG8_SB(1, 1), b3 + hstep, voffB);
            PG8_WAIT_V(6); PG8_BAR; PG8_MMA(1, 1, At, B1); PG8_BAR;
        }
        PG8_STAMP();
        if constexpr (!Epi::AFTER_DRAIN) { E(acc, cur, wr, wc, fr, fq); S.done(cur); }
        PG8_STAMP();
        if (!has_next) break;
#pragma unroll
        for (int a = 0; a < 2; ++a)
#pragma unroll
            for (int b = 0; b < 2; ++b)
#pragma unroll
                for (int m = 0; m < 4; ++m)
#pragma unroll
                    for (int n = 0; n < 2; ++n) acc[a][b][m][n] = (f32x4){0.f, 0.f, 0.f, 0.f};
        cur = nxt; cA = nA; cB = nB; ++ui;
    }
    PG8_WAIT_V(0);
    if (wr == 0) PG8_BAR;
    PG8_BAR;
    if constexpr (Epi::AFTER_DRAIN) { E.fused(acc, cur, wr, wc, fr, fq, lds, wid, lane); S.done(cur); }
    PG8_STAMP();
    if (STAMP && wid == 0) { stamps[lane] = lane < nts ? (((unsigned long long)(unsigned)ts_hi << 32) | (unsigned)ts_lo) : 0ull;
        if (lane == 62) stamps[62] = rt_entry; if (lane == 63) stamps[63] = (unsigned long long)wall_clock64(); }
#undef PG8_STAMP
#undef PG8_SA
#undef PG8_SB
#undef PG8_STAGE
#undef PG8_LDA
#undef PG8_LDB
#undef PG8_MMA
#undef PG8_WAIT_V
#undef PG8_WAIT_L
#undef PG8_BAR
#undef PG8_SCHED
}
}

constexpr int DM = 1024, NPR = 16384, NSM = 256, MTOK = NPR + NSM, SEQ = 4096, NBP = 64, PAST = 16384, NBS = 257, NPG = 128, DFF = 4096;
constexpr int PW = 2048;
constexpr int C_Q = 0, C_KC = 512, C_KS = 768, C_KW = 1024, C_U = 1280, C_G = 1792;
constexpr int CMP_SEC = 17152, CMP_ROWS = 2 * CMP_SEC;
constexpr int CMP_R_PROMPT = 16384, CMP_R_NEW = 16896, CMP_R_END = 16960;
constexpr size_t O_YP = 0, O_YS = 16777216, O_PCMP = 17039360, O_PSLC = 21233664, O_PWIN = 25427968, O_PPOOL = 25952256,
                 O_SCMP = 25982976, O_SSLC = 26048512, O_SWIN = 26114048, O_SPOOL = 30308352, O_END = 30554112;
constexpr size_t MiB = 1u << 20;
constexpr size_t WS_CTL = 0, CTL_ZERO_BYTES = 1 * MiB;
constexpr size_t WS_WIN = 2 * MiB, WS_WOUT = 6 * MiB, WS_WUP = 8 * MiB, WS_WDN = 16 * MiB, WS_W1S = 24 * MiB;
constexpr size_t WS_XN = 32 * MiB, WS_PROJ = 66 * MiB, WS_ACMP = 200 * MiB, WS_HID = 470 * MiB, WS_COMPS = 490 * MiB, WS_COMPP = 500 * MiB;
constexpr size_t WS_MIX = 502 * MiB, WS_H = 536 * MiB, WS_HB = 602 * MiB, WS_ACT = 636 * MiB, WS_END = 768 * MiB;
static_assert(WS_XN + (size_t)MTOK * DM * 2 <= WS_PROJ && WS_PROJ + (size_t)MTOK * PW * 4 <= WS_ACMP && WS_ACMP + (size_t)CMP_ROWS * 4096 * 2 <= WS_HID, "ws map 1");
static_assert(WS_HID + (size_t)CMP_ROWS * 128 * 4 <= WS_COMPS && WS_COMPS + (size_t)32 * NBS * 256 * 4 <= WS_COMPP && WS_COMPP + (size_t)4 * NBP * 256 * 4 <= WS_MIX, "ws map 2");
static_assert(WS_MIX + (size_t)MTOK * DM * 2 <= WS_H && WS_H + (size_t)MTOK * DM * 4 <= WS_HB && WS_HB + (size_t)MTOK * DM * 2 <= WS_ACT && WS_ACT + (size_t)MTOK * DFF * 2 <= WS_END, "ws map 3");
constexpr int CW_BAR = 4096, CW_QUEUE = 8192;

constexpr int NWAVES = 8, NTHR = NWAVES * 64;
constexpr int RING_BYTES = 131072, LDSCTL_OFF = 143360, MISC_OFF = LDSCTL_OFF + 320, LDS_BYTES = 147456;
constexpr int NPHASES = 11;

#define GAS __attribute__((address_space(1)))
#define LAS __attribute__((address_space(3)))
typedef unsigned short bf16;
typedef unsigned v4u __attribute__((ext_vector_type(4)));
typedef unsigned v2u __attribute__((ext_vector_type(2)));
typedef float f32x4 __attribute__((ext_vector_type(4)));
#define LDS_WAIT() asm volatile("s_waitcnt lgkmcnt(0)" ::: "memory")
__device__ __forceinline__ unsigned f2bf(float f) { unsigned u = __builtin_bit_cast(unsigned, f); return (u + 0x7fffu + ((u >> 16) & 1u)) >> 16; }
__device__ __forceinline__ unsigned pk2(float lo, float hi) { return f2bf(lo) | (f2bf(hi) << 16); }
__device__ __forceinline__ float wave_sum(float v) {
#pragma unroll
    for (int o = 1; o < 64; o <<= 1) v += __shfl_xor(v, o);
    return v;
}
__device__ __forceinline__ float wave_max(float v) {
#pragma unroll
    for (int o = 1; o < 64; o <<= 1) v = fmaxf(v, __shfl_xor(v, o));
    return v;
}

#define XB_TMO      128
#define XB_XCNT(j)  (256  + 64 * (j))
#define XB_XSUB(j)  (1280 + 64 * (j))
#define XB_XGEN(j)  (2304 + 64 * (j))
#define XB_TOP      3328
#define XB_TOPGEN   3392
#define XCD_BAR_WORDS 3456
#define XB_SPIN_CAP (1u << 18)
__device__ __forceinline__ unsigned xb_ld(unsigned* p)              { return __hip_atomic_load(p, __ATOMIC_RELAXED, __HIP_MEMORY_SCOPE_AGENT); }
__device__ __forceinline__ unsigned xb_add(unsigned* p, unsigned v) { return __hip_atomic_fetch_add(p, v, __ATOMIC_RELAXED, __HIP_MEMORY_SCOPE_AGENT); }
__device__ __forceinline__ unsigned xb_xcc_id() { return (unsigned)__builtin_amdgcn_s_getreg((3 << 11) | 20) & 0xFu; }
#define XB_SPIN(cond, bar) do { unsigned _sp = 0; while (cond) { __builtin_amdgcn_s_sleep(1); \
    if ((++_sp & 255u) == 0u) { if (xb_ld(&(bar)[XB_TMO])) break; if (_sp > XB_SPIN_CAP) { atomicAdd(&(bar)[XB_TMO], 1u); break; } } } } while (0)
struct XcdBarrier { unsigned* bar; unsigned x; volatile LAS unsigned* st; };
__device__ __forceinline__ XcdBarrier xcd_barrier_post(unsigned* bar, volatile LAS unsigned* st) {
    XcdBarrier b; b.bar = bar; b.x = xb_xcc_id(); b.st = st;
    if (threadIdx.x == 0) (void)xb_add(&bar[XB_XCNT(b.x)], 1u);
    return b;
}
__device__ __forceinline__ void xcd_barrier_complete(unsigned* bar, unsigned x, unsigned& nloc, unsigned& nx) {
    const unsigned G = gridDim.x * gridDim.y * gridDim.z;
    unsigned sum, cnt, mine, sp = 0u;
    for (;;) {
        sum = 0u; cnt = 0u; mine = 0u;
#pragma unroll
        for (unsigned j = 0; j < 16; ++j) { const unsigned c = xb_ld(&bar[XB_XCNT(j)]); sum += c; cnt += (c > 0u) ? 1u : 0u; mine = (j == x) ? c : mine; }
        if (sum == G) break;
        __builtin_amdgcn_s_sleep(1);
        if ((++sp & 255u) == 0u) { if (xb_ld(&bar[XB_TMO])) break; if (sp > XB_SPIN_CAP) { atomicAdd(&bar[XB_TMO], 1u); break; } }
    }
    nloc = mine > 0u ? mine : 1u; nx = cnt > 0u ? cnt : 1u;
}
__device__ __forceinline__ void xcd_barrier(const XcdBarrier& b) {
    asm volatile("s_waitcnt vmcnt(0)" ::: "memory");
    __syncthreads();
    if (threadIdx.x == 0) {
        unsigned* bar = b.bar;
        __builtin_amdgcn_s_waitcnt(0);
        unsigned nloc = b.st[0], nx = b.st[1];
        if (nloc == 0u) { xcd_barrier_complete(bar, b.x, nloc, nx); b.st[0] = nloc; b.st[1] = nx; }
        const unsigned old = xb_add(&bar[XB_XSUB(b.x)], 1u);
        const unsigned gen = old / nloc;
        if (old + 1u == (gen + 1u) * nloc) {
            __builtin_amdgcn_fence(__ATOMIC_RELEASE, "agent");
            asm volatile("s_waitcnt vmcnt(0)" ::: "memory");
            const unsigned og = xb_add(&bar[XB_TOP], 1u);
            const unsigned tg = og / nx;
            if (og + 1u == (tg + 1u) * nx) xb_add(&bar[XB_TOPGEN], 1u);
            else XB_SPIN(xb_ld(&bar[XB_TOPGEN]) == tg, bar);
            __builtin_amdgcn_fence(__ATOMIC_ACQUIRE, "agent");
            xb_add(&bar[XB_XGEN(b.x)], 1u);
            asm volatile("s_waitcnt vmcnt(0)" ::: "memory");
        } else {
            XB_SPIN(xb_ld(&bar[XB_XGEN(b.x)]) == gen, bar);
            __builtin_amdgcn_fence(__ATOMIC_ACQUIRE, "agent");
            asm volatile("s_waitcnt vmcnt(0)" ::: "memory");
        }
    }
    __syncthreads();
}

struct Args { const float* in[19]; float* out; unsigned char* ws; int ph_lo, ph_hi; };
struct Frame {
    LAS unsigned char* lds;
    int tid, lane, wave, G, bid;
};

template <int MAP>
__device__ __forceinline__ void p0_transpose_item(const float* W, int K, int ldw, int nblk, bf16* WT, int row_off, LAS float* scr, int item, int lane) {
    const int kb = item / nblk, nb = item % nblk, k0 = 64 * kb, n0 = 32 * nb;
    const int nd = n0 + (lane & 31);
    int sc = nd;
    if (MAP == 1) { if (nd < 1280) sc = nd; else if (nd < 1792) sc = nd + 24; else if (nd < 1816) sc = nd - 512; else sc = -1; }
#pragma unroll 8
    for (int i = 0; i < 32; ++i) { const int kk = 2 * i + (lane >> 5); scr[kk * 33 + (lane & 31)] = (sc >= 0) ? W[(size_t)(k0 + kk) * ldw + sc] : 0.f; }
    LDS_WAIT(); asm volatile("" ::: "memory");
    const int c = lane & 7;
#pragma unroll
    for (int j = 0; j < 4; ++j) { const int n = (lane >> 3) + 8 * j; const LAS float* s = scr + (8 * c) * 33 + n;
        v4u o; o.x = pk2(s[0 * 33], s[1 * 33]); o.y = pk2(s[2 * 33], s[3 * 33]); o.z = pk2(s[4 * 33], s[5 * 33]); o.w = pk2(s[6 * 33], s[7 * 33]);
        *(v4u*)(WT + (size_t)(row_off + n0 + n) * K + k0 + 8 * c) = o; }
    LDS_WAIT(); asm volatile("" ::: "memory");
}
__device__ __forceinline__ void rms_row_to_bf16(const float* xrow, const float* g, bf16* orow, int lane) {
    const f32x4* xr = (const f32x4*)xrow + lane; const f32x4* gr = (const f32x4*)g + lane;
    f32x4 v[4]; float s = 0.f;
#pragma unroll
    for (int j = 0; j < 4; ++j) { v[j] = xr[64 * j]; s += (v[j].x * v[j].x + v[j].y * v[j].y) + (v[j].z * v[j].z + v[j].w * v[j].w); }
    const float rstd = 1.0f / sqrtf(wave_sum(s) * (1.f / DM) + 1e-6f);
    unsigned long long* o8 = (unsigned long long*)orow + lane;
#pragma unroll
    for (int j = 0; j < 4; ++j) { const f32x4 gg = gr[64 * j];
        o8[64 * j] = (unsigned long long)pk2(v[j].x * rstd * gg.x, v[j].y * rstd * gg.y) | ((unsigned long long)pk2(v[j].z * rstd * gg.z, v[j].w * rstd * gg.w) << 32); }
}

__device__ __forceinline__ void p0_prologue(const Frame& F, const Args& A) {
    LAS float* scr = (LAS float*)(F.lds + F.wave * 16384);
    const int gw = F.bid * NWAVES + F.wave, NGW = F.G * NWAVES;
    constexpr int I_IN = (DM / 64) * (PW / 32), I_OUT = (DM / 64) * (DM / 32), I_UP = (DM / 64) * (DFF / 32), I_DN = (DFF / 64) * (DM / 32), I_W1 = (4096 / 64) * (128 / 32);
    constexpr int NITEMS = I_IN + I_OUT + I_UP + I_DN + 2 * I_W1;
    for (int it = gw; it < NITEMS; it += NGW) {
        int r = it;
        if (r < I_IN) { p0_transpose_item<1>(A.in[8], DM, 1816, PW / 32, ((bf16*)(A.ws + WS_WIN)), 0, scr, r, F.lane); continue; } r -= I_IN;
        if (r < I_OUT) { p0_transpose_item<0>(A.in[14], DM, DM, DM / 32, ((bf16*)(A.ws + WS_WOUT)), 0, scr, r, F.lane); continue; } r -= I_OUT;
        if (r < I_UP) { p0_transpose_item<0>(A.in[16], DM, DFF, DFF / 32, ((bf16*)(A.ws + WS_WUP)), 0, scr, r, F.lane); continue; } r -= I_UP;
        if (r < I_DN) { p0_transpose_item<0>(A.in[17], DFF, DM, DM / 32, ((bf16*)(A.ws + WS_WDN)), 0, scr, r, F.lane); continue; } r -= I_DN;
        if (r < I_W1) { p0_transpose_item<0>(A.in[10], 4096, 128, 4, ((bf16*)(A.ws + WS_W1S)), 0, scr, r, F.lane); continue; } r -= I_W1;
        p0_transpose_item<0>(A.in[10] + (size_t)4096 * 128, 4096, 128, 4, ((bf16*)(A.ws + WS_W1S)), 128, scr, r, F.lane);
    }
    for (int m = gw; m < MTOK; m += NGW) {
        const float* xr = m < NPR ? A.in[0] + (size_t)m * DM : A.in[1] + (size_t)(m - NPR) * DM;
        rms_row_to_bf16(xr, A.in[7], ((bf16*)(A.ws + WS_XN)) + (size_t)m * DM, F.lane);
    }
}

__device__ __forceinline__ void p2_copies(const Frame& F, const Args& A) {
    const size_t gt = (size_t)F.bid * NTHR + F.tid, NT = (size_t)F.G * NTHR;
    const f32x4* P4 = (const f32x4*)((float*)(A.ws + WS_PROJ));
    f32x4* O4 = (f32x4*)A.out;
    for (size_t i = gt; i < (size_t)NPR * 64; i += NT) { const size_t r = i >> 6, c = i & 63;
        O4[O_PCMP / 4 + i] = P4[r * 512 + C_KC / 4 + c]; O4[O_PSLC / 4 + i] = P4[r * 512 + C_KS / 4 + c]; }
    for (size_t i = gt; i < (size_t)4 * 512 * 64; i += NT) { const size_t c = i & 63, r = (i >> 6) & 511, b = i >> 15;
        O4[O_PWIN / 4 + i] = P4[(b * SEQ + SEQ - 512 + r) * 512 + C_KW / 4 + c]; }
    for (size_t i = gt; i < (size_t)4 * 15 * 128; i += NT) { const size_t c = i & 127, r = (i >> 7) % 15, b = (i >> 7) / 15;
        O4[O_PPOOL / 4 + i] = P4[(b * SEQ + SEQ - 15 + r) * 512 + C_U / 4 + c]; }
    for (size_t i = gt; i < (size_t)NSM * 64; i += NT) { const size_t r = i >> 6, c = i & 63;
        O4[O_SCMP / 4 + i] = P4[(NPR + r) * 512 + C_KC / 4 + c]; O4[O_SSLC / 4 + i] = P4[(NPR + r) * 512 + C_KS / 4 + c]; }
    const f32x4* SW4 = (const f32x4*)A.in[4];
    for (size_t i = gt; i < (size_t)32 * 512 * 64; i += NT) { const size_t c = i & 63, r = (i >> 6) & 511, b = i >> 15;
        O4[O_SWIN / 4 + i] = (r < 504) ? SW4[(b * 512 + r + 8) * 64 + c] : P4[(NPR + b * 8 + (r - 504)) * 512 + C_KW / 4 + c]; }
    const f32x4* SP4 = (const f32x4*)A.in[5];
    for (size_t i = gt; i < (size_t)32 * 15 * 128; i += NT) { const size_t c = i & 127, r = (i >> 7) % 15, b = (i >> 7) / 15;
        O4[O_SPOOL / 4 + i] = (r < 7) ? SP4[(b * 15 + r + 8) * 128 + c] : P4[(NPR + b * 8 + (r - 7)) * 512 + C_U / 4 + c]; }
}
__device__ __forceinline__ void p2_cmp_gather(const Frame& F, const Args& A) {
    const int gw = F.bid * NWAVES + F.wave, NGW = F.G * NWAVES;
    constexpr int NBLK = 8192 + 256 + 32;
    const int lane = F.lane, gc = lane >> 4, g = gc >> 1, c = gc & 1, d0 = (lane & 15) * 4;
    for (int it = gw; it < NBLK * 64; it += NGW) {
        const int blk = it >> 6, l = it & 63;
        f32x4 v; int rsec;
        if (blk < 8192) { const int b = blk >> 8, n = blk & 255; const int page = ((const int*)A.in[6])[b * NPG + (n >> 1)];
            v = *(const f32x4*)(A.in[2] + ((size_t)page * 128 + (n & 1) * 64 + l) * 256 + lane * 4); rsec = (b * 256 + n) * 2 + g; }
        else if (blk < 8192 + 256) { const int q = blk - 8192, b = q >> 6, n = q & 63;
            v = *(const f32x4*)(((float*)(A.ws + WS_PROJ)) + ((size_t)b * SEQ + n * 64 + l) * PW + C_KC + lane * 4); rsec = CMP_R_PROMPT + (b * 64 + n) * 2 + g; }
        else { const int b = blk - 8192 - 256;
            v = (l < 8) ? *(const f32x4*)(((float*)(A.ws + WS_PROJ)) + ((size_t)NPR + b * 8 + l) * PW + C_KC + lane * 4) : (f32x4){0.f, 0.f, 0.f, 0.f}; rsec = CMP_R_NEW + b * 2 + g; }
        const f32x4 pe = *(const f32x4*)(A.in[9] + (l * 2 + c) * 64 + d0);
        v = v + pe;
        v2u o; o.x = pk2(v.x, v.y); o.y = pk2(v.z, v.w);
        *(v2u*)(((bf16*)(A.ws + WS_ACMP)) + ((size_t)c * CMP_SEC + rsec) * 4096 + l * 64 + d0) = o;
    }
}
__device__ __forceinline__ void p2_pool(const Frame& F, const Args& A) {
    LAS float* wl = (LAS float*)F.lds;
    LAS float* dl = (LAS float*)(F.lds + 65536 + F.wave * 2048);
    constexpr int NCH = MTOK / 32;
    const int lane = F.lane;
    for (int unit = F.bid; unit < 4 * NCH; unit += F.G) {
        const int gi = unit / NCH, ch = unit % NCH, w = 2 << gi;
        __syncthreads();
        for (int i = F.tid; i < 128 * 128 / 4; i += NTHR) ((LAS f32x4*)wl)[i] = ((const f32x4*)(A.in[12] + (size_t)gi * 16384))[i];
        const int tok0 = ch * 32 + F.wave * 4;
#pragma unroll
        for (int tk = 0; tk < 4; ++tk) {
            const int row = tok0 + tk;
#pragma unroll
            for (int hh = 0; hh < 2; ++hh) {
                const int cc = gi * 128 + lane + 64 * hh;
                float own, sum = 0.f, cnt;
                if (row < NPR) { const int t = row & (SEQ - 1);
                    own = ((float*)(A.ws + WS_PROJ))[(size_t)row * PW + C_U + cc];
                    for (int j = 0; j < w; ++j) if (t - j >= 0) sum += ((float*)(A.ws + WS_PROJ))[(size_t)(row - j) * PW + C_U + cc];
                    cnt = (float)((t + 1 < w) ? t + 1 : w);
                } else { const int q = row - NPR, b = q >> 3, i = q & 7;
                    own = ((float*)(A.ws + WS_PROJ))[(size_t)row * PW + C_U + cc];
                    for (int j = 0; j < w; ++j) { const int idx = 15 + i - j;
                        sum += (idx >= 15) ? ((float*)(A.ws + WS_PROJ))[(size_t)(NPR + b * 8 + idx - 15) * PW + C_U + cc] : A.in[5][((size_t)b * 15 + idx) * 512 + cc]; }
                    cnt = (float)w;
                }
                dl[(lane + 64 * hh) * 4 + tk] = sum / cnt - own;
            }
        }
        __syncthreads();
        float acc[4][2];
#pragma unroll
        for (int tk = 0; tk < 4; ++tk) { acc[tk][0] = 0.f; acc[tk][1] = 0.f; }
#pragma unroll 4
        for (int c = 0; c < 128; ++c) {
            const f32x4 dv = *(const LAS f32x4*)(dl + c * 4);
            const float w0 = wl[c * 128 + lane], w1 = wl[c * 128 + lane + 64];
            acc[0][0] += dv.x * w0; acc[0][1] += dv.x * w1; acc[1][0] += dv.y * w0; acc[1][1] += dv.y * w1;
            acc[2][0] += dv.z * w0; acc[2][1] += dv.z * w1; acc[3][0] += dv.w * w0; acc[3][1] += dv.w * w1;
        }
        const float s0 = A.in[13][gi * 128 + lane], s1 = A.in[13][gi * 128 + lane + 64];
#pragma unroll
        for (int tk = 0; tk < 4; ++tk) { bf16* o = ((bf16*)(A.ws + WS_MIX)) + (size_t)(tok0 + tk) * DM + 512 + gi * 128;
            o[lane] = (bf16)f2bf(acc[tk][0] * s0); o[lane + 64] = (bf16)f2bf(acc[tk][1] * s1); }
    }
    __syncthreads();
}

__device__ __forceinline__ void p4_cmp_w2(const Frame& F, const Args& A) {
    LAS float* w2l = (LAS float*)F.lds;
    LAS float* hl = (LAS float*)(F.lds + 65536 + F.wave * 512);
    for (int i = F.tid; i < 2 * 128 * 64 / 4; i += NTHR) ((LAS f32x4*)w2l)[i] = ((const f32x4*)A.in[11])[i];
    __syncthreads();
    const int gw = F.bid * NWAVES + F.wave, NGW = F.G * NWAVES, lane = F.lane;
    for (int it = gw; it < 2 * CMP_R_END; it += NGW) {
        const int c = it / CMP_R_END, r = it % CMP_R_END;
        const float* hrow = ((float*)(A.ws + WS_HID)) + ((size_t)c * CMP_SEC + r) * 128;
        hl[lane] = hrow[lane]; hl[lane + 64] = hrow[lane + 64];
        LDS_WAIT(); asm volatile("" ::: "memory");
        float a = 0.f;
#pragma unroll 8
        for (int h = 0; h < 128; ++h) a += hl[h] * w2l[(c * 128 + h) * 64 + lane];
        float* dst;
        if (r < CMP_R_PROMPT) { const int b = r >> 9, n = (r & 511) >> 1, g = r & 1; dst = ((float*)(A.ws + WS_COMPS)) + ((((size_t)b * NBS + n) * 2 + g) * 2 + c) * 64; }
        else if (r < CMP_R_NEW) { const int q = r - CMP_R_PROMPT, b = q >> 7, n = (q & 127) >> 1, g = q & 1; dst = ((float*)(A.ws + WS_COMPP)) + ((((size_t)b * NBP + n) * 2 + g) * 2 + c) * 64; }
        else { const int q = r - CMP_R_NEW, b = q >> 1, g = q & 1; dst = ((float*)(A.ws + WS_COMPS)) + ((((size_t)b * NBS + 256) * 2 + g) * 2 + c) * 64; }
        dst[lane] = a;
        LDS_WAIT(); asm volatile("" ::: "memory");
    }
    __syncthreads();
}

namespace att {
typedef short bf16x8 __attribute__((ext_vector_type(8)));
typedef short s16x4 __attribute__((ext_vector_type(4)));
typedef float f32x16 __attribute__((ext_vector_type(16)));
typedef float f32x2 __attribute__((ext_vector_type(2)));
typedef __bf16 bf16x2v __attribute__((ext_vector_type(2)));
constexpr int KP = 144, VP = 192, BUFB = 64 * KP + 64 * VP;
constexpr int AT_T = 2 * BUFB, T_WAVE = 8704, AT_SCORE = AT_T + 8 * T_WAVE, AT_ML = AT_SCORE + 16384, AT_SEL = AT_ML + 2048, AT_UNI = AT_SEL + 4096, AT_TILES = AT_UNI + 64, AT_MISC = AT_TILES + 4096, AT_END = AT_MISC + 64;
static_assert(AT_END <= LDSCTL_OFF, "attention LDS map");
constexpr int NUNITS = 576;
struct TileEnt { unsigned long long base; int pitch, kpos0, kind, blk, nrows, n0; };
static_assert(sizeof(TileEnt) == 32, "TileEnt");
__device__ __forceinline__ unsigned cvtpk(float lo, float hi) { f32x2 a = {lo, hi}; return __builtin_bit_cast(unsigned, __builtin_convertvector(a, bf16x2v)); }
#define ATT_KR(r) (((r) & 3) + 8 * ((r) >> 2))
#define ATT_MFMA(a, b, c) __builtin_amdgcn_mfma_f32_32x32x16_bf16((a), (b), (c), 0, 0, 0)

__device__ __forceinline__ void attn_phase(const Frame& F, const Args& A) {
#if defined(__HIP_DEVICE_COMPILE__)
    LAS unsigned char* L = F.lds;
    const int tid = F.tid, lane = F.lane, wave = F.wave;
    const int r32 = lane & 31, h = lane >> 5, tl = r32 >> 2, p = r32 & 3;
    unsigned* qctr = (unsigned*)(A.ws + WS_CTL) + CW_QUEUE;
    const float* PROJ = (const float*)(A.ws + WS_PROJ);
    LAS TileEnt* TILES = (LAS TileEnt*)(L + AT_TILES);
    volatile LAS int* MISC = (volatile LAS int*)(L + AT_MISC);
    LAS unsigned long long* UNI = (LAS unsigned long long*)(L + AT_UNI);
    LAS unsigned long long* SEL = (LAS unsigned long long*)(L + AT_SEL);
    LAS float* SCORE = (LAS float*)(L + AT_SCORE);
    LAS float* ML = (LAS float*)(L + AT_ML);
    for (;;) {
        __syncthreads();
        if (tid == 0) {
            const int unit = (int)__hip_atomic_fetch_add(qctr, 1u, __ATOMIC_RELAXED, __HIP_MEMORY_SCOPE_AGENT);
            MISC[0] = unit;
            for (int c = 0; c < 8; ++c) UNI[c] = 0ull;
            if (unit < NUNITS) {
                if (unit < 64) { const int b = unit >> 1, g = unit & 1;
                    for (int i = 0; i < 4; ++i) { TileEnt e; e.base = (unsigned long long)((const float*)(A.ws + WS_COMPS) + (((size_t)b * NBS + 64 * i) * 2 + g) * 128); e.pitch = 256; e.kpos0 = 0; e.kind = 0; e.blk = 0; e.nrows = 64; e.n0 = 64 * i; TILES[i] = e; }
                    MISC[1] = 4;
                } else { const int u2 = unit - 64, rem = u2 & 7, b = rem >> 1, g = rem & 1;
                    TileEnt e; e.base = (unsigned long long)((const float*)(A.ws + WS_COMPP) + (((size_t)b * NBP) * 2 + g) * 128); e.pitch = 256; e.kpos0 = 0; e.kind = 0; e.blk = 0; e.nrows = 64; e.n0 = 0; TILES[0] = e;
                    MISC[1] = 1;
                }
            }
        }
        __syncthreads();
        const int unit = MISC[0];
        if (unit >= NUNITS) break;
        const bool is_s = unit < 64;
        int b, g, qt;
        if (is_s) { b = unit >> 1; g = unit & 1; qt = 256; } else { const int u2 = unit - 64, rem = u2 & 7; qt = 63 - (u2 >> 3); b = rem >> 1; g = rem & 1; }
        const bool active = is_s ? (wave == 0) : true;
        const int cur = qt;
        const int tokrow = is_s ? (NPR + b * 8 + tl) : (b * SEQ + qt * 64 + wave * 8 + tl);
        const int qpos = is_s ? (PAST + tl) : (qt * 64 + wave * 8 + tl);
        const int mytok = is_s ? tl : (wave * 8 + tl);
        const int ncmp = is_s ? 4 : 1;
        const int TP = is_s ? 264 : 68;
        LAS float* Tm = (LAS float*)(L + AT_T + (is_s ? 0 : wave * T_WAVE));
        bf16x8 Q[4];
        float gate0 = 0.f, gate1 = 0.f, gate2 = 0.f;
        const float slope2 = exp2f(-(float)(g * 4 + p + 1)) * 1.4426950408889634f;
        if (active) {
            const float* prow = PROJ + (size_t)tokrow * PW;
            const float qs = 0.125f * 1.4426950408889634f;
#pragma unroll
            for (int ks = 0; ks < 4; ++ks) { const f32x4 a = *(const f32x4*)(prow + C_Q + g * 256 + p * 64 + 16 * ks + 8 * h), c = *(const f32x4*)(prow + C_Q + g * 256 + p * 64 + 16 * ks + 8 * h + 4);
                v4u w; w.x = cvtpk(a.x * qs, a.y * qs); w.y = cvtpk(a.z * qs, a.w * qs); w.z = cvtpk(c.x * qs, c.y * qs); w.w = cvtpk(c.z * qs, c.w * qs);
                Q[ks] = __builtin_bit_cast(bf16x8, w); }
            gate0 = 1.0f / (1.0f + __expf(-prow[C_G + 0 + g * 4 + p])); gate1 = 1.0f / (1.0f + __expf(-prow[C_G + 8 + g * 4 + p])); gate2 = 1.0f / (1.0f + __expf(-prow[C_G + 16 + g * 4 + p]));
        } else {
#pragma unroll
            for (int ks = 0; ks < 4; ++ks) Q[ks] = (bf16x8){0, 0, 0, 0, 0, 0, 0, 0};
        }
        f32x16 O0, O1, T0, T1;
#pragma unroll
        for (int i = 0; i < 16; ++i) { O0[i] = 0.f; O1[i] = 0.f; T0[i] = 0.f; T1[i] = 0.f; }
        float m_run = -1e20f, l_run = 0.f;
        int curkind = 0;
        int ntiles = ncmp;
        f32x4 R0, R1, R2, R3;
#define ATT_LOAD(idx) do { const TileEnt e_ = TILES[(idx)]; const float* bp_ = (const float*)e_.base; const int nr_ = e_.nrows - 1; \
            { const int f_ = tid;        int row_ = f_ >> 5; row_ = row_ < nr_ ? row_ : nr_; R0 = *(const f32x4*)(bp_ + (size_t)row_ * e_.pitch + (f_ & 31) * 4); } \
            { const int f_ = tid + 512;  int row_ = f_ >> 5; row_ = row_ < nr_ ? row_ : nr_; R1 = *(const f32x4*)(bp_ + (size_t)row_ * e_.pitch + (f_ & 31) * 4); } \
            { const int f_ = tid + 1024; int row_ = f_ >> 5; row_ = row_ < nr_ ? row_ : nr_; R2 = *(const f32x4*)(bp_ + (size_t)row_ * e_.pitch + (f_ & 31) * 4); } \
            { const int f_ = tid + 1536; int row_ = f_ >> 5; row_ = row_ < nr_ ? row_ : nr_; R3 = *(const f32x4*)(bp_ + (size_t)row_ * e_.pitch + (f_ & 31) * 4); } } while (0)
#define ATT_ST1(buf, f_, Rv) do { const int row_ = (f_) >> 5, c4_ = (f_) & 31; v2u o_; o_.x = cvtpk(Rv.x, Rv.y); o_.y = cvtpk(Rv.z, Rv.w); \
            const int off_ = (buf) * BUFB + (c4_ < 16 ? row_ * KP + c4_ * 8 : 64 * KP + row_ * VP + (c4_ - 16) * 8); *(LAS v2u*)(L + off_) = o_; } while (0)
#define ATT_STORE(buf) do { ATT_ST1(buf, tid, R0); ATT_ST1(buf, tid + 512, R1); ATT_ST1(buf, tid + 1024, R2); ATT_ST1(buf, tid + 1536, R3); } while (0)
        ATT_LOAD(0); ATT_STORE(0);
        __syncthreads();
        for (int i = 0; i < ntiles; ++i) {
            const int buf = i & 1;
            const bool has_next = (i + 1 < ntiles) && (i + 1 != ncmp);
            if (has_next) ATT_LOAD(i + 1);
            if (active) {
                const TileEnt e = TILES[i];
                const int kind = __builtin_amdgcn_readfirstlane(e.kind), kpos0 = __builtin_amdgcn_readfirstlane(e.kpos0), blk = __builtin_amdgcn_readfirstlane(e.blk), n0 = __builtin_amdgcn_readfirstlane(e.n0);
                if (kind != curkind) {
                    const float sc = gate1 / fmaxf(l_run, 1e-30f);
#pragma unroll
                    for (int r = 0; r < 16; ++r) { T0[r] += sc * O0[r]; T1[r] += sc * O1[r]; O0[r] = 0.f; O1[r] = 0.f; }
                    m_run = -1e20f; l_run = 0.f; curkind = kind;
                }
                int dq_hi, dq_lo = -1; float sstep = slope2, rowc;
                if (kind == 0) { dq_hi = (qpos - 63 - 64 * n0) >> 6; sstep = slope2 * 64.f; rowc = slope2 * (float)(64 * n0 + 63 - qpos); }
                else if (kind == 1) { const unsigned long long w = SEL[mytok * 8 + (blk >> 6)]; const bool sb = (w >> (blk & 63)) & 1ull; dq_hi = sb ? (qpos - kpos0) : -1; rowc = slope2 * (float)(kpos0 - qpos); }
                else { dq_hi = qpos - kpos0; dq_lo = qpos - 512 - kpos0; rowc = slope2 * (float)(kpos0 - qpos); }
                const bool lane_any = (dq_hi >= 0) && (dq_lo < 63);
                if (kind == 0 || __any(lane_any)) {
                    const LAS unsigned char* Kb = L + buf * BUFB; const LAS unsigned char* Vb = Kb + 64 * KP;
                    f32x16 X0, X1;
#pragma unroll
                    for (int r = 0; r < 16; ++r) { X0[r] = 0.f; X1[r] = 0.f; }
#pragma unroll
                    for (int ks = 0; ks < 4; ++ks) {
                        const bf16x8 a0 = *(const LAS bf16x8*)(Kb + r32 * KP + (16 * ks + 8 * h) * 2);
                        const bf16x8 a1 = *(const LAS bf16x8*)(Kb + (32 + r32) * KP + (16 * ks + 8 * h) * 2);
                        X0 = ATT_MFMA(a0, Q[ks], X0); X1 = ATT_MFMA(a1, Q[ks], X1);
                    }
                    const float cb = rowc + sstep * (float)(4 * h);
#pragma unroll
                    for (int r = 0; r < 16; ++r) { X0[r] += fmaf(sstep, (float)ATT_KR(r), cb); X1[r] += fmaf(sstep, (float)(32 + ATT_KR(r)), cb); }
                    const bool lane_full = (dq_hi >= 63) && (dq_lo < 0);
                    if (!__all(lane_full)) {
                        const int hi2 = dq_hi - 4 * h, lo2 = dq_lo - 4 * h;
#pragma unroll
                        for (int r = 0; r < 16; ++r) { const int k0 = ATT_KR(r), k1 = 32 + ATT_KR(r);
                            X0[r] = (k0 <= hi2 && k0 > lo2) ? X0[r] : -1e30f; X1[r] = (k1 <= hi2 && k1 > lo2) ? X1[r] : -1e30f; }
                    }
                    if (kind == 0) {
#pragma unroll
                        for (int q4 = 0; q4 < 4; ++q4) {
                            *(LAS f32x4*)(Tm + r32 * TP + n0 + 8 * q4 + 4 * h) = (f32x4){X0[4 * q4], X0[4 * q4 + 1], X0[4 * q4 + 2], X0[4 * q4 + 3]};
                            *(LAS f32x4*)(Tm + r32 * TP + n0 + 32 + 8 * q4 + 4 * h) = (f32x4){X1[4 * q4], X1[4 * q4 + 1], X1[4 * q4 + 2], X1[4 * q4 + 3]}; }
                    }
                    float mx = -1e30f;
#pragma unroll
                    for (int r = 0; r < 16; ++r) mx = fmaxf(mx, fmaxf(X0[r], X1[r]));
                    mx = fmaxf(mx, __shfl_xor(mx, 32));
                    const float m_new = fmaxf(m_run, mx);
                    if (__any(m_new > m_run)) {
                        const float alpha = exp2f(m_run - m_new);
#pragma unroll
                        for (int r = 0; r < 16; ++r) { O0[r] *= alpha; O1[r] *= alpha; }
                        l_run *= alpha; m_run = m_new;
                    }
                    float ls = 0.f;
#pragma unroll
                    for (int r = 0; r < 16; ++r) { X0[r] = __builtin_amdgcn_exp2f(X0[r] - m_run); X1[r] = __builtin_amdgcn_exp2f(X1[r] - m_run); ls += X0[r] + X1[r]; }
                    ls += __shfl_xor(ls, 32);
                    l_run += ls;
#pragma unroll
                    for (int kt = 0; kt < 2; ++kt) {
#pragma unroll
                        for (int s = 0; s < 2; ++s) {
                            v4u pw;
                            if (kt == 0) { pw.x = cvtpk(X0[8 * s], X0[8 * s + 1]); pw.y = cvtpk(X0[8 * s + 2], X0[8 * s + 3]); pw.z = cvtpk(X0[8 * s + 4], X0[8 * s + 5]); pw.w = cvtpk(X0[8 * s + 6], X0[8 * s + 7]); }
                            else         { pw.x = cvtpk(X1[8 * s], X1[8 * s + 1]); pw.y = cvtpk(X1[8 * s + 2], X1[8 * s + 3]); pw.z = cvtpk(X1[8 * s + 4], X1[8 * s + 5]); pw.w = cvtpk(X1[8 * s + 6], X1[8 * s + 7]); }
                            const bf16x8 pf = __builtin_bit_cast(bf16x8, pw);
                            const int key0 = kt * 32 + 16 * s + 4 * h, i16 = lane & 15, q = i16 >> 2, pp = i16 & 3, blk16 = (lane >> 4) & 1;
#pragma unroll
                            for (int dt = 0; dt < 2; ++dt) {
                                const LAS unsigned char* va = Vb + (key0 + q) * VP + (dt * 32 + 16 * blk16 + 4 * pp) * 2;
                                const s16x4 lo = __builtin_amdgcn_ds_read_tr16_b64_v4i16((LAS s16x4*)va);
                                const s16x4 hi = __builtin_amdgcn_ds_read_tr16_b64_v4i16((LAS s16x4*)(va + 8 * VP));
                                const bf16x8 vf = __builtin_shufflevector(lo, hi, 0, 1, 2, 3, 4, 5, 6, 7);
                                if (dt == 0) O0 = ATT_MFMA(vf, pf, O0); else O1 = ATT_MFMA(vf, pf, O1);
                            }
                        }
                    }
                }
            }
            if (has_next) ATT_STORE(buf ^ 1);
            __syncthreads();
            if (i + 1 == ncmp) {
                if (active) {
                    const float il = 1.0f / fmaxf(l_run, 1e-30f), sc = gate0 * il;
#pragma unroll
                    for (int r = 0; r < 16; ++r) { T0[r] += sc * O0[r]; T1[r] += sc * O1[r]; O0[r] = 0.f; O1[r] = 0.f; }
                    if (h == 0) { ML[(wave * 32 + r32) * 2] = m_run; ML[(wave * 32 + r32) * 2 + 1] = il; }
                    m_run = -1e20f; l_run = 0.f; curkind = 1;
                }
                __syncthreads();
                if (!is_s) {
                    const LAS float* Tw = (const LAS float*)(L + AT_T + wave * T_WAVE);
                    for (int k = 0; k < 8; ++k) { const int tok = wave * 8 + k, n = lane; float imp = 0.f;
#pragma unroll
                        for (int pq = 0; pq < 4; ++pq) { const int row = k * 4 + pq; imp += exp2f(Tw[row * 68 + n] - ML[(wave * 32 + row) * 2]) * ML[(wave * 32 + row) * 2 + 1]; }
                        float s = imp; if (n == 0 || n == cur || n == cur - 1) s = 5.0f; if (n > cur) s = -1.0f;
                        SCORE[tok * 64 + n] = s; }
                } else {
                    const LAS float* Tw = (const LAS float*)(L + AT_T);
                    const int tok = wave;
                    for (int c = 0; c < 5; ++c) { const int n = lane + 64 * c; if (n < 264) { float s;
                        if (n < 256) { float imp = 0.f;
#pragma unroll
                            for (int pq = 0; pq < 4; ++pq) { const int row = tok * 4 + pq; imp += exp2f(Tw[row * 264 + n] - ML[row * 2]) * ML[row * 2 + 1]; }
                            s = imp; if (n == 0 || n == 255) s = 5.0f; }
                        else if (n == 256) s = 5.0f; else s = -2.0f;
                        SCORE[tok * 264 + n] = s; } }
                }
                __syncthreads();
                if (!is_s) {
                    for (int k = 0; k < 8; ++k) { const int tok = wave * 8 + k, n = lane; const float sn = SCORE[tok * 64 + n]; int cnt = 0;
#pragma unroll 4
                        for (int m4 = 0; m4 < 16; ++m4) { const f32x4 sm = *(const LAS f32x4*)(SCORE + tok * 64 + 4 * m4);
                            cnt += (sm.x > sn || (sm.x == sn && 4 * m4 < n)) ? 1 : 0; cnt += (sm.y > sn || (sm.y == sn && 4 * m4 + 1 < n)) ? 1 : 0;
                            cnt += (sm.z > sn || (sm.z == sn && 4 * m4 + 2 < n)) ? 1 : 0; cnt += (sm.w > sn || (sm.w == sn && 4 * m4 + 3 < n)) ? 1 : 0; }
                        const unsigned long long bal = __ballot(n <= cur && cnt < 16);
                        if (lane == 0) { SEL[tok * 8] = bal; __hip_atomic_fetch_or(&UNI[0], bal, __ATOMIC_RELAXED, __HIP_MEMORY_SCOPE_WORKGROUP); } }
                } else {
                    const int tok = wave;
                    for (int c = 0; c < 5; ++c) { const int n = lane + 64 * c; const float sn = (n < 264) ? SCORE[tok * 264 + n] : -2.0f; int cnt = 0;
#pragma unroll 2
                        for (int m4 = 0; m4 < 66; ++m4) { const f32x4 sm = *(const LAS f32x4*)(SCORE + tok * 264 + 4 * m4);
                            cnt += (sm.x > sn || (sm.x == sn && 4 * m4 < n)) ? 1 : 0; cnt += (sm.y > sn || (sm.y == sn && 4 * m4 + 1 < n)) ? 1 : 0;
                            cnt += (sm.z > sn || (sm.z == sn && 4 * m4 + 2 < n)) ? 1 : 0; cnt += (sm.w > sn || (sm.w == sn && 4 * m4 + 3 < n)) ? 1 : 0; }
                        const unsigned long long bal = __ballot(n <= 256 && cnt < 16);
                        if (lane == 0) { SEL[tok * 8 + c] = bal; __hip_atomic_fetch_or(&UNI[c], bal, __ATOMIC_RELAXED, __HIP_MEMORY_SCOPE_WORKGROUP); } }
                }
                __syncthreads();
                if (tid == 0) {
                    int nt = ncmp;
                    for (int c = 4; c >= 0; --c) { unsigned long long w = UNI[c];
                        while (w) { const int bit = 63 - __builtin_clzll(w); w &= ~(1ull << bit); const int j = c * 64 + bit; TileEnt e; e.kind = 1; e.blk = j; e.kpos0 = j * 64; e.n0 = 0;
                            if (!is_s) { e.base = (unsigned long long)(PROJ + ((size_t)b * SEQ + j * 64) * PW + C_KS + g * 128); e.pitch = PW; e.nrows = 64; }
                            else if (j < 256) { const int page = ((const int*)A.in[6])[b * NPG + (j >> 1)]; e.base = (unsigned long long)(A.in[3] + ((size_t)page * 128 + (j & 1) * 64) * 256 + g * 128); e.pitch = 256; e.nrows = 64; }
                            else { e.base = (unsigned long long)(PROJ + ((size_t)NPR + b * 8) * PW + C_KS + g * 128); e.pitch = PW; e.nrows = 8; }
                            TILES[nt++] = e; } }
                    if (!is_s) { for (int tw = qt; tw >= 0 && tw >= qt - 8; --tw) { TileEnt e; e.kind = 2; e.blk = 0; e.n0 = 0; e.kpos0 = tw * 64; e.base = (unsigned long long)(PROJ + ((size_t)b * SEQ + tw * 64) * PW + C_KW + g * 128); e.pitch = PW; e.nrows = 64; TILES[nt++] = e; } }
                    else { { TileEnt e; e.kind = 2; e.blk = 0; e.n0 = 0; e.kpos0 = PAST; e.base = (unsigned long long)(PROJ + ((size_t)NPR + b * 8) * PW + C_KW + g * 128); e.pitch = PW; e.nrows = 8; TILES[nt++] = e; }
                        for (int ti = 7; ti >= 0; --ti) { TileEnt e; e.kind = 2; e.blk = 0; e.n0 = 0; e.kpos0 = PAST - 512 + ti * 64; e.base = (unsigned long long)(A.in[4] + ((size_t)b * 512 + ti * 64) * 256 + g * 128); e.pitch = 256; e.nrows = 64; TILES[nt++] = e; } }
                    MISC[1] = nt;
                }
                __syncthreads();
                ntiles = MISC[1];
                ATT_LOAD(i + 1); ATT_STORE(buf ^ 1);
                __syncthreads();
            }
        }
        if (active) {
            const float sc = gate2 / fmaxf(l_run, 1e-30f);
#pragma unroll
            for (int r = 0; r < 16; ++r) { T0[r] += sc * O0[r]; T1[r] += sc * O1[r]; }
            bf16* orow = (bf16*)(A.ws + WS_MIX) + (size_t)tokrow * DM + g * 256 + p * 64;
#pragma unroll
            for (int q4 = 0; q4 < 4; ++q4) {
                v2u o; o.x = cvtpk(T0[4 * q4], T0[4 * q4 + 1]); o.y = cvtpk(T0[4 * q4 + 2], T0[4 * q4 + 3]); *(v2u*)(orow + 8 * q4 + 4 * h) = o;
                v2u o2; o2.x = cvtpk(T1[4 * q4], T1[4 * q4 + 1]); o2.y = cvtpk(T1[4 * q4 + 2], T1[4 * q4 + 3]); *(v2u*)(orow + 32 + 8 * q4 + 4 * h) = o2; }
        }
    }
#undef ATT_LOAD
#undef ATT_ST1
#undef ATT_STORE
#endif
}
#undef ATT_KR
#undef ATT_MFMA
}

__device__ __forceinline__ void p7_hb(const Frame& F, const Args& A) {
    const int gw = F.bid * NWAVES + F.wave, NGW = F.G * NWAVES;
    for (int m = gw; m < MTOK; m += NGW) rms_row_to_bf16(((float*)(A.ws + WS_H)) + (size_t)m * DM, A.in[15], ((bf16*)(A.ws + WS_HB)) + (size_t)m * DM, F.lane);
}
__device__ __forceinline__ void p10_final(const Frame& F, const Args& A) {
    const int gw = F.bid * NWAVES + F.wave, NGW = F.G * NWAVES, lane = F.lane;
    for (int m = gw; m < MTOK; m += NGW) {
        f32x4* xr = (f32x4*)(A.out + (size_t)m * DM) + lane; const f32x4* gr = (const f32x4*)A.in[18] + lane;
        f32x4 v[4]; float s = 0.f;
#pragma unroll
        for (int j = 0; j < 4; ++j) { v[j] = xr[64 * j]; s += (v[j].x * v[j].x + v[j].y * v[j].y) + (v[j].z * v[j].z + v[j].w * v[j].w); }
        const float rstd = 1.0f / sqrtf(wave_sum(s) * (1.f / DM) + 1e-6f);
#pragma unroll
        for (int j = 0; j < 4; ++j) xr[64 * j] = v[j] * rstd * gr[64 * j];
    }
}

__global__ void __launch_bounds__(NTHR, 2) fwd_kernel(Args A) {
    extern __shared__ __attribute__((aligned(16))) unsigned char lds_raw[];
    Frame F;
    F.lds = (LAS unsigned char*)lds_raw;
    F.tid = threadIdx.x; F.lane = F.tid & 63; F.wave = __builtin_amdgcn_readfirstlane(F.tid >> 6); F.G = gridDim.x; F.bid = blockIdx.x;
    unsigned char* ws = A.ws;
    for (int u = F.tid; u < (LDS_BYTES - LDSCTL_OFF) / 4; u += NTHR) ((LAS unsigned*)(F.lds + LDSCTL_OFF))[u] = 0u;
    __syncthreads();
    const int lo = A.ph_lo, hi = A.ph_hi;
    const bool multi = (hi - lo) > 1;
    XcdBarrier bar; bar.bar = (unsigned*)(ws + WS_CTL) + CW_BAR; bar.x = 0; bar.st = nullptr;
    if (multi) bar = xcd_barrier_post((unsigned*)(ws + WS_CTL) + CW_BAR, (volatile LAS unsigned*)(F.lds + MISC_OFF));
#define IN(k) (lo <= (k) && (k) < hi)
#define SEAM(k) do { if (IN(k) && IN((k) + 1)) xcd_barrier(bar); } while (0)

    if (IN(0)) { p0_prologue(F, A); } SEAM(0);
    if (IN(1)) {
        pg8::Gemm g{((bf16*)(A.ws + WS_XN)), ((bf16*)(A.ws + WS_WIN)), MTOK, PW, DM}; pg8::StaticOrder S; S.init(MTOK, PW, F.G, F.bid);
        pg8::EpiF32 E{((float*)(A.ws + WS_PROJ)), PW};
        pg8::gemm_phase<pg8::EpiF32, pg8::StaticOrder>(F.lds, g, S, E, nullptr);
    } SEAM(1);
    if (IN(2)) { p2_copies(F, A); p2_cmp_gather(F, A); p2_pool(F, A); } SEAM(2);
    if (IN(3)) {
        pg8::Gemm g{((bf16*)(A.ws + WS_ACMP)), ((bf16*)(A.ws + WS_W1S)), CMP_ROWS, 256, 4096}; pg8::StaticOrder S; S.init(CMP_ROWS, 256, F.G, F.bid);
        pg8::EpiCmpHid E{((float*)(A.ws + WS_HID)), CMP_SEC / 256};
        pg8::gemm_phase<pg8::EpiCmpHid, pg8::StaticOrder>(F.lds, g, S, E, nullptr);
    } SEAM(3);
    if (IN(4)) { p4_cmp_w2(F, A); } SEAM(4);
    if (IN(5)) { att::attn_phase(F, A); } SEAM(5);
    if (IN(6)) {
        pg8::Gemm g{((bf16*)(A.ws + WS_MIX)), ((bf16*)(A.ws + WS_WOUT)), MTOK, DM, DM}; pg8::StaticOrder S; S.init(MTOK, DM, F.G, F.bid);
        pg8::EpiResF32 E{A.in[0], A.in[1], NPR / 256, ((float*)(A.ws + WS_H)), DM};
        pg8::gemm_phase<pg8::EpiResF32, pg8::StaticOrder>(F.lds, g, S, E, nullptr);
    } SEAM(6);
    if (IN(7)) { p7_hb(F, A); } SEAM(7);
    if (IN(8)) {
        pg8::Gemm g{((bf16*)(A.ws + WS_HB)), ((bf16*)(A.ws + WS_WUP)), MTOK, DFF, DM}; pg8::StaticOrder S; S.init(MTOK, DFF, F.G, F.bid);
        pg8::EpiRelu2Bf16 E{((bf16*)(A.ws + WS_ACT)), DFF};
        pg8::gemm_phase<pg8::EpiRelu2Bf16, pg8::StaticOrder>(F.lds, g, S, E, nullptr);
    } SEAM(8);
    if (IN(9)) {
        pg8::Gemm g{((bf16*)(A.ws + WS_ACT)), ((bf16*)(A.ws + WS_WDN)), MTOK, DM, DFF}; pg8::StaticOrder S; S.init(MTOK, DM, F.G, F.bid);
        pg8::EpiResF32 E{((float*)(A.ws + WS_H)), ((float*)(A.ws + WS_H)), 1 << 20, A.out, DM};
        pg8::gemm_phase<pg8::EpiResF32, pg8::StaticOrder>(F.lds, g, S, E, nullptr);
    } SEAM(9);
    if (IN(10)) { p10_final(F, A); }
#undef IN
#undef SEAM
}

#ifndef MK_ONE_LAUNCH
#define MK_ONE_LAUNCH 1
#endif
extern "C" void kernel_launch(void* const* d_in, const int* in_sizes, int n_in, void* d_out, int out_size, void* d_ws, size_t ws_size, hipStream_t stream) {
    static int grid = 0;
    if (grid == 0) {
        if (n_in != 19 || (size_t)out_size != O_END || ws_size < WS_END) { fprintf(stderr, "kernel_launch: unexpected shapes n_in %d out %d ws %zu\n", n_in, out_size, ws_size); grid = -1; return; }
        int dev = 0, cus = 0, per_cu = 0;
        if (hipGetDevice(&dev) != hipSuccess || hipDeviceGetAttribute(&cus, hipDeviceAttributeMultiprocessorCount, dev) != hipSuccess) { grid = -1; return; }
        if (hipFuncSetAttribute((const void*)fwd_kernel, hipFuncAttributeMaxDynamicSharedMemorySize, LDS_BYTES) != hipSuccess) { fprintf(stderr, "kernel_launch: hipFuncSetAttribute failed\n"); grid = -1; return; }
        if (hipOccupancyMaxActiveBlocksPerMultiprocessor(&per_cu, (const void*)fwd_kernel, NTHR, LDS_BYTES) != hipSuccess || per_cu < 1) fprintf(stderr, "kernel_launch: occupancy query says %d\n", per_cu);
        (void)hipGetLastError();
        grid = cus;
    }
    if (grid < 0) return;
    if (hipMemsetAsync((char*)d_ws + WS_CTL, 0, CTL_ZERO_BYTES, stream) != hipSuccess) return;
    Args a{};
    for (int i = 0; i < 19; ++i) a.in[i] = (const float*)d_in[i];
    a.out = (float*)d_out; a.ws = (unsigned char*)d_ws;
#if MK_ONE_LAUNCH
    a.ph_lo = 0; a.ph_hi = NPHASES;
    hipLaunchKernelGGL(fwd_kernel, dim3(grid), dim3(NTHR), LDS_BYTES, stream, a);
#else
    for (int p = 0; p < NPHASES; ++p) { a.ph_lo = p; a.ph_hi = p + 1; hipLaunchKernelGGL(fwd_kernel, dim3(grid), dim3(NTHR), LDS_BYTES, stream, a); }
#endif
}
```

```cpp
#include <hip/hip_runtime.h>
#include <cstdio>
#include <cstdint>
namespace pg8 {
#define PG8_LAS __attribute__((address_space(3)))
typedef unsigned short bf16_t;
typedef short bf16x8 __attribute__((ext_vector_type(8)));
typedef float f32x4 __attribute__((ext_vector_type(4)));
typedef unsigned u32x4 __attribute__((ext_vector_type(4)));
constexpr int BM = 256, BK = 64, HALF = 128, HTB = HALF * BK * 2  , STAGE_BYTES = 8 * HTB, NXCD = 8, WGM = 8;

__host__ __device__ __forceinline__ int lds_byte(int r, int c) { const int st = (r >> 4) * 2 + (c >> 5), rr = r & 15, cc = c & 31, ob = rr * 64 + cc * 2; return st * 1024 + (ob ^ (((ob >> 9) & 1) << 5)); }
__host__ __device__ __forceinline__ void stage_rc(int b, int& R, int& C) { const int st = b / 1024, sb = b % 1024, swz = sb ^ (((sb >> 9) & 1) << 5); R = (st >> 1) * 16 + swz / 64; C = (st & 1) * 32 + (swz % 64) / 2; }
__host__ __device__ __forceinline__ int perm32(int rho) { const int n = rho >> 4, i = rho & 15; return 8 * (i >> 2) + 4 * n + (i & 3); }

struct Unit { int pm, pn; };
struct Gemm { const bf16_t* A; const bf16_t* Bt; int M, N, K; };

struct StaticOrder {
    int nM, nN, nwg, G, c;
    __host__ __device__ void init(int M, int N, int G_, int c_) { nM = M / BM; nN = N / BM; nwg = nM * nN; G = G_; c = c_; }
    __host__ __device__ bool next(int i, Unit& u) const {
        const long L = (long)i * G + c; if (L >= nwg) return false;
        int wgid = (int)L; { const int q = nwg / NXCD, r = nwg % NXCD, xcd = wgid % NXCD, off = wgid / NXCD; wgid = (xcd < r ? xcd * (q + 1) : r * (q + 1) + (xcd - r) * q) + off; }
        const int nig = WGM * nN, gid = wgid / nig, fm = gid * WGM, gsz = (nM - fm) < WGM ? (nM - fm) : WGM;
        u.pm = fm + ((wgid % nig) % gsz); u.pn = (wgid % nig) / gsz; return true;
    }
    __device__ __forceinline__ void a_ready(const Unit&) const {}
    __device__ __forceinline__ void done(const Unit&) const {}
};
struct CountedOrder : StaticOrder {
    const unsigned* ready; unsigned need; unsigned* tmo;
    __device__ __forceinline__ void a_ready(const Unit& u) const {
        if (threadIdx.x < 64) {
            const unsigned long long t0 = __builtin_amdgcn_s_memrealtime(); unsigned polls = 0;
            while ((unsigned)__builtin_amdgcn_readfirstlane(__hip_atomic_load(ready + 64 * u.pm, __ATOMIC_RELAXED, __HIP_MEMORY_SCOPE_AGENT)) < need) {
                if ((++polls & 255u) == 0u && __builtin_amdgcn_readfirstlane(__hip_atomic_load(tmo, __ATOMIC_RELAXED, __HIP_MEMORY_SCOPE_AGENT)) != 0u) break;
                if (__builtin_amdgcn_s_memrealtime() - t0 > 2000000ull) {
                    if (threadIdx.x == 0) { unsigned expect = 0u; __hip_atomic_compare_exchange_strong(tmo + 1, &expect, 0x600u | (unsigned)(u.pm & 0xff), __ATOMIC_RELAXED, __ATOMIC_RELAXED, __HIP_MEMORY_SCOPE_AGENT); __hip_atomic_store(tmo, 1u, __ATOMIC_RELAXED, __HIP_MEMORY_SCOPE_AGENT); }
                    break; }
                __builtin_amdgcn_s_sleep(2); }
            __builtin_amdgcn_fence(__ATOMIC_ACQUIRE, "agent");
            asm volatile("s_waitcnt vmcnt(0)" ::: "memory");
        }
#if !defined(BROKEN_HOOK_NO_BARRIER)
        asm volatile("" ::: "memory"); __builtin_amdgcn_s_barrier(); asm volatile("" ::: "memory");
#endif
    }
};

__device__ __forceinline__ unsigned cvt_pk_bf16(float lo, float hi) { unsigned r; asm volatile("v_cvt_pk_bf16_f32 %0, %1, %2" : "=v"(r) : "v"(lo), "v"(hi)); return r; }
struct EpiF32 {
    static constexpr bool PERM = false, AFTER_DRAIN = false;
    float* C; int ldc;
    __device__ __forceinline__ void operator()(const f32x4 (&acc)[2][2][4][2], const Unit& u, int wr, int wc, int fr, int fq) const {
        const int row0 = u.pm * BM + wr * 64 + fr, col0 = u.pn * BM + wc * 32 + 4 * fq;
#pragma unroll
        for (int ai = 0; ai < 2; ++ai)
#pragma unroll
            for (int m = 0; m < 4; ++m) { float* rowp = C + (size_t)(row0 + ai * HALF + m * 16) * ldc + col0;
#pragma unroll
                for (int bj = 0; bj < 2; ++bj)
#pragma unroll
                    for (int n = 0; n < 2; ++n) *(f32x4*)(rowp + bj * HALF + n * 16) = acc[ai][bj][m][n]; }
    }
};
struct EpiResF32 {
    static constexpr bool PERM = false, AFTER_DRAIN = false;
    const float* base0; const float* base1; int split; float* out; int ldc;
    __device__ __forceinline__ void operator()(const f32x4 (&acc)[2][2][4][2], const Unit& u, int wr, int wc, int fr, int fq) const {
        const int row0 = u.pm * BM + wr * 64 + fr, col0 = u.pn * BM + wc * 32 + 4 * fq;
        const float* bb = (u.pm < split) ? base0 : (base1 - (size_t)split * BM * ldc);
#pragma unroll
        for (int ai = 0; ai < 2; ++ai)
#pragma unroll
            for (int m = 0; m < 4; ++m) { const size_t off = (size_t)(row0 + ai * HALF + m * 16) * ldc + col0;
#pragma unroll
                for (int bj = 0; bj < 2; ++bj)
#pragma unroll
                    for (int n = 0; n < 2; ++n) { const f32x4 b = *(const f32x4*)(bb + off + bj * HALF + n * 16); *(f32x4*)(out + off + bj * HALF + n * 16) = acc[ai][bj][m][n] + b; } }
    }
};
struct EpiRelu2Bf16 {
    static constexpr bool PERM = true, AFTER_DRAIN = false;
    bf16_t* O; int ldc;
    __device__ __forceinline__ void operator()(const f32x4 (&acc)[2][2][4][2], const Unit& u, int wr, int wc, int fr, int fq) const {
        const int row0 = u.pm * BM + wr * 64 + fr, col0 = u.pn * BM + wc * 32 + 8 * fq;
#pragma unroll
        for (int ai = 0; ai < 2; ++ai)
#pragma unroll
            for (int m = 0; m < 4; ++m) { bf16_t* rowp = O + (size_t)(row0 + ai * HALF + m * 16) * ldc + col0;
#pragma unroll
                for (int bj = 0; bj < 2; ++bj) { f32x4 v0 = acc[ai][bj][m][0], v1 = acc[ai][bj][m][1];
#pragma unroll
                    for (int j = 0; j < 4; ++j) { const float a = fmaxf(v0[j], 0.f), b = fmaxf(v1[j], 0.f); v0[j] = a * a; v1[j] = b * b; }
                    u32x4 w; w.x = cvt_pk_bf16(v0[0], v0[1]); w.y = cvt_pk_bf16(v0[2], v0[3]); w.z = cvt_pk_bf16(v1[0], v1[1]); w.w = cvt_pk_bf16(v1[2], v1[3]);
                    *(u32x4*)(rowp + bj * HALF) = w; } }
    }
};
__device__ __forceinline__ float gelu_tanh(float x) {
    const float y = 0.7978845608028654f * (x + 0.044715f * x * x * x);
    const float t = 1.0f - 2.0f / (__expf(2.0f * y) + 1.0f);
    return 0.5f * x * (1.0f + t);
}
struct EpiCmpHid {
    static constexpr bool PERM = false, AFTER_DRAIN = false;
    float* H; int csplit;
    __device__ __forceinline__ void operator()(const f32x4 (&acc)[2][2][4][2], const Unit& u, int wr, int wc, int fr, int fq) const {
        const int row0 = u.pm * BM + wr * 64 + fr, col0 = wc * 32 + 4 * fq;
        const bool c1 = u.pm >= csplit;
#pragma unroll
        for (int ai = 0; ai < 2; ++ai)
#pragma unroll
            for (int m = 0; m < 4; ++m) { float* rowp = H + (size_t)(row0 + ai * HALF + m * 16) * 128 + col0;
#pragma unroll
                for (int n = 0; n < 2; ++n) { f32x4 v = c1 ? acc[ai][1][m][n] : acc[ai][0][m][n];
#pragma unroll
                    for (int j = 0; j < 4; ++j) v[j] = gelu_tanh(v[j]);
                    *(f32x4*)(rowp + n * 16) = v; } }
    }
};
template <class Epi, class Sched, bool STAMP = false>
__device__ __forceinline__ void gemm_phase(PG8_LAS unsigned char* lds, const Gemm g, const Sched& S, const Epi& E, unsigned long long* stamps) {
    const int tid = threadIdx.x, wid = __builtin_amdgcn_readfirstlane(tid >> 6), lane = tid & 63, wr = wid >> 2, wc = wid & 3, fr = lane & 15, fq = lane >> 4;
    const int K = g.K, nt = K / BK;
    int ts_lo = 0, ts_hi = 0, nts = 0; const unsigned long long rt_entry = STAMP ? (unsigned long long)wall_clock64() : 0ull;
#define PG8_STAMP() do { if (STAMP && wid == 0 && nts < 64) { const unsigned long long _c = (unsigned long long)clock64(); \
        ts_lo = (lane == nts) ? (int)(unsigned)_c : ts_lo; ts_hi = (lane == nts) ? (int)(unsigned)(_c >> 32) : ts_hi; ++nts; } } while (0)
    PG8_STAMP();
    unsigned voffA[2], voffB[2];
#pragma unroll
    for (int i = 0; i < 2; ++i) { int R, C; stage_rc(tid * 16 + i * 8192, R, C); const int Rb = Epi::PERM ? ((R & ~31) + perm32(R & 31)) : R;
        voffA[i] = (unsigned)(R * K + C) * 2u; voffB[i] = (unsigned)(Rb * K + C) * 2u; }
    const size_t kstep = (size_t)(BK * 2);
    const size_t hstep = (size_t)HALF * K * 2;
    const size_t tstep = 2 * hstep;
    const unsigned ldsw = (unsigned)wid * 1024u;
    const int aoff = lds_byte(wr * 64 + fr, fq * 8), boff = lds_byte(wc * 32 + fr, fq * 8);
#define PG8_SA(b, h) (((b) * 2 + (h)) * HTB)
#define PG8_SB(b, h) ((4 + (b) * 2 + (h)) * HTB)
#define PG8_STAGE(bufoff, gbase, voff) do { _Pragma("unroll") for (int _i = 0; _i < 2; ++_i) \
        __builtin_amdgcn_global_load_lds((const unsigned*)((const char*)(gbase) + (voff)[_i]), (PG8_LAS unsigned*)(lds + (bufoff) + ldsw + _i * 8192), 16, 0, 0); } while (0)
#define PG8_LDA(dst, b, h) do { _Pragma("unroll") for (int m = 0; m < 4; ++m) _Pragma("unroll") for (int k = 0; k < 2; ++k) dst[m][k] = *(const PG8_LAS bf16x8*)(lds + PG8_SA(b, h) + aoff + m * 2048 + k * 1024); } while (0)
#define PG8_LDB(dst, b, h) do { _Pragma("unroll") for (int n = 0; n < 2; ++n) _Pragma("unroll") for (int k = 0; k < 2; ++k) dst[n][k] = *(const PG8_LAS bf16x8*)(lds + PG8_SB(b, h) + boff + n * 2048 + k * 1024); } while (0)
#define PG8_MMA(ai, bj, At, Bt) do { __builtin_amdgcn_s_setprio(1); _Pragma("unroll") for (int m = 0; m < 4; ++m) _Pragma("unroll") for (int n = 0; n < 2; ++n) _Pragma("unroll") for (int k = 0; k < 2; ++k) \
        acc[ai][bj][m][n] = __builtin_amdgcn_mfma_f32_16x16x32_bf16(Bt[n][k], At[m][k], acc[ai][bj][m][n], 0, 0, 0); __builtin_amdgcn_s_setprio(0); } while (0)
#define PG8_WAIT_V(n) asm volatile("s_waitcnt vmcnt(" #n ")" ::: "memory")
#define PG8_WAIT_L(n) asm volatile("s_waitcnt lgkmcnt(" #n ")" ::: "memory")
#define PG8_BAR __builtin_amdgcn_s_barrier()
#define PG8_SCHED __builtin_amdgcn_sched_barrier(0)
    Unit cur, nxt; int ui = 0;
    if (!S.next(0, cur)) return;
    f32x4 acc[2][2][4][2];
#pragma unroll
    for (int a = 0; a < 2; ++a)
#pragma unroll
        for (int b = 0; b < 2; ++b)
#pragma unroll
            for (int m = 0; m < 4; ++m)
#pragma unroll
                for (int n = 0; n < 2; ++n) acc[a][b][m][n] = (f32x4){0.f, 0.f, 0.f, 0.f};
    bf16x8 At[4][2], B0[2][2], B1[2][2];
    const char* cA = (const char*)g.A + (size_t)cur.pm * tstep; const char* cB = (const char*)g.Bt + (size_t)cur.pn * tstep;
    S.a_ready(cur);
    PG8_STAGE(PG8_SB(0, 0), cB, voffB); PG8_STAGE(PG8_SA(0, 0), cA, voffA); PG8_STAGE(PG8_SB(0, 1), cB + hstep, voffB); PG8_STAGE(PG8_SA(0, 1), cA + hstep, voffA);
    if (wr == 1) PG8_BAR;
    PG8_WAIT_V(4); PG8_BAR;
    PG8_STAGE(PG8_SB(1, 0), cB + kstep, voffB); PG8_STAGE(PG8_SA(1, 0), cA + kstep, voffA); PG8_STAGE(PG8_SB(1, 1), cB + hstep + kstep, voffB);
    PG8_WAIT_V(6); PG8_BAR;
    PG8_STAMP();
    for (;;) {
        const bool has_next = S.next(ui + 1, nxt);
        const char* nA = has_next ? (const char*)g.A + (size_t)nxt.pm * tstep : cA; const char* nB = has_next ? (const char*)g.Bt + (size_t)nxt.pn * tstep : cB;
        for (int t = 0; t < nt; t += 2) {
            const bool last = (t == nt - 2);
            const char* a1 = cA + (size_t)(t + 1) * kstep;
            const char* a2 = last ? nA : cA + (size_t)(t + 2) * kstep; const char* b2 = last ? nB : cB + (size_t)(t + 2) * kstep;
            const char* a3 = a2 + kstep; const char* b3 = b2 + kstep;
            if (last && has_next) S.a_ready(nxt);
            PG8_LDB(B0, 0, 0); PG8_SCHED; PG8_LDA(At, 0, 0); PG8_STAGE(PG8_SA(1, 1), a1 + hstep, voffA);
            PG8_WAIT_L(8); PG8_BAR; PG8_WAIT_L(0); PG8_MMA(0, 0, At, B0); PG8_BAR; PG8_SCHED;
            PG8_LDB(B1, 0, 1); PG8_STAGE(PG8_SB(0, 0), b2, voffB);
            PG8_BAR; PG8_WAIT_L(0); PG8_MMA(0, 1, At, B1); PG8_BAR;
            PG8_LDA(At, 0, 1); PG8_STAGE(PG8_SA(0, 0), a2, voffA);
            PG8_BAR; PG8_WAIT_L(0); PG8_MMA(1, 0, At, B0); PG8_BAR; PG8_SCHED;
            PG8_STAGE(PG8_SB(0, 1), b2 + hstep, voffB);
            PG8_WAIT_V(6); PG8_BAR; PG8_MMA(1, 1, At, B1); PG8_BAR;
            PG8_LDB(B0, 1, 0); PG8_SCHED; PG8_LDA(At, 1, 0); PG8_STAGE(PG8_SA(0, 1), a2 + hstep, voffA);
            PG8_WAIT_L(8); PG8_BAR; PG8_WAIT_L(0); PG8_MMA(0, 0, At, B0); PG8_BAR; PG8_SCHED;
            PG8_LDB(B1, 1, 1); PG8_STAGE(PG8_SB(1, 0), b3, voffB);
            PG8_BAR; PG8_WAIT_L(0); PG8_MMA(0, 1, At, B1); PG8_BAR;
            PG8_LDA(At, 1, 1); PG8_STAGE(PG8_SA(1, 0), a3, voffA);
            PG8_BAR; PG8_WAIT_L(0); PG8_MMA(1, 0, At, B0); PG8_BAR; PG8_SCHED;
            PG8_STAGE(PG8_SB(1, 1), b3 + hstep, voffB);
            PG8_WAIT_V(6); PG8_BAR; PG8_MMA(1, 1, At, B1); PG8_BAR;
        }
        PG8_STAMP();
        if constexpr (!Epi::AFTER_DRAIN) { E(acc, cur, wr, wc, fr, fq); S.done(cur); }
        PG8_STAMP();
        if (!has_next) break;
#pragma unroll
        for (int a = 0; a < 2; ++a)
#pragma unroll
            for (int b = 0; b < 2; ++b)
#pragma unroll
                for (int m = 0; m < 4; ++m)
#pragma unroll
                    for (int n = 0; n < 2; ++n) acc[a][b][m][n] = (f32x4){0.f, 0.f, 0.f, 0.f};
        cur = nxt; cA = nA; cB = nB; ++ui;
    }
    PG8_WAIT_V(0);
    if (wr == 0) PG8_BAR;
    PG8_BAR;
    if constexpr (Epi::AFTER_DRAIN) { E.fused(acc, cur, wr, wc, fr, fq, lds, wid, lane); S.done(cur); }
    PG8_STAMP();
    if (STAMP && wid == 0) { stamps[lane] = lane < nts ? (((unsigned long long)(unsigned)ts_hi << 32) | (unsigned)ts_lo) : 0ull;
        if (lane == 62) stamps[62] = rt_entry; if (lane == 63) stamps[63] = (unsigned long long)wall_clock64(); }
#undef PG8_STAMP
#undef PG8_SA
#undef PG8_SB
#undef PG8_STAGE
#undef PG8_LDA
#undef PG8_LDB
#undef PG8_MMA
#undef PG8_WAIT_V
#undef PG8_WAIT_L
#undef PG8_BAR
#undef PG8_SCHED
}
}

constexpr int DM = 1024, NPR = 16384, NSM = 256, MTOK = NPR + NSM, SEQ = 4096, NBP = 64, PAST = 16384, NBS = 257, NPG = 128, DFF = 4096;
constexpr int PW = 2048;
constexpr int C_Q = 0, C_KC = 512, C_KS = 768, C_KW = 1024, C_U = 1280, C_G = 1792;
constexpr int CMP_SEC = 17152, CMP_ROWS = 2 * CMP_SEC;
constexpr int CMP_R_PROMPT = 16384, CMP_R_NEW = 16896, CMP_R_END = 16960;
constexpr size_t O_YP = 0, O_YS = 16777216, O_PCMP = 17039360, O_PSLC = 21233664, O_PWIN = 25427968, O_PPOOL = 25952256,
                 O_SCMP = 25982976, O_SSLC = 26048512, O_SWIN = 26114048, O_SPOOL = 30308352, O_END = 30554112;
constexpr size_t MiB = 1u << 20;
constexpr size_t WS_CTL = 0, CTL_ZERO_BYTES = 1 * MiB;
constexpr size_t WS_WIN = 2 * MiB, WS_WOUT = 6 * MiB, WS_WUP = 8 * MiB, WS_WDN = 16 * MiB, WS_W1S = 24 * MiB;
constexpr size_t WS_XN = 32 * MiB, WS_PROJ = 66 * MiB, WS_ACMP = 200 * MiB, WS_HID = 470 * MiB, WS_COMPS = 490 * MiB, WS_COMPP = 500 * MiB;
constexpr size_t WS_MIX = 502 * MiB, WS_H = 536 * MiB, WS_HB = 602 * MiB, WS_ACT = 636 * MiB, WS_END = 768 * MiB;
static_assert(WS_XN + (size_t)MTOK * DM * 2 <= WS_PROJ && WS_PROJ + (size_t)MTOK * PW * 4 <= WS_ACMP && WS_ACMP + (size_t)CMP_ROWS * 4096 * 2 <= WS_HID, "ws map 1");
static_assert(WS_HID + (size_t)CMP_ROWS * 128 * 4 <= WS_COMPS && WS_COMPS + (size_t)32 * NBS * 256 * 4 <= WS_COMPP && WS_COMPP + (size_t)4 * NBP * 256 * 4 <= WS_MIX, "ws map 2");
static_assert(WS_MIX + (size_t)MTOK * DM * 2 <= WS_H && WS_H + (size_t)MTOK * DM * 4 <= WS_HB && WS_HB + (size_t)MTOK * DM * 2 <= WS_ACT && WS_ACT + (size_t)MTOK * DFF * 2 <= WS_END, "ws map 3");
constexpr int CW_BAR = 4096, CW_QUEUE = 8192;

constexpr int NWAVES = 8, NTHR = NWAVES * 64;
constexpr int RING_BYTES = 131072, LDSCTL_OFF = 143360, MISC_OFF = LDSCTL_OFF + 320, LDS_BYTES = 147456;
constexpr int NPHASES = 9;

#define GAS __attribute__((address_space(1)))
#define LAS __attribute__((address_space(3)))
typedef unsigned short bf16;
typedef unsigned v4u __attribute__((ext_vector_type(4)));
typedef unsigned v2u __attribute__((ext_vector_type(2)));
typedef float f32x4 __attribute__((ext_vector_type(4)));
#define LDS_WAIT() asm volatile("s_waitcnt lgkmcnt(0)" ::: "memory")
__device__ __forceinline__ unsigned f2bf(float f) { unsigned u = __builtin_bit_cast(unsigned, f); return (u + 0x7fffu + ((u >> 16) & 1u)) >> 16; }
__device__ __forceinline__ unsigned pk2(float lo, float hi) { return f2bf(lo) | (f2bf(hi) << 16); }
__device__ __forceinline__ float wave_sum(float v) {
#pragma unroll
    for (int o = 1; o < 64; o <<= 1) v += __shfl_xor(v, o);
    return v;
}
__device__ __forceinline__ float wave_max(float v) {
#pragma unroll
    for (int o = 1; o < 64; o <<= 1) v = fmaxf(v, __shfl_xor(v, o));
    return v;
}

#define XB_TMO      128
#define XB_XCNT(j)  (256  + 64 * (j))
#define XB_XSUB(j)  (1280 + 64 * (j))
#define XB_XGEN(j)  (2304 + 64 * (j))
#define XB_TOP      3328
#define XB_TOPGEN   3392
#define XCD_BAR_WORDS 3456
#define XB_SPIN_CAP (1u << 18)
__device__ __forceinline__ unsigned xb_ld(unsigned* p)              { return __hip_atomic_load(p, __ATOMIC_RELAXED, __HIP_MEMORY_SCOPE_AGENT); }
__device__ __forceinline__ unsigned xb_add(unsigned* p, unsigned v) { return __hip_atomic_fetch_add(p, v, __ATOMIC_RELAXED, __HIP_MEMORY_SCOPE_AGENT); }
__device__ __forceinline__ unsigned xb_xcc_id() { return (unsigned)__builtin_amdgcn_s_getreg((3 << 11) | 20) & 0xFu; }
#define XB_SPIN(cond, bar) do { unsigned _sp = 0; while (cond) { __builtin_amdgcn_s_sleep(1); \
    if ((++_sp & 255u) == 0u) { if (xb_ld(&(bar)[XB_TMO])) break; if (_sp > XB_SPIN_CAP) { atomicAdd(&(bar)[XB_TMO], 1u); break; } } } } while (0)
struct XcdBarrier { unsigned* bar; unsigned x; volatile LAS unsigned* st; };
__device__ __forceinline__ XcdBarrier xcd_barrier_post(unsigned* bar, volatile LAS unsigned* st) {
    XcdBarrier b; b.bar = bar; b.x = xb_xcc_id(); b.st = st;
    if (threadIdx.x == 0) (void)xb_add(&bar[XB_XCNT(b.x)], 1u);
    return b;
}
__device__ __forceinline__ void xcd_barrier_complete(unsigned* bar, unsigned x, unsigned& nloc, unsigned& nx) {
    const unsigned G = gridDim.x * gridDim.y * gridDim.z;
    unsigned sum, cnt, mine, sp = 0u;
    for (;;) {
        sum = 0u; cnt = 0u; mine = 0u;
#pragma unroll
        for (unsigned j = 0; j < 16; ++j) { const unsigned c = xb_ld(&bar[XB_XCNT(j)]); sum += c; cnt += (c > 0u) ? 1u : 0u; mine = (j == x) ? c : mine; }
        if (sum == G) break;
        __builtin_amdgcn_s_sleep(1);
        if ((++sp & 255u) == 0u) { if (xb_ld(&bar[XB_TMO])) break; if (sp > XB_SPIN_CAP) { atomicAdd(&bar[XB_TMO], 1u); break; } }
    }
    nloc = mine > 0u ? mine : 1u; nx = cnt > 0u ? cnt : 1u;
}
__device__ __forceinline__ void xcd_barrier(const XcdBarrier& b) {
    asm volatile("s_waitcnt vmcnt(0)" ::: "memory");
    __syncthreads();
    if (threadIdx.x == 0) {
        unsigned* bar = b.bar;
        __builtin_amdgcn_s_waitcnt(0);
        unsigned nloc = b.st[0], nx = b.st[1];
        if (nloc == 0u) { xcd_barrier_complete(bar, b.x, nloc, nx); b.st[0] = nloc; b.st[1] = nx; }
        const unsigned old = xb_add(&bar[XB_XSUB(b.x)], 1u);
        const unsigned gen = old / nloc;
        if (old + 1u == (gen + 1u) * nloc) {
            __builtin_amdgcn_fence(__ATOMIC_RELEASE, "agent");
            asm volatile("s_waitcnt vmcnt(0)" ::: "memory");
            const unsigned og = xb_add(&bar[XB_TOP], 1u);
            const unsigned tg = og / nx;
            if (og + 1u == (tg + 1u) * nx) xb_add(&bar[XB_TOPGEN], 1u);
            else XB_SPIN(xb_ld(&bar[XB_TOPGEN]) == tg, bar);
            __builtin_amdgcn_fence(__ATOMIC_ACQUIRE, "agent");
            xb_add(&bar[XB_XGEN(b.x)], 1u);
            asm volatile("s_waitcnt vmcnt(0)" ::: "memory");
        } else {
            XB_SPIN(xb_ld(&bar[XB_XGEN(b.x)]) == gen, bar);
            __builtin_amdgcn_fence(__ATOMIC_ACQUIRE, "agent");
            asm volatile("s_waitcnt vmcnt(0)" ::: "memory");
        }
    }
    __syncthreads();
}

struct Args { const float* in[19]; float* out; unsigned char* ws; int ph_lo, ph_hi; };
struct Frame {
    LAS unsigned char* lds;
    int tid, lane, wave, G, bid;
};

template <int MAP>
__device__ __forceinline__ void p0_transpose_item(const float* W, int K, int ldw, int nblk, bf16* WT, int row_off, LAS float* scr, int item, int lane) {
    const int kb = item / nblk, nb = item % nblk, k0 = 64 * kb, n0 = 32 * nb;
    const int nd = n0 + (lane & 31);
    int sc = nd;
    if (MAP == 1) { if (nd < 1280) sc = nd; else if (nd < 1792) sc = nd + 24; else if (nd < 1816) sc = nd - 512; else sc = -1; }
#pragma unroll 8
    for (int i = 0; i < 32; ++i) { const int kk = 2 * i + (lane >> 5); scr[kk * 33 + (lane & 31)] = (sc >= 0) ? W[(size_t)(k0 + kk) * ldw + sc] : 0.f; }
    LDS_WAIT(); asm volatile("" ::: "memory");
    const int c = lane & 7;
#pragma unroll
    for (int j = 0; j < 4; ++j) { const int n = (lane >> 3) + 8 * j; const LAS float* s = scr + (8 * c) * 33 + n;
        v4u o; o.x = pk2(s[0 * 33], s[1 * 33]); o.y = pk2(s[2 * 33], s[3 * 33]); o.z = pk2(s[4 * 33], s[5 * 33]); o.w = pk2(s[6 * 33], s[7 * 33]);
        *(v4u*)(WT + (size_t)(row_off + n0 + n) * K + k0 + 8 * c) = o; }
    LDS_WAIT(); asm volatile("" ::: "memory");
}
__device__ __forceinline__ void rms_row_to_bf16(const float* xrow, const float* g, bf16* orow, int lane) {
    const f32x4* xr = (const f32x4*)xrow + lane; const f32x4* gr = (const f32x4*)g + lane;
    f32x4 v[4]; float s = 0.f;
#pragma unroll
    for (int j = 0; j < 4; ++j) { v[j] = xr[64 * j]; s += (v[j].x * v[j].x + v[j].y * v[j].y) + (v[j].z * v[j].z + v[j].w * v[j].w); }
    const float rstd = 1.0f / sqrtf(wave_sum(s) * (1.f / DM) + 1e-6f);
    unsigned long long* o8 = (unsigned long long*)orow + lane;
#pragma unroll
    for (int j = 0; j < 4; ++j) { const f32x4 gg = gr[64 * j];
        o8[64 * j] = (unsigned long long)pk2(v[j].x * rstd * gg.x, v[j].y * rstd * gg.y) | ((unsigned long long)pk2(v[j].z * rstd * gg.z, v[j].w * rstd * gg.w) << 32); }
}

__device__ __forceinline__ void p0_prologue(const Frame& F, const Args& A) {
    LAS float* scr = (LAS float*)(F.lds + F.wave * 16384);
    const int gw = F.bid * NWAVES + F.wave, NGW = F.G * NWAVES;
    constexpr int I_IN = (DM / 64) * (PW / 32), I_OUT = (DM / 64) * (DM / 32), I_UP = (DM / 64) * (DFF / 32), I_DN = (DFF / 64) * (DM / 32), I_W1 = (4096 / 64) * (128 / 32);
    constexpr int NITEMS = I_IN + I_OUT + I_UP + I_DN + 2 * I_W1;
    for (int it = gw; it < NITEMS; it += NGW) {
        int r = it;
        if (r < I_IN) { p0_transpose_item<1>(A.in[8], DM, 1816, PW / 32, ((bf16*)(A.ws + WS_WIN)), 0, scr, r, F.lane); continue; } r -= I_IN;
        if (r < I_OUT) { p0_transpose_item<0>(A.in[14], DM, DM, DM / 32, ((bf16*)(A.ws + WS_WOUT)), 0, scr, r, F.lane); continue; } r -= I_OUT;
        if (r < I_UP) { p0_transpose_item<0>(A.in[16], DM, DFF, DFF / 32, ((bf16*)(A.ws + WS_WUP)), 0, scr, r, F.lane); continue; } r -= I_UP;
        if (r < I_DN) { p0_transpose_item<0>(A.in[17], DFF, DM, DM / 32, ((bf16*)(A.ws + WS_WDN)), 0, scr, r, F.lane); continue; } r -= I_DN;
        if (r < I_W1) { p0_transpose_item<0>(A.in[10], 4096, 128, 4, ((bf16*)(A.ws + WS_W1S)), 0, scr, r, F.lane); continue; } r -= I_W1;
        p0_transpose_item<0>(A.in[10] + (size_t)4096 * 128, 4096, 128, 4, ((bf16*)(A.ws + WS_W1S)), 128, scr, r, F.lane);
    }
    for (int m = gw; m < MTOK; m += NGW) {
        const float* xr = m < NPR ? A.in[0] + (size_t)m * DM : A.in[1] + (size_t)(m - NPR) * DM;
        rms_row_to_bf16(xr, A.in[7], ((bf16*)(A.ws + WS_XN)) + (size_t)m * DM, F.lane);
    }
}

__device__ __forceinline__ void p2_copies(const Frame& F, const Args& A) {
    const size_t gt = (size_t)F.bid * NTHR + F.tid, NT = (size_t)F.G * NTHR;
    const f32x4* P4 = (const f32x4*)((float*)(A.ws + WS_PROJ));
    f32x4* O4 = (f32x4*)A.out;
    for (size_t i = gt; i < (size_t)NPR * 64; i += NT) { const size_t r = i >> 6, c = i & 63;
        O4[O_PCMP / 4 + i] = P4[r * 512 + C_KC / 4 + c]; O4[O_PSLC / 4 + i] = P4[r * 512 + C_KS / 4 + c]; }
    for (size_t i = gt; i < (size_t)4 * 512 * 64; i += NT) { const size_t c = i & 63, r = (i >> 6) & 511, b = i >> 15;
        O4[O_PWIN / 4 + i] = P4[(b * SEQ + SEQ - 512 + r) * 512 + C_KW / 4 + c]; }
    for (size_t i = gt; i < (size_t)4 * 15 * 128; i += NT) { const size_t c = i & 127, r = (i >> 7) % 15, b = (i >> 7) / 15;
        O4[O_PPOOL / 4 + i] = P4[(b * SEQ + SEQ - 15 + r) * 512 + C_U / 4 + c]; }
    for (size_t i = gt; i < (size_t)NSM * 64; i += NT) { const size_t r = i >> 6, c = i & 63;
        O4[O_SCMP / 4 + i] = P4[(NPR + r) * 512 + C_KC / 4 + c]; O4[O_SSLC / 4 + i] = P4[(NPR + r) * 512 + C_KS / 4 + c]; }
    const f32x4* SW4 = (const f32x4*)A.in[4];
    for (size_t i = gt; i < (size_t)32 * 512 * 64; i += NT) { const size_t c = i & 63, r = (i >> 6) & 511, b = i >> 15;
        O4[O_SWIN / 4 + i] = (r < 504) ? SW4[(b * 512 + r + 8) * 64 + c] : P4[(NPR + b * 8 + (r - 504)) * 512 + C_KW / 4 + c]; }
    const f32x4* SP4 = (const f32x4*)A.in[5];
    for (size_t i = gt; i < (size_t)32 * 15 * 128; i += NT) { const size_t c = i & 127, r = (i >> 7) % 15, b = (i >> 7) / 15;
        O4[O_SPOOL / 4 + i] = (r < 7) ? SP4[(b * 15 + r + 8) * 128 + c] : P4[(NPR + b * 8 + (r - 7)) * 512 + C_U / 4 + c]; }
}
__device__ __forceinline__ void p2_cmp_gather(const Frame& F, const Args& A) {
    const int gw = F.bid * NWAVES + F.wave, NGW = F.G * NWAVES;
    constexpr int NBLK = 8192 + 256 + 32;
    const int lane = F.lane, gc = lane >> 4, g = gc >> 1, c = gc & 1, d0 = (lane & 15) * 4;
    for (int it = gw; it < NBLK * 64; it += NGW) {
        const int blk = it >> 6, l = it & 63;
        f32x4 v; int rsec;
        if (blk < 8192) { const int b = blk >> 8, n = blk & 255; const int page = ((const int*)A.in[6])[b * NPG + (n >> 1)];
            v = *(const f32x4*)(A.in[2] + ((size_t)page * 128 + (n & 1) * 64 + l) * 256 + lane * 4); rsec = (b * 256 + n) * 2 + g; }
        else if (blk < 8192 + 256) { const int q = blk - 8192, b = q >> 6, n = q & 63;
            v = *(const f32x4*)(((float*)(A.ws + WS_PROJ)) + ((size_t)b * SEQ + n * 64 + l) * PW + C_KC + lane * 4); rsec = CMP_R_PROMPT + (b * 64 + n) * 2 + g; }
        else { const int b = blk - 8192 - 256;
            v = (l < 8) ? *(const f32x4*)(((float*)(A.ws + WS_PROJ)) + ((size_t)NPR + b * 8 + l) * PW + C_KC + lane * 4) : (f32x4){0.f, 0.f, 0.f, 0.f}; rsec = CMP_R_NEW + b * 2 + g; }
        const f32x4 pe = *(const f32x4*)(A.in[9] + (l * 2 + c) * 64 + d0);
        v = v + pe;
        v2u o; o.x = pk2(v.x, v.y); o.y = pk2(v.z, v.w);
        *(v2u*)(((bf16*)(A.ws + WS_ACMP)) + ((size_t)c * CMP_SEC + rsec) * 4096 + l * 64 + d0) = o;
    }
}
__device__ __forceinline__ void p2_pool(const Frame& F, const Args& A) {
    LAS float* wl = (LAS float*)F.lds;
    LAS float* dl = (LAS float*)(F.lds + 65536 + F.wave * 2048);
    constexpr int NCH = MTOK / 32;
    const int lane = F.lane;
    for (int unit = F.bid; unit < 4 * NCH; unit += F.G) {
        const int gi = unit / NCH, ch = unit % NCH, w = 2 << gi;
        __syncthreads();
        for (int i = F.tid; i < 128 * 128 / 4; i += NTHR) ((LAS f32x4*)wl)[i] = ((const f32x4*)(A.in[12] + (size_t)gi * 16384))[i];
        const int tok0 = ch * 32 + F.wave * 4;
#pragma unroll
        for (int tk = 0; tk < 4; ++tk) {
            const int row = tok0 + tk;
#pragma unroll
            for (int hh = 0; hh < 2; ++hh) {
                const int cc = gi * 128 + lane + 64 * hh;
                float own, sum = 0.f, cnt;
                if (row < NPR) { const int t = row & (SEQ - 1);
                    own = ((float*)(A.ws + WS_PROJ))[(size_t)row * PW + C_U + cc];
                    for (int j = 0; j < w; ++j) if (t - j >= 0) sum += ((float*)(A.ws + WS_PROJ))[(size_t)(row - j) * PW + C_U + cc];
                    cnt = (float)((t + 1 < w) ? t + 1 : w);
                } else { const int q = row - NPR, b = q >> 3, i = q & 7;
                    own = ((float*)(A.ws + WS_PROJ))[(size_t)row * PW + C_U + cc];
                    for (int j = 0; j < w; ++j) { const int idx = 15 + i - j;
                        sum += (idx >= 15) ? ((float*)(A.ws + WS_PROJ))[(size_t)(NPR + b * 8 + idx - 15) * PW + C_U + cc] : A.in[5][((size_t)b * 15 + idx) * 512 + cc]; }
                    cnt = (float)w;
                }
                dl[(lane + 64 * hh) * 4 + tk] = sum / cnt - own;
            }
        }
        __syncthreads();
        float acc[4][2];
#pragma unroll
        for (int tk = 0; tk < 4; ++tk) { acc[tk][0] = 0.f; acc[tk][1] = 0.f; }
#pragma unroll 4
        for (int c = 0; c < 128; ++c) {
            const f32x4 dv = *(const LAS f32x4*)(dl + c * 4);
            const float w0 = wl[c * 128 + lane], w1 = wl[c * 128 + lane + 64];
            acc[0][0] += dv.x * w0; acc[0][1] += dv.x * w1; acc[1][0] += dv.y * w0; acc[1][1] += dv.y * w1;
            acc[2][0] += dv.z * w0; acc[2][1] += dv.z * w1; acc[3][0] += dv.w * w0; acc[3][1] += dv.w * w1;
        }
        const float s0 = A.in[13][gi * 128 + lane], s1 = A.in[13][gi * 128 + lane + 64];
#pragma unroll
        for (int tk = 0; tk < 4; ++tk) { bf16* o = ((bf16*)(A.ws + WS_MIX)) + (size_t)(tok0 + tk) * DM + 512 + gi * 128;
            o[lane] = (bf16)f2bf(acc[tk][0] * s0); o[lane + 64] = (bf16)f2bf(acc[tk][1] * s1); }
    }
    __syncthreads();
}

__device__ __forceinline__ void p4_cmp_w2(const Frame& F, const Args& A) {
    LAS float* w2l = (LAS float*)F.lds;
    LAS float* hl = (LAS float*)(F.lds + 65536 + F.wave * 512);
    for (int i = F.tid; i < 2 * 128 * 64 / 4; i += NTHR) ((LAS f32x4*)w2l)[i] = ((const f32x4*)A.in[11])[i];
    __syncthreads();
    const int gw = F.bid * NWAVES + F.wave, NGW = F.G * NWAVES, lane = F.lane;
    for (int it = gw; it < 2 * CMP_R_END; it += NGW) {
        const int c = it / CMP_R_END, r = it % CMP_R_END;
        const float* hrow = ((float*)(A.ws + WS_HID)) + ((size_t)c * CMP_SEC + r) * 128;
        hl[lane] = hrow[lane]; hl[lane + 64] = hrow[lane + 64];
        LDS_WAIT(); asm volatile("" ::: "memory");
        float a = 0.f;
#pragma unroll 8
        for (int h = 0; h < 128; ++h) a += hl[h] * w2l[(c * 128 + h) * 64 + lane];
        float* dst;
        if (r < CMP_R_PROMPT) { const int b = r >> 9, n = (r & 511) >> 1, g = r & 1; dst = ((float*)(A.ws + WS_COMPS)) + ((((size_t)b * NBS + n) * 2 + g) * 2 + c) * 64; }
        else if (r < CMP_R_NEW) { const int q = r - CMP_R_PROMPT, b = q >> 7, n = (q & 127) >> 1, g = q & 1; dst = ((float*)(A.ws + WS_COMPP)) + ((((size_t)b * NBP + n) * 2 + g) * 2 + c) * 64; }
        else { const int q = r - CMP_R_NEW, b = q >> 1, g = q & 1; dst = ((float*)(A.ws + WS_COMPS)) + ((((size_t)b * NBS + 256) * 2 + g) * 2 + c) * 64; }
        dst[lane] = a;
        LDS_WAIT(); asm volatile("" ::: "memory");
    }
    __syncthreads();
}

namespace att {
typedef short bf16x8 __attribute__((ext_vector_type(8)));
typedef short s16x4 __attribute__((ext_vector_type(4)));
typedef float f32x16 __attribute__((ext_vector_type(16)));
typedef float f32x2 __attribute__((ext_vector_type(2)));
typedef __bf16 bf16x2v __attribute__((ext_vector_type(2)));
constexpr int KP = 144, VP = 192, BUFB = 64 * KP + 64 * VP;
constexpr int AT_T = 2 * BUFB, T_WAVE = 8704, AT_SCORE = AT_T + 8 * T_WAVE, AT_ML = AT_SCORE + 16384, AT_SEL = AT_ML + 2048, AT_UNI = AT_SEL + 4096, AT_TILES = AT_UNI + 64, AT_MISC = AT_TILES + 4096, AT_END = AT_MISC + 64;
static_assert(AT_END <= LDSCTL_OFF, "attention LDS map");
constexpr int NUNITS = 576;
struct TileEnt { unsigned long long base; int pitch, kpos0, kind, blk, nrows, n0; };
static_assert(sizeof(TileEnt) == 32, "TileEnt");
__device__ __forceinline__ unsigned cvtpk(float lo, float hi) { f32x2 a = {lo, hi}; return __builtin_bit_cast(unsigned, __builtin_convertvector(a, bf16x2v)); }
#define ATT_KR(r) (((r) & 3) + 8 * ((r) >> 2))
#define ATT_MFMA(a, b, c) __builtin_amdgcn_mfma_f32_32x32x16_bf16((a), (b), (c), 0, 0, 0)

__device__ __forceinline__ void attn_phase(const Frame& F, const Args& A, int qslot) {
#if defined(__HIP_DEVICE_COMPILE__)
    LAS unsigned char* L = F.lds;
    const int tid = F.tid, lane = F.lane, wave = F.wave;
    const int r32 = lane & 31, h = lane >> 5, tl = r32 >> 2, p = r32 & 3;
    unsigned* qctr = (unsigned*)(A.ws + WS_CTL) + CW_QUEUE + 64 * qslot;
    const float* PROJ = (const float*)(A.ws + WS_PROJ);
    LAS TileEnt* TILES = (LAS TileEnt*)(L + AT_TILES);
    volatile LAS int* MISC = (volatile LAS int*)(L + AT_MISC);
    LAS unsigned long long* UNI = (LAS unsigned long long*)(L + AT_UNI);
    LAS unsigned long long* SEL = (LAS unsigned long long*)(L + AT_SEL);
    LAS float* SCORE = (LAS float*)(L + AT_SCORE);
    LAS float* ML = (LAS float*)(L + AT_ML);
    for (;;) {
        __syncthreads();
        if (tid == 0) {
            const int unit = (int)__hip_atomic_fetch_add(qctr, 1u, __ATOMIC_RELAXED, __HIP_MEMORY_SCOPE_AGENT);
            MISC[0] = unit;
            for (int c = 0; c < 8; ++c) UNI[c] = 0ull;
            if (unit < NUNITS) {
                if (unit < 64) { const int b = unit >> 1, g = unit & 1;
                    for (int i = 0; i < 4; ++i) { TileEnt e; e.base = (unsigned long long)((const float*)(A.ws + WS_COMPS) + (((size_t)b * NBS + 64 * i) * 2 + g) * 128); e.pitch = 256; e.kpos0 = 0; e.kind = 0; e.blk = 0; e.nrows = 64; e.n0 = 64 * i; TILES[i] = e; }
                    MISC[1] = 4;
                } else { const int u2 = unit - 64, rem = u2 & 7, b = rem >> 1, g = rem & 1;
                    TileEnt e; e.base = (unsigned long long)((const float*)(A.ws + WS_COMPP) + (((size_t)b * NBP) * 2 + g) * 128); e.pitch = 256; e.kpos0 = 0; e.kind = 0; e.blk = 0; e.nrows = 64; e.n0 = 0; TILES[0] = e;
                    MISC[1] = 1;
                }
            }
        }
        __syncthreads();
        const int unit = MISC[0];
        if (unit >= NUNITS) break;
        const bool is_s = unit < 64;
        int b, g, qt;
        if (is_s) { b = unit >> 1; g = unit & 1; qt = 256; } else { const int u2 = unit - 64, rem = u2 & 7; qt = 63 - (u2 >> 3); b = rem >> 1; g = rem & 1; }
        const bool active = is_s ? (wave == 0) : true;
        const int cur = qt;
        const int tokrow = is_s ? (NPR + b * 8 + tl) : (b * SEQ + qt * 64 + wave * 8 + tl);
        const int qpos = is_s ? (PAST + tl) : (qt * 64 + wave * 8 + tl);
        const int mytok = is_s ? tl : (wave * 8 + tl);
        const int ncmp = is_s ? 4 : 1;
        const int TP = is_s ? 264 : 68;
        LAS float* Tm = (LAS float*)(L + AT_T + (is_s ? 0 : wave * T_WAVE));
        bf16x8 Q[4];
        float gate0 = 0.f, gate1 = 0.f, gate2 = 0.f;
        const float slope2 = exp2f(-(float)(g * 4 + p + 1)) * 1.4426950408889634f;
        if (active) {
            const float* prow = PROJ + (size_t)tokrow * PW;
            const float qs = 0.125f * 1.4426950408889634f;
#pragma unroll
            for (int ks = 0; ks < 4; ++ks) { const f32x4 a = *(const f32x4*)(prow + C_Q + g * 256 + p * 64 + 16 * ks + 8 * h), c = *(const f32x4*)(prow + C_Q + g * 256 + p * 64 + 16 * ks + 8 * h + 4);
                v4u w; w.x = cvtpk(a.x * qs, a.y * qs); w.y = cvtpk(a.z * qs, a.w * qs); w.z = cvtpk(c.x * qs, c.y * qs); w.w = cvtpk(c.z * qs, c.w * qs);
                Q[ks] = __builtin_bit_cast(bf16x8, w); }
            gate0 = 1.0f / (1.0f + __expf(-prow[C_G + 0 + g * 4 + p])); gate1 = 1.0f / (1.0f + __expf(-prow[C_G + 8 + g * 4 + p])); gate2 = 1.0f / (1.0f + __expf(-prow[C_G + 16 + g * 4 + p]));
        } else {
#pragma unroll
            for (int ks = 0; ks < 4; ++ks) Q[ks] = (bf16x8){0, 0, 0, 0, 0, 0, 0, 0};
        }
        f32x16 O0, O1, T0, T1;
#pragma unroll
        for (int i = 0; i < 16; ++i) { O0[i] = 0.f; O1[i] = 0.f; T0[i] = 0.f; T1[i] = 0.f; }
        float m_run = -1e20f, l_run = 0.f;
        int curkind = 0;
        int ntiles = ncmp;
        f32x4 R0, R1, R2, R3;
#define ATT_LOAD(idx) do { const TileEnt e_ = TILES[(idx)]; const float* bp_ = (const float*)e_.base; const int nr_ = e_.nrows - 1; \
            { const int f_ = tid;        int row_ = f_ >> 5; row_ = row_ < nr_ ? row_ : nr_; R0 = *(const f32x4*)(bp_ + (size_t)row_ * e_.pitch + (f_ & 31) * 4); } \
            { const int f_ = tid + 512;  int row_ = f_ >> 5; row_ = row_ < nr_ ? row_ : nr_; R1 = *(const f32x4*)(bp_ + (size_t)row_ * e_.pitch + (f_ & 31) * 4); } \
            { const int f_ = tid + 1024; int row_ = f_ >> 5; row_ = row_ < nr_ ? row_ : nr_; R2 = *(const f32x4*)(bp_ + (size_t)row_ * e_.pitch + (f_ & 31) * 4); } \
            { const int f_ = tid + 1536; int row_ = f_ >> 5; row_ = row_ < nr_ ? row_ : nr_; R3 = *(const f32x4*)(bp_ + (size_t)row_ * e_.pitch + (f_ & 31) * 4); } } while (0)
#define ATT_ST1(buf, f_, Rv) do { const int row_ = (f_) >> 5, c4_ = (f_) & 31; v2u o_; o_.x = cvtpk(Rv.x, Rv.y); o_.y = cvtpk(Rv.z, Rv.w); \
            const int off_ = (buf) * BUFB + (c4_ < 16 ? row_ * KP + c4_ * 8 : 64 * KP + row_ * VP + (c4_ - 16) * 8); *(LAS v2u*)(L + off_) = o_; } while (0)
#define ATT_STORE(buf) do { ATT_ST1(buf, tid, R0); ATT_ST1(buf, tid + 512, R1); ATT_ST1(buf, tid + 1024, R2); ATT_ST1(buf, tid + 1536, R3); } while (0)
        ATT_LOAD(0); ATT_STORE(0);
        __syncthreads();
        for (int i = 0; i < ntiles; ++i) {
            const int buf = i & 1;
            const bool has_next = (i + 1 < ntiles) && (i + 1 != ncmp);
            if (has_next) ATT_LOAD(i + 1);
            if (active) {
                const TileEnt e = TILES[i];
                const int kind = __builtin_amdgcn_readfirstlane(e.kind), kpos0 = __builtin_amdgcn_readfirstlane(e.kpos0), blk = __builtin_amdgcn_readfirstlane(e.blk), n0 = __builtin_amdgcn_readfirstlane(e.n0);
                if (kind != curkind) {
                    const float sc = gate1 / fmaxf(l_run, 1e-30f);
#pragma unroll
                    for (int r = 0; r < 16; ++r) { T0[r] += sc * O0[r]; T1[r] += sc * O1[r]; O0[r] = 0.f; O1[r] = 0.f; }
                    m_run = -1e20f; l_run = 0.f; curkind = kind;
                }
                int dq_hi, dq_lo = -1; float sstep = slope2, rowc;
                if (kind == 0) { dq_hi = (qpos - 63 - 64 * n0) >> 6; sstep = slope2 * 64.f; rowc = slope2 * (float)(64 * n0 + 63 - qpos); }
                else if (kind == 1) { const unsigned long long w = SEL[mytok * 8 + (blk >> 6)]; const bool sb = (w >> (blk & 63)) & 1ull; dq_hi = sb ? (qpos - kpos0) : -1; rowc = slope2 * (float)(kpos0 - qpos); }
                else { dq_hi = qpos - kpos0; dq_lo = qpos - 512 - kpos0; rowc = slope2 * (float)(kpos0 - qpos); }
                const bool lane_any = (dq_hi >= 0) && (dq_lo < 63);
                if (kind == 0 || __any(lane_any)) {
                    const LAS unsigned char* Kb = L + buf * BUFB; const LAS unsigned char* Vb = Kb + 64 * KP;
                    f32x16 X0, X1;
#pragma unroll
                    for (int r = 0; r < 16; ++r) { X0[r] = 0.f; X1[r] = 0.f; }
#pragma unroll
                    for (int ks = 0; ks < 4; ++ks) {
                        const bf16x8 a0 = *(const LAS bf16x8*)(Kb + r32 * KP + (16 * ks + 8 * h) * 2);
                        const bf16x8 a1 = *(const LAS bf16x8*)(Kb + (32 + r32) * KP + (16 * ks + 8 * h) * 2);
                        X0 = ATT_MFMA(a0, Q[ks], X0); X1 = ATT_MFMA(a1, Q[ks], X1);
                    }
                    const float cb = rowc + sstep * (float)(4 * h);
#pragma unroll
                    for (int r = 0; r < 16; ++r) { X0[r] += fmaf(sstep, (float)ATT_KR(r), cb); X1[r] += fmaf(sstep, (float)(32 + ATT_KR(r)), cb); }
                    const bool lane_full = (dq_hi >= 63) && (dq_lo < 0);
                    if (!__all(lane_full)) {
                        const int hi2 = dq_hi - 4 * h, lo2 = dq_lo - 4 * h;
#pragma unroll
                        for (int r = 0; r < 16; ++r) { const int k0 = ATT_KR(r), k1 = 32 + ATT_KR(r);
                            X0[r] = (k0 <= hi2 && k0 > lo2) ? X0[r] : -1e30f; X1[r] = (k1 <= hi2 && k1 > lo2) ? X1[r] : -1e30f; }
                    }
                    if (kind == 0) {
#pragma unroll
                        for (int q4 = 0; q4 < 4; ++q4) {
                            *(LAS f32x4*)(Tm + r32 * TP + n0 + 8 * q4 + 4 * h) = (f32x4){X0[4 * q4], X0[4 * q4 + 1], X0[4 * q4 + 2], X0[4 * q4 + 3]};
                            *(LAS f32x4*)(Tm + r32 * TP + n0 + 32 + 8 * q4 + 4 * h) = (f32x4){X1[4 * q4], X1[4 * q4 + 1], X1[4 * q4 + 2], X1[4 * q4 + 3]}; }
                    }
                    float mx = -1e30f;
#pragma unroll
                    for (int r = 0; r < 16; ++r) mx = fmaxf(mx, fmaxf(X0[r], X1[r]));
                    mx = fmaxf(mx, __shfl_xor(mx, 32));
                    const float m_new = fmaxf(m_run, mx);
                    if (__any(m_new > m_run)) {
                        const float alpha = exp2f(m_run - m_new);
#pragma unroll
                        for (int r = 0; r < 16; ++r) { O0[r] *= alpha; O1[r] *= alpha; }
                        l_run *= alpha; m_run = m_new;
                    }
                    float ls = 0.f;
#pragma unroll
                    for (int r = 0; r < 16; ++r) { X0[r] = __builtin_amdgcn_exp2f(X0[r] - m_run); X1[r] = __builtin_amdgcn_exp2f(X1[r] - m_run); ls += X0[r] + X1[r]; }
                    ls += __shfl_xor(ls, 32);
                    l_run += ls;
#pragma unroll
                    for (int kt = 0; kt < 2; ++kt) {
#pragma unroll
                        for (int s = 0; s < 2; ++s) {
                            v4u pw;
                            if (kt == 0) { pw.x = cvtpk(X0[8 * s], X0[8 * s + 1]); pw.y = cvtpk(X0[8 * s + 2], X0[8 * s + 3]); pw.z = cvtpk(X0[8 * s + 4], X0[8 * s + 5]); pw.w = cvtpk(X0[8 * s + 6], X0[8 * s + 7]); }
                            else         { pw.x = cvtpk(X1[8 * s], X1[8 * s + 1]); pw.y = cvtpk(X1[8 * s + 2], X1[8 * s + 3]); pw.z = cvtpk(X1[8 * s + 4], X1[8 * s + 5]); pw.w = cvtpk(X1[8 * s + 6], X1[8 * s + 7]); }
                            const bf16x8 pf = __builtin_bit_cast(bf16x8, pw);
                            const int key0 = kt * 32 + 16 * s + 4 * h, i16 = lane & 15, q = i16 >> 2, pp = i16 & 3, blk16 = (lane >> 4) & 1;
#pragma unroll
                            for (int dt = 0; dt < 2; ++dt) {
                                const LAS unsigned char* va = Vb + (key0 + q) * VP + (dt * 32 + 16 * blk16 + 4 * pp) * 2;
                                const s16x4 lo = __builtin_amdgcn_ds_read_tr16_b64_v4i16((LAS s16x4*)va);
                                const s16x4 hi = __builtin_amdgcn_ds_read_tr16_b64_v4i16((LAS s16x4*)(va + 8 * VP));
                                const bf16x8 vf = __builtin_shufflevector(lo, hi, 0, 1, 2, 3, 4, 5, 6, 7);
                                if (dt == 0) O0 = ATT_MFMA(vf, pf, O0); else O1 = ATT_MFMA(vf, pf, O1);
                            }
                        }
                    }
                }
            }
            if (has_next) ATT_STORE(buf ^ 1);
            __syncthreads();
            if (i + 1 == ncmp) {
                if (active) {
                    const float il = 1.0f / fmaxf(l_run, 1e-30f), sc = gate0 * il;
#pragma unroll
                    for (int r = 0; r < 16; ++r) { T0[r] += sc * O0[r]; T1[r] += sc * O1[r]; O0[r] = 0.f; O1[r] = 0.f; }
                    if (h == 0) { ML[(wave * 32 + r32) * 2] = m_run; ML[(wave * 32 + r32) * 2 + 1] = il; }
                    m_run = -1e20f; l_run = 0.f; curkind = 1;
                }
                __syncthreads();
                if (!is_s) {
                    const LAS float* Tw = (const LAS float*)(L + AT_T + wave * T_WAVE);
                    for (int k = 0; k < 8; ++k) { const int tok = wave * 8 + k, n = lane; float imp = 0.f;
#pragma unroll
                        for (int pq = 0; pq < 4; ++pq) { const int row = k * 4 + pq; imp += exp2f(Tw[row * 68 + n] - ML[(wave * 32 + row) * 2]) * ML[(wave * 32 + row) * 2 + 1]; }
                        float s = imp; if (n == 0 || n == cur || n == cur - 1) s = 5.0f; if (n > cur) s = -1.0f;
                        SCORE[tok * 64 + n] = s; }
                } else {
                    const LAS float* Tw = (const LAS float*)(L + AT_T);
                    const int tok = wave;
                    for (int c = 0; c < 5; ++c) { const int n = lane + 64 * c; if (n < 264) { float s;
                        if (n < 256) { float imp = 0.f;
#pragma unroll
                            for (int pq = 0; pq < 4; ++pq) { const int row = tok * 4 + pq; imp += exp2f(Tw[row * 264 + n] - ML[row * 2]) * ML[row * 2 + 1]; }
                            s = imp; if (n == 0 || n == 255) s = 5.0f; }
                        else if (n == 256) s = 5.0f; else s = -2.0f;
                        SCORE[tok * 264 + n] = s; } }
                }
                __syncthreads();
                if (!is_s) {
                    for (int k = 0; k < 8; ++k) { const int tok = wave * 8 + k, n = lane; const float sn = SCORE[tok * 64 + n]; int cnt = 0;
#pragma unroll 4
                        for (int m4 = 0; m4 < 16; ++m4) { const f32x4 sm = *(const LAS f32x4*)(SCORE + tok * 64 + 4 * m4);
                            cnt += (sm.x > sn || (sm.x == sn && 4 * m4 < n)) ? 1 : 0; cnt += (sm.y > sn || (sm.y == sn && 4 * m4 + 1 < n)) ? 1 : 0;
                            cnt += (sm.z > sn || (sm.z == sn && 4 * m4 + 2 < n)) ? 1 : 0; cnt += (sm.w > sn || (sm.w == sn && 4 * m4 + 3 < n)) ? 1 : 0; }
                        const unsigned long long bal = __ballot(n <= cur && cnt < 16);
                        if (lane == 0) { SEL[tok * 8] = bal; __hip_atomic_fetch_or(&UNI[0], bal, __ATOMIC_RELAXED, __HIP_MEMORY_SCOPE_WORKGROUP); } }
                } else {
                    const int tok = wave;
                    for (int c = 0; c < 5; ++c) { const int n = lane + 64 * c; const float sn = (n < 264) ? SCORE[tok * 264 + n] : -2.0f; int cnt = 0;
#pragma unroll 2
                        for (int m4 = 0; m4 < 66; ++m4) { const f32x4 sm = *(const LAS f32x4*)(SCORE + tok * 264 + 4 * m4);
                            cnt += (sm.x > sn || (sm.x == sn && 4 * m4 < n)) ? 1 : 0; cnt += (sm.y > sn || (sm.y == sn && 4 * m4 + 1 < n)) ? 1 : 0;
                            cnt += (sm.z > sn || (sm.z == sn && 4 * m4 + 2 < n)) ? 1 : 0; cnt += (sm.w > sn || (sm.w == sn && 4 * m4 + 3 < n)) ? 1 : 0; }
                        const unsigned long long bal = __ballot(n <= 256 && cnt < 16);
                        if (lane == 0) { SEL[tok * 8 + c] = bal; __hip_atomic_fetch_or(&UNI[c], bal, __ATOMIC_RELAXED, __HIP_MEMORY_SCOPE_WORKGROUP); } }
                }
                __syncthreads();
                if (tid == 0) {
                    int nt = ncmp;
                    for (int c = 4; c >= 0; --c) { unsigned long long w = UNI[c];
                        while (w) { const int bit = 63 - __builtin_clzll(w); w &= ~(1ull << bit); const int j = c * 64 + bit; TileEnt e; e.kind = 1; e.blk = j; e.kpos0 = j * 64; e.n0 = 0;
                            if (!is_s) { e.base = (unsigned long long)(PROJ + ((size_t)b * SEQ + j * 64) * PW + C_KS + g * 128); e.pitch = PW; e.nrows = 64; }
                            else if (j < 256) { const int page = ((const int*)A.in[6])[b * NPG + (j >> 1)]; e.base = (unsigned long long)(A.in[3] + ((size_t)page * 128 + (j & 1) * 64) * 256 + g * 128); e.pitch = 256; e.nrows = 64; }
                            else { e.base = (unsigned long long)(PROJ + ((size_t)NPR + b * 8) * PW + C_KS + g * 128); e.pitch = PW; e.nrows = 8; }
                            TILES[nt++] = e; } }
                    if (!is_s) { for (int tw = qt; tw >= 0 && tw >= qt - 8; --tw) { TileEnt e; e.kind = 2; e.blk = 0; e.n0 = 0; e.kpos0 = tw * 64; e.base = (unsigned long long)(PROJ + ((size_t)b * SEQ + tw * 64) * PW + C_KW + g * 128); e.pitch = PW; e.nrows = 64; TILES[nt++] = e; } }
                    else { { TileEnt e; e.kind = 2; e.blk = 0; e.n0 = 0; e.kpos0 = PAST; e.base = (unsigned long long)(PROJ + ((size_t)NPR + b * 8) * PW + C_KW + g * 128); e.pitch = PW; e.nrows = 8; TILES[nt++] = e; }
                        for (int ti = 7; ti >= 0; --ti) { TileEnt e; e.kind = 2; e.blk = 0; e.n0 = 0; e.kpos0 = PAST - 512 + ti * 64; e.base = (unsigned long long)(A.in[4] + ((size_t)b * 512 + ti * 64) * 256 + g * 128); e.pitch = 256; e.nrows = 64; TILES[nt++] = e; } }
                    MISC[1] = nt;
                }
                __syncthreads();
                ntiles = MISC[1];
                ATT_LOAD(i + 1); ATT_STORE(buf ^ 1);
                __syncthreads();
            }
        }
        if (active) {
            const float sc = gate2 / fmaxf(l_run, 1e-30f);
#pragma unroll
            for (int r = 0; r < 16; ++r) { T0[r] += sc * O0[r]; T1[r] += sc * O1[r]; }
            bf16* orow = (bf16*)(A.ws + WS_MIX) + (size_t)tokrow * DM + g * 256 + p * 64;
#pragma unroll
            for (int q4 = 0; q4 < 4; ++q4) {
                v2u o; o.x = cvtpk(T0[4 * q4], T0[4 * q4 + 1]); o.y = cvtpk(T0[4 * q4 + 2], T0[4 * q4 + 3]); *(v2u*)(orow + 8 * q4 + 4 * h) = o;
                v2u o2; o2.x = cvtpk(T1[4 * q4], T1[4 * q4 + 1]); o2.y = cvtpk(T1[4 * q4 + 2], T1[4 * q4 + 3]); *(v2u*)(orow + 32 + 8 * q4 + 4 * h) = o2; }
        }
    }
#undef ATT_LOAD
#undef ATT_ST1
#undef ATT_STORE
#endif
}
#undef ATT_KR
#undef ATT_MFMA
}

namespace cmpk {
typedef short bf16x8 __attribute__((ext_vector_type(8)));
typedef float f32x16 __attribute__((ext_vector_type(16)));
constexpr int AP = 144, A_BYTES = 128 * AP, B_BYTES = 256 * AP, STG = A_BYTES + B_BYTES;
static_assert(2 * STG <= LDSCTL_OFF && 131072 <= LDSCTL_OFF, "compress LDS map");
constexpr int NUNITS_PAST = 256, NUNITS_ALL = 265;
__device__ __forceinline__ void cmp_unit(const Frame& F, const Args& A, int unit) {
#if defined(__HIP_DEVICE_COMPILE__)
    LAS unsigned char* L = F.lds;
    const int tid = F.tid, lane = F.lane, wave = F.wave, r32 = lane & 31, h = lane >> 5;
    const float* PROJ = (const float*)(A.ws + WS_PROJ);
    const int* pt = (const int*)A.in[6];
    const float* bp0; const float* bp1; const float* bp2; const float* bp3; int pitch, nvalid;
    {
        const float* bpp[4];
#pragma unroll
        for (int i = 0; i < 4; ++i) { const int blk = wave + 8 * i;
            if (unit < 256) { const int b = unit >> 3, n = (unit & 7) * 32 + blk; const int page = pt[b * NPG + (n >> 1)]; bpp[i] = A.in[2] + ((size_t)page * 128 + (n & 1) * 64) * 256; }
            else if (unit < 264) { const int pu = unit - 256, b = pu >> 1, n = (pu & 1) * 32 + blk; bpp[i] = PROJ + ((size_t)b * SEQ + n * 64) * PW + C_KC; }
            else bpp[i] = PROJ + ((size_t)NPR + blk * 8) * PW + C_KC; }
        bp0 = bpp[0]; bp1 = bpp[1]; bp2 = bpp[2]; bp3 = bpp[3];
        pitch = unit < 256 ? 256 : PW; nvalid = unit < 264 ? 64 : 8;
    }
    const int gc = lane >> 4, g = gc >> 1, c = gc & 1, d0 = (lane & 15) * 4;
    const float* pep = A.in[9] + c * 64 + d0;
    const int a_off = (c * 64 + wave * 2 + g) * AP + d0 * 2;
    const bf16* bsrc = (const bf16*)(A.ws + WS_W1S) + (size_t)(tid >> 3) * 4096 + (tid & 7) * 8;
    const int b_off = A_BYTES + (tid >> 3) * AP + (tid & 7) * 16;
    const int cw = wave >> 2, rh = (wave >> 1) & 1, ch = wave & 1;
    const int fa_off = (cw * 64 + rh * 32 + r32) * AP + 16 * h, fb_off = A_BYTES + (cw * 128 + ch * 64 + r32) * AP + 16 * h;
    f32x16 acc0, acc1;
#pragma unroll
    for (int r = 0; r < 16; ++r) { acc0[r] = 0.f; acc1[r] = 0.f; }
    f32x4 RA0[4], RA1[4], RP0, RP1; v4u RB[4];
    const f32x4 z4 = {0.f, 0.f, 0.f, 0.f};
#define CK_LA(l, RA, RP) do { const size_t ro_ = (size_t)(l) * pitch + lane * 4; const bool ok_ = (l) < nvalid; \
        RA[0] = ok_ ? *(const f32x4*)(bp0 + ro_) : z4; RA[1] = ok_ ? *(const f32x4*)(bp1 + ro_) : z4; RA[2] = ok_ ? *(const f32x4*)(bp2 + ro_) : z4; RA[3] = ok_ ? *(const f32x4*)(bp3 + ro_) : z4; \
        RP = *(const f32x4*)(pep + (l) * 128); } while (0)
#define CK_LB(l) do { _Pragma("unroll") for (int i_ = 0; i_ < 4; ++i_) RB[i_] = *(const v4u*)(bsrc + (size_t)i_ * 64 * 4096 + (l) * 64); } while (0)
#define CK_SA(buf, RA, RP) do { _Pragma("unroll") for (int i_ = 0; i_ < 4; ++i_) { const f32x4 v_ = RA[i_] + RP; v2u o_; o_.x = att::cvtpk(v_.x, v_.y); o_.y = att::cvtpk(v_.z, v_.w); \
        *(LAS v2u*)(L + (buf) * STG + a_off + i_ * 16 * AP) = o_; } } while (0)
#define CK_SB(buf) do { _Pragma("unroll") for (int i_ = 0; i_ < 4; ++i_) *(LAS v4u*)(L + (buf) * STG + b_off + i_ * 64 * AP) = RB[i_]; } while (0)
#define CK_MMA(buf) do { _Pragma("unroll") for (int ks_ = 0; ks_ < 4; ++ks_) { \
        const bf16x8 a_ = *(const LAS bf16x8*)(L + (buf) * STG + fa_off + 32 * ks_); \
        const bf16x8 b0_ = *(const LAS bf16x8*)(L + (buf) * STG + fb_off + 32 * ks_); const bf16x8 b1_ = *(const LAS bf16x8*)(L + (buf) * STG + fb_off + 32 * AP + 32 * ks_); \
        acc0 = __builtin_amdgcn_mfma_f32_32x32x16_bf16(a_, b0_, acc0, 0, 0, 0); acc1 = __builtin_amdgcn_mfma_f32_32x32x16_bf16(a_, b1_, acc1, 0, 0, 0); } } while (0)
    __syncthreads();
    CK_LA(0, RA0, RP0); CK_LA(1, RA1, RP1); CK_LB(0);
    CK_SA(0, RA0, RP0); CK_SB(0); CK_LA(2, RA0, RP0); CK_LB(1);
    __syncthreads();
    for (int l = 0; l < 64; l += 2) {
        CK_MMA(0);
        CK_SA(1, RA1, RP1); CK_SB(1);
        if (l + 3 < 64) CK_LA(l + 3, RA1, RP1);
        if (l + 2 < 64) CK_LB(l + 2);
        __syncthreads();
        CK_MMA(1);
        if (l + 2 < 64) { CK_SA(0, RA0, RP0); CK_SB(0); }
        if (l + 4 < 64) CK_LA(l + 4, RA0, RP0);
        if (l + 3 < 64) CK_LB(l + 3);
        __syncthreads();
    }
#undef CK_LA
#undef CK_LB
#undef CK_SA
#undef CK_SB
#undef CK_MMA
    LAS float* HL = (LAS float*)L; LAS float* W2L = (LAS float*)(L + 65536);
#pragma unroll
    for (int r = 0; r < 16; ++r) { const int row = rh * 32 + (r & 3) + 8 * (r >> 2) + 4 * h;
        HL[(cw * 64 + row) * 128 + ch * 64 + r32] = pg8::gelu_tanh(acc0[r]); HL[(cw * 64 + row) * 128 + ch * 64 + 32 + r32] = pg8::gelu_tanh(acc1[r]); }
    for (int i = tid; i < 2 * 128 * 64 / 4; i += NTHR) ((LAS f32x4*)W2L)[i] = ((const f32x4*)A.in[11])[i];
    __syncthreads();
    {
        const int c2 = wave >> 2, row0 = (wave & 3) * 16;
        float o[16];
#pragma unroll
        for (int rr = 0; rr < 16; ++rr) o[rr] = 0.f;
        for (int h4 = 0; h4 < 32; ++h4) {
            const float w0 = W2L[(c2 * 128 + 4 * h4) * 64 + lane], w1 = W2L[(c2 * 128 + 4 * h4 + 1) * 64 + lane], w2 = W2L[(c2 * 128 + 4 * h4 + 2) * 64 + lane], w3 = W2L[(c2 * 128 + 4 * h4 + 3) * 64 + lane];
#pragma unroll
            for (int rr = 0; rr < 16; ++rr) { const f32x4 hv = *(const LAS f32x4*)(HL + (c2 * 64 + row0 + rr) * 128 + 4 * h4); o[rr] += (hv.x * w0 + hv.y * w1) + (hv.z * w2 + hv.w * w3); }
        }
#pragma unroll
        for (int rr = 0; rr < 16; ++rr) { const int row = row0 + rr, blk = row >> 1, gg = row & 1; float* dst;
            if (unit < 256) { const int b = unit >> 3, n = (unit & 7) * 32 + blk; dst = (float*)(A.ws + WS_COMPS) + ((((size_t)b * NBS + n) * 2 + gg) * 2 + c2) * 64; }
            else if (unit < 264) { const int pu = unit - 256, b = pu >> 1, n = (pu & 1) * 32 + blk; dst = (float*)(A.ws + WS_COMPP) + ((((size_t)b * NBP + n) * 2 + gg) * 2 + c2) * 64; }
            else dst = (float*)(A.ws + WS_COMPS) + ((((size_t)blk * NBS + 256) * 2 + gg) * 2 + c2) * 64;
            dst[lane] = o[rr]; }
    }
    __syncthreads();
#endif
}
}


__device__ __forceinline__ void p7_hb(const Frame& F, const Args& A) {
    const int gw = F.bid * NWAVES + F.wave, NGW = F.G * NWAVES;
    for (int m = gw; m < MTOK; m += NGW) rms_row_to_bf16(((float*)(A.ws + WS_H)) + (size_t)m * DM, A.in[15], ((bf16*)(A.ws + WS_HB)) + (size_t)m * DM, F.lane);
}
__device__ __forceinline__ void p10_final(const Frame& F, const Args& A) {
    const int gw = F.bid * NWAVES + F.wave, NGW = F.G * NWAVES, lane = F.lane;
    for (int m = gw; m < MTOK; m += NGW) {
        f32x4* xr = (f32x4*)(A.out + (size_t)m * DM) + lane; const f32x4* gr = (const f32x4*)A.in[18] + lane;
        f32x4 v[4]; float s = 0.f;
#pragma unroll
        for (int j = 0; j < 4; ++j) { v[j] = xr[64 * j]; s += (v[j].x * v[j].x + v[j].y * v[j].y) + (v[j].z * v[j].z + v[j].w * v[j].w); }
        const float rstd = 1.0f / sqrtf(wave_sum(s) * (1.f / DM) + 1e-6f);
#pragma unroll
        for (int j = 0; j < 4; ++j) xr[64 * j] = v[j] * rstd * gr[64 * j];
    }
}

__global__ void __launch_bounds__(NTHR, 2) fwd_kernel(Args A) {
    extern __shared__ __attribute__((aligned(16))) unsigned char lds_raw[];
    Frame F;
    F.lds = (LAS unsigned char*)lds_raw;
    F.tid = threadIdx.x; F.lane = F.tid & 63; F.wave = __builtin_amdgcn_readfirstlane(F.tid >> 6); F.G = gridDim.x; F.bid = blockIdx.x;
    unsigned char* ws = A.ws;
    for (int u = F.tid; u < (LDS_BYTES - LDSCTL_OFF) / 4; u += NTHR) ((LAS unsigned*)(F.lds + LDSCTL_OFF))[u] = 0u;
    __syncthreads();
    const int lo = A.ph_lo, hi = A.ph_hi;
    const bool multi = (hi - lo) > 1;
    XcdBarrier bar; bar.bar = (unsigned*)(ws + WS_CTL) + CW_BAR; bar.x = 0; bar.st = nullptr;
    if (multi) bar = xcd_barrier_post((unsigned*)(ws + WS_CTL) + CW_BAR, (volatile LAS unsigned*)(F.lds + MISC_OFF));
#define IN(k) (lo <= (k) && (k) < hi)
#define SEAM(k) do { if (IN(k) && IN((k) + 1)) xcd_barrier(bar); } while (0)

#ifndef REP_PHASE
#define REP_PHASE -1
#endif
#define RUN(k, ...) if (IN(k)) { __VA_ARGS__; if (REP_PHASE == (k)) { xcd_barrier(bar); __VA_ARGS__; } } SEAM(k)
#define GEMM_BODY(EPI, Aptr, Bptr, M_, N_, K_, ...) do { pg8::Gemm g{Aptr, Bptr, M_, N_, K_}; pg8::StaticOrder S; S.init(M_, N_, F.G, F.bid); pg8::EPI E{__VA_ARGS__}; pg8::gemm_phase<pg8::EPI, pg8::StaticOrder>(F.lds, g, S, E, nullptr); } while (0)
    RUN(0, p0_prologue(F, A));
    RUN(1, do { for (int u = F.bid; u < cmpk::NUNITS_PAST; u += F.G) cmpk::cmp_unit(F, A, u);
                GEMM_BODY(EpiF32, ((bf16*)(A.ws + WS_XN)), ((bf16*)(A.ws + WS_WIN)), MTOK, PW, DM, ((float*)(A.ws + WS_PROJ)), PW); } while (0));
    RUN(2, do { for (int u = cmpk::NUNITS_PAST + F.bid; u < cmpk::NUNITS_ALL; u += F.G) cmpk::cmp_unit(F, A, u); p2_copies(F, A); p2_pool(F, A); } while (0));
    if (IN(3)) { att::attn_phase(F, A, 0); if (REP_PHASE == 3) { xcd_barrier(bar); att::attn_phase(F, A, 1); } } SEAM(3);
    RUN(4, GEMM_BODY(EpiResF32, ((bf16*)(A.ws + WS_MIX)), ((bf16*)(A.ws + WS_WOUT)), MTOK, DM, DM, A.in[0], A.in[1], NPR / 256, ((float*)(A.ws + WS_H)), DM));
    RUN(5, p7_hb(F, A));
    RUN(6, GEMM_BODY(EpiRelu2Bf16, ((bf16*)(A.ws + WS_HB)), ((bf16*)(A.ws + WS_WUP)), MTOK, DFF, DM, ((bf16*)(A.ws + WS_ACT)), DFF));
    RUN(7, GEMM_BODY(EpiResF32, ((bf16*)(A.ws + WS_ACT)), ((bf16*)(A.ws + WS_WDN)), MTOK, DM, DFF, ((float*)(A.ws + WS_H)), ((float*)(A.ws + WS_H)), 1 << 20, A.out, DM));
    if (IN(8)) { p10_final(F, A); }
#undef IN
#undef SEAM
}

#ifndef MK_ONE_LAUNCH
#define MK_ONE_LAUNCH 1
#endif
extern "C" void kernel_launch(void* const* d_in, const int* in_sizes, int n_in, void* d_out, int out_size, void* d_ws, size_t ws_size, hipStream_t stream) {
    static int grid = 0;
    if (grid == 0) {
        if (n_in != 19 || (size_t)out_size != O_END || ws_size < WS_END) { fprintf(stderr, "kernel_launch: unexpected shapes n_in %d out %d ws %zu\n", n_in, out_size, ws_size); grid = -1; return; }
        int dev = 0, cus = 0, per_cu = 0;
        if (hipGetDevice(&dev) != hipSuccess || hipDeviceGetAttribute(&cus, hipDeviceAttributeMultiprocessorCount, dev) != hipSuccess) { grid = -1; return; }
        if (hipFuncSetAttribute((const void*)fwd_kernel, hipFuncAttributeMaxDynamicSharedMemorySize, LDS_BYTES) != hipSuccess) { fprintf(stderr, "kernel_launch: hipFuncSetAttribute failed\n"); grid = -1; return; }
        if (hipOccupancyMaxActiveBlocksPerMultiprocessor(&per_cu, (const void*)fwd_kernel, NTHR, LDS_BYTES) != hipSuccess || per_cu < 1) fprintf(stderr, "kernel_launch: occupancy query says %d\n", per_cu);
        (void)hipGetLastError();
        grid = cus;
    }
    if (grid < 0) return;
    if (hipMemsetAsync((char*)d_ws + WS_CTL, 0, CTL_ZERO_BYTES, stream) != hipSuccess) return;
    Args a{};
    for (int i = 0; i < 19; ++i) a.in[i] = (const float*)d_in[i];
    a.out = (float*)d_out; a.ws = (unsigned char*)d_ws;
#if MK_ONE_LAUNCH
    a.ph_lo = 0; a.ph_hi = NPHASES;
    hipLaunchKernelGGL(fwd_kernel, dim3(grid), dim3(NTHR), LDS_BYTES, stream, a);
#else
    for (int p = 0; p < NPHASES; ++p) { a.ph_lo = p; a.ph_hi = p + 1; hipLaunchKernelGGL(fwd_kernel, dim3(grid), dim3(NTHR), LDS_BYTES, stream, a); }
#endif
}
```

```cpp
#include <hip/hip_runtime.h>
#include <cstdio>
#include <cstdint>
namespace pg8 {
#define PG8_LAS __attribute__((address_space(3)))
typedef unsigned short bf16_t;
typedef short bf16x8 __attribute__((ext_vector_type(8)));
typedef float f32x4 __attribute__((ext_vector_type(4)));
typedef unsigned u32x4 __attribute__((ext_vector_type(4)));
constexpr int BM = 256, BK = 64, HALF = 128, HTB = HALF * BK * 2  , STAGE_BYTES = 8 * HTB, NXCD = 8, WGM = 8;

__host__ __device__ __forceinline__ int lds_byte(int r, int c) { const int st = (r >> 4) * 2 + (c >> 5), rr = r & 15, cc = c & 31, ob = rr * 64 + cc * 2; return st * 1024 + (ob ^ (((ob >> 9) & 1) << 5)); }
__host__ __device__ __forceinline__ void stage_rc(int b, int& R, int& C) { const int st = b / 1024, sb = b % 1024, swz = sb ^ (((sb >> 9) & 1) << 5); R = (st >> 1) * 16 + swz / 64; C = (st & 1) * 32 + (swz % 64) / 2; }
__host__ __device__ __forceinline__ int perm32(int rho) { const int n = rho >> 4, i = rho & 15; return 8 * (i >> 2) + 4 * n + (i & 3); }

struct Unit { int pm, pn; };
struct Gemm { const bf16_t* A; const bf16_t* Bt; int M, N, K; };

struct StaticOrder {
    int nM, nN, nwg, G, c;
    __host__ __device__ void init(int M, int N, int G_, int c_) { nM = M / BM; nN = N / BM; nwg = nM * nN; G = G_; c = c_; }
    __host__ __device__ bool next(int i, Unit& u) const {
        const long L = (long)i * G + c; if (L >= nwg) return false;
        int wgid = (int)L; { const int q = nwg / NXCD, r = nwg % NXCD, xcd = wgid % NXCD, off = wgid / NXCD; wgid = (xcd < r ? xcd * (q + 1) : r * (q + 1) + (xcd - r) * q) + off; }
        const int nig = WGM * nN, gid = wgid / nig, fm = gid * WGM, gsz = (nM - fm) < WGM ? (nM - fm) : WGM;
        u.pm = fm + ((wgid % nig) % gsz); u.pn = (wgid % nig) / gsz; return true;
    }
    __device__ __forceinline__ void a_ready(const Unit&) const {}
    __device__ __forceinline__ void done(const Unit&) const {}
};
struct CountedOrder : StaticOrder {
    const unsigned* ready; unsigned need; unsigned* tmo;
    __device__ __forceinline__ void a_ready(const Unit& u) const {
        if (threadIdx.x < 64) {
            const unsigned long long t0 = __builtin_amdgcn_s_memrealtime(); unsigned polls = 0;
            while ((unsigned)__builtin_amdgcn_readfirstlane(__hip_atomic_load(ready + 64 * u.pm, __ATOMIC_RELAXED, __HIP_MEMORY_SCOPE_AGENT)) < need) {
                if ((++polls & 255u) == 0u && __builtin_amdgcn_readfirstlane(__hip_atomic_load(tmo, __ATOMIC_RELAXED, __HIP_MEMORY_SCOPE_AGENT)) != 0u) break;
                if (__builtin_amdgcn_s_memrealtime() - t0 > 2000000ull) {
                    if (threadIdx.x == 0) { unsigned expect = 0u; __hip_atomic_compare_exchange_strong(tmo + 1, &expect, 0x600u | (unsigned)(u.pm & 0xff), __ATOMIC_RELAXED, __ATOMIC_RELAXED, __HIP_MEMORY_SCOPE_AGENT); __hip_atomic_store(tmo, 1u, __ATOMIC_RELAXED, __HIP_MEMORY_SCOPE_AGENT); }
                    break; }
                __builtin_amdgcn_s_sleep(2); }
            __builtin_amdgcn_fence(__ATOMIC_ACQUIRE, "agent");
            asm volatile("s_waitcnt vmcnt(0)" ::: "memory");
        }
#if !defined(BROKEN_HOOK_NO_BARRIER)
        asm volatile("" ::: "memory"); __builtin_amdgcn_s_barrier(); asm volatile("" ::: "memory");
#endif
    }
};

__device__ __forceinline__ unsigned cvt_pk_bf16(float lo, float hi) { unsigned r; asm volatile("v_cvt_pk_bf16_f32 %0, %1, %2" : "=v"(r) : "v"(lo), "v"(hi)); return r; }
struct EpiF32 {
    static constexpr bool PERM = false, AFTER_DRAIN = false;
    float* C; int ldc;
    __device__ __forceinline__ void operator()(const f32x4 (&acc)[2][2][4][2], const Unit& u, int wr, int wc, int fr, int fq) const {
        const int row0 = u.pm * BM + wr * 64 + fr, col0 = u.pn * BM + wc * 32 + 4 * fq;
#pragma unroll
        for (int ai = 0; ai < 2; ++ai)
#pragma unroll
            for (int m = 0; m < 4; ++m) { float* rowp = C + (size_t)(row0 + ai * HALF + m * 16) * ldc + col0;
#pragma unroll
                for (int bj = 0; bj < 2; ++bj)
#pragma unroll
                    for (int n = 0; n < 2; ++n) *(f32x4*)(rowp + bj * HALF + n * 16) = acc[ai][bj][m][n]; }
    }
};
struct EpiResF32 {
    static constexpr bool PERM = false, AFTER_DRAIN = false;
    const float* base0; const float* base1; int split; float* out; int ldc;
    __device__ __forceinline__ void operator()(const f32x4 (&acc)[2][2][4][2], const Unit& u, int wr, int wc, int fr, int fq) const {
        const int row0 = u.pm * BM + wr * 64 + fr, col0 = u.pn * BM + wc * 32 + 4 * fq;
        const float* bb = (u.pm < split) ? base0 : (base1 - (size_t)split * BM * ldc);
#pragma unroll
        for (int ai = 0; ai < 2; ++ai)
#pragma unroll
            for (int m = 0; m < 4; ++m) { const size_t off = (size_t)(row0 + ai * HALF + m * 16) * ldc + col0;
#pragma unroll
                for (int bj = 0; bj < 2; ++bj)
#pragma unroll
                    for (int n = 0; n < 2; ++n) { const f32x4 b = *(const f32x4*)(bb + off + bj * HALF + n * 16); *(f32x4*)(out + off + bj * HALF + n * 16) = acc[ai][bj][m][n] + b; } }
    }
};
struct EpiRelu2Bf16 {
    static constexpr bool PERM = true, AFTER_DRAIN = false;
    bf16_t* O; int ldc;
    __device__ __forceinline__ void operator()(const f32x4 (&acc)[2][2][4][2], const Unit& u, int wr, int wc, int fr, int fq) const {
        const int row0 = u.pm * BM + wr * 64 + fr, col0 = u.pn * BM + wc * 32 + 8 * fq;
#pragma unroll
        for (int ai = 0; ai < 2; ++ai)
#pragma unroll
            for (int m = 0; m < 4; ++m) { bf16_t* rowp = O + (size_t)(row0 + ai * HALF + m * 16) * ldc + col0;
#pragma unroll
                for (int bj = 0; bj < 2; ++bj) { f32x4 v0 = acc[ai][bj][m][0], v1 = acc[ai][bj][m][1];
#pragma unroll
                    for (int j = 0; j < 4; ++j) { const float a = fmaxf(v0[j], 0.f), b = fmaxf(v1[j], 0.f); v0[j] = a * a; v1[j] = b * b; }
                    u32x4 w; w.x = cvt_pk_bf16(v0[0], v0[1]); w.y = cvt_pk_bf16(v0[2], v0[3]); w.z = cvt_pk_bf16(v1[0], v1[1]); w.w = cvt_pk_bf16(v1[2], v1[3]);
                    *(u32x4*)(rowp + bj * HALF) = w; } }
    }
};
__device__ __forceinline__ float gelu_tanh(float x) {
    const float y = 0.7978845608028654f * (x + 0.044715f * x * x * x);
    const float t = 1.0f - 2.0f / (__expf(2.0f * y) + 1.0f);
    return 0.5f * x * (1.0f + t);
}
struct EpiCmpHid {
    static constexpr bool PERM = false, AFTER_DRAIN = false;
    float* H; int csplit;
    __device__ __forceinline__ void operator()(const f32x4 (&acc)[2][2][4][2], const Unit& u, int wr, int wc, int fr, int fq) const {
        const int row0 = u.pm * BM + wr * 64 + fr, col0 = wc * 32 + 4 * fq;
        const bool c1 = u.pm >= csplit;
#pragma unroll
        for (int ai = 0; ai < 2; ++ai)
#pragma unroll
            for (int m = 0; m < 4; ++m) { float* rowp = H + (size_t)(row0 + ai * HALF + m * 16) * 128 + col0;
#pragma unroll
                for (int n = 0; n < 2; ++n) { f32x4 v = c1 ? acc[ai][1][m][n] : acc[ai][0][m][n];
#pragma unroll
                    for (int j = 0; j < 4; ++j) v[j] = gelu_tanh(v[j]);
                    *(f32x4*)(rowp + n * 16) = v; } }
    }
};
template <class Epi, class Sched, bool STAMP = false>
__device__ __forceinline__ void gemm_phase(PG8_LAS unsigned char* lds, const Gemm g, const Sched& S, const Epi& E, unsigned long long* stamps) {
    const int tid = threadIdx.x, wid = __builtin_amdgcn_readfirstlane(tid >> 6), lane = tid & 63, wr = wid >> 2, wc = wid & 3, fr = lane & 15, fq = lane >> 4;
    const int K = g.K, nt = K / BK;
    int ts_lo = 0, ts_hi = 0, nts = 0; const unsigned long long rt_entry = STAMP ? (unsigned long long)wall_clock64() : 0ull;
#define PG8_STAMP() do { if (STAMP && wid == 0 && nts < 64) { const unsigned long long _c = (unsigned long long)clock64(); \
        ts_lo = (lane == nts) ? (int)(unsigned)_c : ts_lo; ts_hi = (lane == nts) ? (int)(unsigned)(_c >> 32) : ts_hi; ++nts; } } while (0)
    PG8_STAMP();
    unsigned voffA[2], voffB[2];
#pragma unroll
    for (int i = 0; i < 2; ++i) { int R, C; stage_rc(tid * 16 + i * 8192, R, C); const int Rb = Epi::PERM ? ((R & ~31) + perm32(R & 31)) : R;
        voffA[i] = (unsigned)(R * K + C) * 2u; voffB[i] = (unsigned)(Rb * K + C) * 2u; }
    const size_t kstep = (size_t)(BK * 2);
    const size_t hstep = (size_t)HALF * K * 2;
    const size_t tstep = 2 * hstep;
    const unsigned ldsw = (unsigned)wid * 1024u;
    const int aoff = lds_byte(wr * 64 + fr, fq * 8), boff = lds_byte(wc * 32 + fr, fq * 8);
#define PG8_SA(b, h) (((b) * 2 + (h)) * HTB)
#define PG8_SB(b, h) ((4 + (b) * 2 + (h)) * HTB)
#define PG8_STAGE(bufoff, gbase, voff) do { _Pragma("unroll") for (int _i = 0; _i < 2; ++_i) \
        __builtin_amdgcn_global_load_lds((const unsigned*)((const char*)(gbase) + (voff)[_i]), (PG8_LAS unsigned*)(lds + (bufoff) + ldsw + _i * 8192), 16, 0, 0); } while (0)
#define PG8_LDA(dst, b, h) do { _Pragma("unroll") for (int m = 0; m < 4; ++m) _Pragma("unroll") for (int k = 0; k < 2; ++k) dst[m][k] = *(const PG8_LAS bf16x8*)(lds + PG8_SA(b, h) + aoff + m * 2048 + k * 1024); } while (0)
#define PG8_LDB(dst, b, h) do { _Pragma("unroll") for (int n = 0; n < 2; ++n) _Pragma("unroll") for (int k = 0; k < 2; ++k) dst[n][k] = *(const PG8_LAS bf16x8*)(lds + PG8_SB(b, h) + boff + n * 2048 + k * 1024); } while (0)
#define PG8_MMA(ai, bj, At, Bt) do { __builtin_amdgcn_s_setprio(1); _Pragma("unroll") for (int m = 0; m < 4; ++m) _Pragma("unroll") for (int n = 0; n < 2; ++n) _Pragma("unroll") for (int k = 0; k < 2; ++k) \
        acc[ai][bj][m][n] = __builtin_amdgcn_mfma_f32_16x16x32_bf16(Bt[n][k], At[m][k], acc[ai][bj][m][n], 0, 0, 0); __builtin_amdgcn_s_setprio(0); } while (0)
#define PG8_WAIT_V(n) asm volatile("s_waitcnt vmcnt(" #n ")" ::: "memory")
#define PG8_WAIT_L(n) asm volatile("s_waitcnt lgkmcnt(" #n ")" ::: "memory")
#define PG8_BAR __builtin_amdgcn_s_barrier()
#define PG8_SCHED __builtin_amdgcn_sched_barrier(0)
    Unit cur, nxt; int ui = 0;
    if (!S.next(0, cur)) return;
    f32x4 acc[2][2][4][2];
#pragma unroll
    for (int a = 0; a < 2; ++a)
#pragma unroll
        for (int b = 0; b < 2; ++b)
#pragma unroll
            for (int m = 0; m < 4; ++m)
#pragma unroll
                for (int n = 0; n < 2; ++n) acc[a][b][m][n] = (f32x4){0.f, 0.f, 0.f, 0.f};
    bf16x8 At[4][2], B0[2][2], B1[2][2];
    const char* cA = (const char*)g.A + (size_t)cur.pm * tstep; const char* cB = (const char*)g.Bt + (size_t)cur.pn * tstep;
    S.a_ready(cur);
    PG8_STAGE(PG8_SB(0, 0), cB, voffB); PG8_STAGE(PG8_SA(0, 0), cA, voffA); PG8_STAGE(PG8_SB(0, 1), cB + hstep, voffB); PG8_STAGE(PG8_SA(0, 1), cA + hstep, voffA);
    if (wr == 1) PG8_BAR;
    PG8_WAIT_V(4); PG8_BAR;
    PG8_STAGE(PG8_SB(1, 0), cB + kstep, voffB); PG8_STAGE(PG8_SA(1, 0), cA + kstep, voffA); PG8_STAGE(PG8_SB(1, 1), cB + hstep + kstep, voffB);
    PG8_WAIT_V(6); PG8_BAR;
    PG8_STAMP();
    for (;;) {
        const bool has_next = S.next(ui + 1, nxt);
        const char* nA = has_next ? (const char*)g.A + (size_t)nxt.pm * tstep : cA; const char* nB = has_next ? (const char*)g.Bt + (size_t)nxt.pn * tstep : cB;
        for (int t = 0; t < nt; t += 2) {
            const bool last = (t == nt - 2);
            const char* a1 = cA + (size_t)(t + 1) * kstep;
            const char* a2 = last ? nA : cA + (size_t)(t + 2) * kstep; const char* b2 = last ? nB : cB + (size_t)(t + 2) * kstep;
            const char* a3 = a2 + kstep; const char* b3 = b2 + kstep;
            if (last && has_next) S.a_ready(nxt);
            PG8_LDB(B0, 0, 0); PG8_SCHED; PG8_LDA(At, 0, 0); PG8_STAGE(PG8_SA(1, 1), a1 + hstep, voffA);
            PG8_WAIT_L(8); PG8_BAR; PG8_WAIT_L(0); PG8_MMA(0, 0, At, B0); PG8_BAR; PG8_SCHED;
            PG8_LDB(B1, 0, 1); PG8_STAGE(PG8_SB(0, 0), b2, voffB);
            PG8_BAR; PG8_WAIT_L(0); PG8_MMA(0, 1, At, B1); PG8_BAR;
            PG8_LDA(At, 0, 1); PG8_STAGE(PG8_SA(0, 0), a2, voffA);
            PG8_BAR; PG8_WAIT_L(0); PG8_MMA(1, 0, At, B0); PG8_BAR; PG8_SCHED;
            PG8_STAGE(PG8_SB(0, 1), b2 + hstep, voffB);
            PG8_WAIT_V(6); PG8_BAR; PG8_MMA(1, 1, At, B1); PG8_BAR;
            PG8_LDB(B0, 1, 0); PG8_SCHED; PG8_LDA(At, 1, 0); PG8_STAGE(PG8_SA(0, 1), a2 + hstep, voffA);
            PG8_WAIT_L(8); PG8_BAR; PG8_WAIT_L(0); PG8_MMA(0, 0, At, B0); PG8_BAR; PG8_SCHED;
            PG8_LDB(B1, 1, 1); PG8_STAGE(PG8_SB(1, 0), b3, voffB);
            PG8_BAR; PG8_WAIT_L(0); PG8_MMA(0, 1, At, B1); PG8_BAR;
            PG8_LDA(At, 1, 1); PG8_STAGE(PG8_SA(1, 0), a3, voffA);
            PG8_BAR; PG8_WAIT_L(0); PG8_MMA(1, 0, At, B0); PG8_BAR; PG8_SCHED;
            PG8_STAGE(PG8_SB(1, 1), b3 + hstep, voffB);
            PG8_WAIT_V(6); PG8_BAR; PG8_MMA(1, 1, At, B1); PG8_BAR;
        }
        PG8_STAMP();
        if constexpr (!Epi::AFTER_DRAIN) { E(acc, cur, wr, wc, fr, fq); S.done(cur); }
        PG8_STAMP();
        if (!has_next) break;
#pragma unroll
        for (int a = 0; a < 2; ++a)
#pragma unroll
            for (int b = 0; b < 2; ++b)
#pragma unroll
                for (int m = 0; m < 4; ++m)
#pragma unroll
                    for (int n = 0; n < 2; ++n) acc[a][b][m][n] = (f32x4){0.f, 0.f, 0.f, 0.f};
        cur = nxt; cA = nA; cB = nB; ++ui;
    }
    PG8_WAIT_V(0);
    if (wr == 0) PG8_BAR;
    PG8_BAR;
    if constexpr (Epi::AFTER_DRAIN) { E.fused(acc, cur, wr, wc, fr, fq, lds, wid, lane); S.done(cur); }
    PG8_STAMP();
    if (STAMP && wid == 0) { stamps[lane] = lane < nts ? (((unsigned long long)(unsigned)ts_hi << 32) | (unsigned)ts_lo) : 0ull;
        if (lane == 62) stamps[62] = rt_entry; if (lane == 63) stamps[63] = (unsigned long long)wall_clock64(); }
#undef PG8_STAMP
#undef PG8_SA
#undef PG8_SB
#undef PG8_STAGE
#undef PG8_LDA
#undef PG8_LDB
#undef PG8_MMA
#undef PG8_WAIT_V
#undef PG8_WAIT_L
#undef PG8_BAR
#undef PG8_SCHED
}
}

constexpr int DM = 1024, NPR = 16384, NSM = 256, MTOK = NPR + NSM, SEQ = 4096, NBP = 64, PAST = 16384, NBS = 257, NPG = 128, DFF = 4096;
constexpr int PW = 2048;
constexpr int C_Q = 0, C_KC = 512, C_KS = 768, C_KW = 1024, C_U = 1280, C_G = 1792;
constexpr int CMP_SEC = 17152, CMP_ROWS = 2 * CMP_SEC;
constexpr int CMP_R_PROMPT = 16384, CMP_R_NEW = 16896, CMP_R_END = 16960;
constexpr size_t O_YP = 0, O_YS = 16777216, O_PCMP = 17039360, O_PSLC = 21233664, O_PWIN = 25427968, O_PPOOL = 25952256,
                 O_SCMP = 25982976, O_SSLC = 26048512, O_SWIN = 26114048, O_SPOOL = 30308352, O_END = 30554112;
constexpr size_t MiB = 1u << 20;
constexpr size_t WS_CTL = 0, CTL_ZERO_BYTES = 1 * MiB;
constexpr size_t WS_WIN = 2 * MiB, WS_WOUT = 6 * MiB, WS_WUP = 8 * MiB, WS_WDN = 16 * MiB, WS_W1S = 24 * MiB, WS_WPOOL = 26 * MiB;
constexpr size_t WS_XN = 32 * MiB, WS_PROJ = 66 * MiB, WS_ACMP = 200 * MiB, WS_HID = 470 * MiB, WS_COMPS = 490 * MiB, WS_COMPP = 500 * MiB;
constexpr size_t WS_MIX = 502 * MiB, WS_H = 536 * MiB, WS_HB = 602 * MiB, WS_ACT = 636 * MiB, WS_END = 768 * MiB;
static_assert(WS_XN + (size_t)MTOK * DM * 2 <= WS_PROJ && WS_PROJ + (size_t)MTOK * PW * 4 <= WS_ACMP && WS_ACMP + (size_t)CMP_ROWS * 4096 * 2 <= WS_HID, "ws map 1");
static_assert(WS_HID + (size_t)CMP_ROWS * 128 * 4 <= WS_COMPS && WS_COMPS + (size_t)32 * NBS * 256 * 4 <= WS_COMPP && WS_COMPP + (size_t)4 * NBP * 256 * 4 <= WS_MIX, "ws map 2");
static_assert(WS_MIX + (size_t)MTOK * DM * 2 <= WS_H && WS_H + (size_t)MTOK * DM * 4 <= WS_HB && WS_HB + (size_t)MTOK * DM * 2 <= WS_ACT && WS_ACT + (size_t)MTOK * DFF * 2 <= WS_END, "ws map 3");
constexpr int CW_BAR = 4096, CW_QUEUE = 8192;

constexpr int NWAVES = 8, NTHR = NWAVES * 64;
constexpr int RING_BYTES = 131072, LDSCTL_OFF = 143360, MISC_OFF = LDSCTL_OFF + 320, LDS_BYTES = 147456;
constexpr int NPHASES = 9;

#define GAS __attribute__((address_space(1)))
#define LAS __attribute__((address_space(3)))
typedef unsigned short bf16;
typedef unsigned v4u __attribute__((ext_vector_type(4)));
typedef unsigned v2u __attribute__((ext_vector_type(2)));
typedef float f32x4 __attribute__((ext_vector_type(4)));
#define LDS_WAIT() asm volatile("s_waitcnt lgkmcnt(0)" ::: "memory")
__device__ __forceinline__ unsigned f2bf(float f) { unsigned u = __builtin_bit_cast(unsigned, f); return (u + 0x7fffu + ((u >> 16) & 1u)) >> 16; }
__device__ __forceinline__ unsigned pk2(float lo, float hi) { return f2bf(lo) | (f2bf(hi) << 16); }
__device__ __forceinline__ float wave_sum(float v) {
#pragma unroll
    for (int o = 1; o < 64; o <<= 1) v += __shfl_xor(v, o);
    return v;
}
__device__ __forceinline__ float wave_max(float v) {
#pragma unroll
    for (int o = 1; o < 64; o <<= 1) v = fmaxf(v, __shfl_xor(v, o));
    return v;
}

#define XB_TMO      128
#define XB_XCNT(j)  (256  + 64 * (j))
#define XB_XSUB(j)  (1280 + 64 * (j))
#define XB_XGEN(j)  (2304 + 64 * (j))
#define XB_TOP      3328
#define XB_TOPGEN   3392
#define XCD_BAR_WORDS 3456
#define XB_SPIN_CAP (1u << 18)
__device__ __forceinline__ unsigned xb_ld(unsigned* p)              { return __hip_atomic_load(p, __ATOMIC_RELAXED, __HIP_MEMORY_SCOPE_AGENT); }
__device__ __forceinline__ unsigned xb_add(unsigned* p, unsigned v) { return __hip_atomic_fetch_add(p, v, __ATOMIC_RELAXED, __HIP_MEMORY_SCOPE_AGENT); }
__device__ __forceinline__ unsigned xb_xcc_id() { return (unsigned)__builtin_amdgcn_s_getreg((3 << 11) | 20) & 0xFu; }
#define XB_SPIN(cond, bar) do { unsigned _sp = 0; while (cond) { __builtin_amdgcn_s_sleep(1); \
    if ((++_sp & 255u) == 0u) { if (xb_ld(&(bar)[XB_TMO])) break; if (_sp > XB_SPIN_CAP) { atomicAdd(&(bar)[XB_TMO], 1u); break; } } } } while (0)
struct XcdBarrier { unsigned* bar; unsigned x; volatile LAS unsigned* st; };
__device__ __forceinline__ XcdBarrier xcd_barrier_post(unsigned* bar, volatile LAS unsigned* st) {
    XcdBarrier b; b.bar = bar; b.x = xb_xcc_id(); b.st = st;
    if (threadIdx.x == 0) (void)xb_add(&bar[XB_XCNT(b.x)], 1u);
    return b;
}
__device__ __forceinline__ void xcd_barrier_complete(unsigned* bar, unsigned x, unsigned& nloc, unsigned& nx) {
    const unsigned G = gridDim.x * gridDim.y * gridDim.z;
    unsigned sum, cnt, mine, sp = 0u;
    for (;;) {
        sum = 0u; cnt = 0u; mine = 0u;
#pragma unroll
        for (unsigned j = 0; j < 16; ++j) { const unsigned c = xb_ld(&bar[XB_XCNT(j)]); sum += c; cnt += (c > 0u) ? 1u : 0u; mine = (j == x) ? c : mine; }
        if (sum == G) break;
        __builtin_amdgcn_s_sleep(1);
        if ((++sp & 255u) == 0u) { if (xb_ld(&bar[XB_TMO])) break; if (sp > XB_SPIN_CAP) { atomicAdd(&bar[XB_TMO], 1u); break; } }
    }
    nloc = mine > 0u ? mine : 1u; nx = cnt > 0u ? cnt : 1u;
}
__device__ __forceinline__ void xcd_barrier(const XcdBarrier& b) {
    asm volatile("s_waitcnt vmcnt(0)" ::: "memory");
    __syncthreads();
    if (threadIdx.x == 0) {
        unsigned* bar = b.bar;
        __builtin_amdgcn_s_waitcnt(0);
        unsigned nloc = b.st[0], nx = b.st[1];
        if (nloc == 0u) { xcd_barrier_complete(bar, b.x, nloc, nx); b.st[0] = nloc; b.st[1] = nx; }
        const unsigned old = xb_add(&bar[XB_XSUB(b.x)], 1u);
        const unsigned gen = old / nloc;
        if (old + 1u == (gen + 1u) * nloc) {
            __builtin_amdgcn_fence(__ATOMIC_RELEASE, "agent");
            asm volatile("s_waitcnt vmcnt(0)" ::: "memory");
            const unsigned og = xb_add(&bar[XB_TOP], 1u);
            const unsigned tg = og / nx;
            if (og + 1u == (tg + 1u) * nx) xb_add(&bar[XB_TOPGEN], 1u);
            else XB_SPIN(xb_ld(&bar[XB_TOPGEN]) == tg, bar);
            __builtin_amdgcn_fence(__ATOMIC_ACQUIRE, "agent");
            xb_add(&bar[XB_XGEN(b.x)], 1u);
            asm volatile("s_waitcnt vmcnt(0)" ::: "memory");
        } else {
            XB_SPIN(xb_ld(&bar[XB_XGEN(b.x)]) == gen, bar);
            __builtin_amdgcn_fence(__ATOMIC_ACQUIRE, "agent");
            asm volatile("s_waitcnt vmcnt(0)" ::: "memory");
        }
    }
    __syncthreads();
}

struct Args { const float* in[19]; float* out; unsigned char* ws; int ph_lo, ph_hi; };
struct Frame {
    LAS unsigned char* lds;
    int tid, lane, wave, G, bid;
};

template <int MAP>
__device__ __forceinline__ void p0_transpose_item(const float* W, int K, int ldw, int nblk, bf16* WT, int row_off, LAS float* scr, int item, int lane) {
    const int kb = item / nblk, nb = item % nblk, k0 = 64 * kb, n0 = 32 * nb;
    const int nd = n0 + (lane & 31);
    int sc = nd;
    if (MAP == 1) { if (nd < 1280) sc = nd; else if (nd < 1792) sc = nd + 24; else if (nd < 1816) sc = nd - 512; else sc = -1; }
#pragma unroll 8
    for (int i = 0; i < 32; ++i) { const int kk = 2 * i + (lane >> 5); scr[kk * 33 + (lane & 31)] = (sc >= 0) ? W[(size_t)(k0 + kk) * ldw + sc] : 0.f; }
    LDS_WAIT(); asm volatile("" ::: "memory");
    const int c = lane & 7;
#pragma unroll
    for (int j = 0; j < 4; ++j) { const int n = (lane >> 3) + 8 * j; const LAS float* s = scr + (8 * c) * 33 + n;
        v4u o; o.x = pk2(s[0 * 33], s[1 * 33]); o.y = pk2(s[2 * 33], s[3 * 33]); o.z = pk2(s[4 * 33], s[5 * 33]); o.w = pk2(s[6 * 33], s[7 * 33]);
        *(v4u*)(WT + (size_t)(row_off + n0 + n) * K + k0 + 8 * c) = o; }
    LDS_WAIT(); asm volatile("" ::: "memory");
}
__device__ __forceinline__ void rms_row_to_bf16(const float* xrow, const float* g, bf16* orow, int lane) {
    const f32x4* xr = (const f32x4*)xrow + lane; const f32x4* gr = (const f32x4*)g + lane;
    f32x4 v[4]; float s = 0.f;
#pragma unroll
    for (int j = 0; j < 4; ++j) { v[j] = xr[64 * j]; s += (v[j].x * v[j].x + v[j].y * v[j].y) + (v[j].z * v[j].z + v[j].w * v[j].w); }
    const float rstd = 1.0f / sqrtf(wave_sum(s) * (1.f / DM) + 1e-6f);
    unsigned long long* o8 = (unsigned long long*)orow + lane;
#pragma unroll
    for (int j = 0; j < 4; ++j) { const f32x4 gg = gr[64 * j];
        o8[64 * j] = (unsigned long long)pk2(v[j].x * rstd * gg.x, v[j].y * rstd * gg.y) | ((unsigned long long)pk2(v[j].z * rstd * gg.z, v[j].w * rstd * gg.w) << 32); }
}

__device__ __forceinline__ void p0_prologue(const Frame& F, const Args& A) {
    LAS float* scr = (LAS float*)(F.lds + F.wave * 16384);
    const int gw = F.bid * NWAVES + F.wave, NGW = F.G * NWAVES;
    constexpr int I_IN = (DM / 64) * (PW / 32), I_OUT = (DM / 64) * (DM / 32), I_UP = (DM / 64) * (DFF / 32), I_DN = (DFF / 64) * (DM / 32), I_W1 = (4096 / 64) * (128 / 32);
    constexpr int I_WP = 32;
    constexpr int NITEMS = I_IN + I_OUT + I_UP + I_DN + 2 * I_W1 + I_WP;
    for (int it = gw; it < NITEMS; it += NGW) {
        int r = it;
        if (r < I_IN) { p0_transpose_item<1>(A.in[8], DM, 1816, PW / 32, ((bf16*)(A.ws + WS_WIN)), 0, scr, r, F.lane); continue; } r -= I_IN;
        if (r < I_OUT) { p0_transpose_item<0>(A.in[14], DM, DM, DM / 32, ((bf16*)(A.ws + WS_WOUT)), 0, scr, r, F.lane); continue; } r -= I_OUT;
        if (r < I_UP) { p0_transpose_item<0>(A.in[16], DM, DFF, DFF / 32, ((bf16*)(A.ws + WS_WUP)), 0, scr, r, F.lane); continue; } r -= I_UP;
        if (r < I_DN) { p0_transpose_item<0>(A.in[17], DFF, DM, DM / 32, ((bf16*)(A.ws + WS_WDN)), 0, scr, r, F.lane); continue; } r -= I_DN;
        if (r < I_W1) { p0_transpose_item<0>(A.in[10], 4096, 128, 4, ((bf16*)(A.ws + WS_W1S)), 0, scr, r, F.lane); continue; } r -= I_W1;
        if (r < I_W1) { p0_transpose_item<0>(A.in[10] + (size_t)4096 * 128, 4096, 128, 4, ((bf16*)(A.ws + WS_W1S)), 128, scr, r, F.lane); continue; } r -= I_W1;
        p0_transpose_item<0>(A.in[12] + (size_t)(r >> 3) * 16384, 128, 128, 4, ((bf16*)(A.ws + WS_WPOOL)), (r >> 3) * 128, scr, r & 7, F.lane);
    }
    for (int m = gw; m < MTOK; m += NGW) {
        const float* xr = m < NPR ? A.in[0] + (size_t)m * DM : A.in[1] + (size_t)(m - NPR) * DM;
        rms_row_to_bf16(xr, A.in[7], ((bf16*)(A.ws + WS_XN)) + (size_t)m * DM, F.lane);
    }
}

__device__ __forceinline__ void p2_copies(const Frame& F, const Args& A) {
    const size_t gt = (size_t)F.bid * NTHR + F.tid, NT = (size_t)F.G * NTHR;
    const f32x4* P4 = (const f32x4*)((float*)(A.ws + WS_PROJ));
    f32x4* O4 = (f32x4*)A.out;
    for (size_t i = gt; i < (size_t)NPR * 64; i += NT) { const size_t r = i >> 6, c = i & 63;
        O4[O_PCMP / 4 + i] = P4[r * 512 + C_KC / 4 + c]; O4[O_PSLC / 4 + i] = P4[r * 512 + C_KS / 4 + c]; }
    for (size_t i = gt; i < (size_t)4 * 512 * 64; i += NT) { const size_t c = i & 63, r = (i >> 6) & 511, b = i >> 15;
        O4[O_PWIN / 4 + i] = P4[(b * SEQ + SEQ - 512 + r) * 512 + C_KW / 4 + c]; }
    for (size_t i = gt; i < (size_t)4 * 15 * 128; i += NT) { const size_t c = i & 127, r = (i >> 7) % 15, b = (i >> 7) / 15;
        O4[O_PPOOL / 4 + i] = P4[(b * SEQ + SEQ - 15 + r) * 512 + C_U / 4 + c]; }
    for (size_t i = gt; i < (size_t)NSM * 64; i += NT) { const size_t r = i >> 6, c = i & 63;
        O4[O_SCMP / 4 + i] = P4[(NPR + r) * 512 + C_KC / 4 + c]; O4[O_SSLC / 4 + i] = P4[(NPR + r) * 512 + C_KS / 4 + c]; }
    const f32x4* SW4 = (const f32x4*)A.in[4];
    for (size_t i = gt; i < (size_t)32 * 512 * 64; i += NT) { const size_t c = i & 63, r = (i >> 6) & 511, b = i >> 15;
        O4[O_SWIN / 4 + i] = (r < 504) ? SW4[(b * 512 + r + 8) * 64 + c] : P4[(NPR + b * 8 + (r - 504)) * 512 + C_KW / 4 + c]; }
    const f32x4* SP4 = (const f32x4*)A.in[5];
    for (size_t i = gt; i < (size_t)32 * 15 * 128; i += NT) { const size_t c = i & 127, r = (i >> 7) % 15, b = (i >> 7) / 15;
        O4[O_SPOOL / 4 + i] = (r < 7) ? SP4[(b * 15 + r + 8) * 128 + c] : P4[(NPR + b * 8 + (r - 7)) * 512 + C_U / 4 + c]; }
}
__device__ __forceinline__ void p2_cmp_gather(const Frame& F, const Args& A) {
    const int gw = F.bid * NWAVES + F.wave, NGW = F.G * NWAVES;
    constexpr int NBLK = 8192 + 256 + 32;
    const int lane = F.lane, gc = lane >> 4, g = gc >> 1, c = gc & 1, d0 = (lane & 15) * 4;
    for (int it = gw; it < NBLK * 64; it += NGW) {
        const int blk = it >> 6, l = it & 63;
        f32x4 v; int rsec;
        if (blk < 8192) { const int b = blk >> 8, n = blk & 255; const int page = ((const int*)A.in[6])[b * NPG + (n >> 1)];
            v = *(const f32x4*)(A.in[2] + ((size_t)page * 128 + (n & 1) * 64 + l) * 256 + lane * 4); rsec = (b * 256 + n) * 2 + g; }
        else if (blk < 8192 + 256) { const int q = blk - 8192, b = q >> 6, n = q & 63;
            v = *(const f32x4*)(((float*)(A.ws + WS_PROJ)) + ((size_t)b * SEQ + n * 64 + l) * PW + C_KC + lane * 4); rsec = CMP_R_PROMPT + (b * 64 + n) * 2 + g; }
        else { const int b = blk - 8192 - 256;
            v = (l < 8) ? *(const f32x4*)(((float*)(A.ws + WS_PROJ)) + ((size_t)NPR + b * 8 + l) * PW + C_KC + lane * 4) : (f32x4){0.f, 0.f, 0.f, 0.f}; rsec = CMP_R_NEW + b * 2 + g; }
        const f32x4 pe = *(const f32x4*)(A.in[9] + (l * 2 + c) * 64 + d0);
        v = v + pe;
        v2u o; o.x = pk2(v.x, v.y); o.y = pk2(v.z, v.w);
        *(v2u*)(((bf16*)(A.ws + WS_ACMP)) + ((size_t)c * CMP_SEC + rsec) * 4096 + l * 64 + d0) = o;
    }
}
__device__ __forceinline__ void p2_pool(const Frame& F, const Args& A) {
    LAS float* wl = (LAS float*)F.lds;
    LAS float* dl = (LAS float*)(F.lds + 65536 + F.wave * 2048);
    constexpr int NCH = MTOK / 32;
    const int lane = F.lane;
    for (int unit = F.bid; unit < 4 * NCH; unit += F.G) {
        const int gi = unit / NCH, ch = unit % NCH, w = 2 << gi;
        __syncthreads();
        for (int i = F.tid; i < 128 * 128 / 4; i += NTHR) ((LAS f32x4*)wl)[i] = ((const f32x4*)(A.in[12] + (size_t)gi * 16384))[i];
        const int tok0 = ch * 32 + F.wave * 4;
#pragma unroll
        for (int tk = 0; tk < 4; ++tk) {
            const int row = tok0 + tk;
#pragma unroll
            for (int hh = 0; hh < 2; ++hh) {
                const int cc = gi * 128 + lane + 64 * hh;
                float own, sum = 0.f, cnt;
                if (row < NPR) { const int t = row & (SEQ - 1);
                    own = ((float*)(A.ws + WS_PROJ))[(size_t)row * PW + C_U + cc];
                    for (int j = 0; j < w; ++j) if (t - j >= 0) sum += ((float*)(A.ws + WS_PROJ))[(size_t)(row - j) * PW + C_U + cc];
                    cnt = (float)((t + 1 < w) ? t + 1 : w);
                } else { const int q = row - NPR, b = q >> 3, i = q & 7;
                    own = ((float*)(A.ws + WS_PROJ))[(size_t)row * PW + C_U + cc];
                    for (int j = 0; j < w; ++j) { const int idx = 15 + i - j;
                        sum += (idx >= 15) ? ((float*)(A.ws + WS_PROJ))[(size_t)(NPR + b * 8 + idx - 15) * PW + C_U + cc] : A.in[5][((size_t)b * 15 + idx) * 512 + cc]; }
                    cnt = (float)w;
                }
                dl[(lane + 64 * hh) * 4 + tk] = sum / cnt - own;
            }
        }
        __syncthreads();
        float acc[4][2];
#pragma unroll
        for (int tk = 0; tk < 4; ++tk) { acc[tk][0] = 0.f; acc[tk][1] = 0.f; }
#pragma unroll 4
        for (int c = 0; c < 128; ++c) {
            const f32x4 dv = *(const LAS f32x4*)(dl + c * 4);
            const float w0 = wl[c * 128 + lane], w1 = wl[c * 128 + lane + 64];
            acc[0][0] += dv.x * w0; acc[0][1] += dv.x * w1; acc[1][0] += dv.y * w0; acc[1][1] += dv.y * w1;
            acc[2][0] += dv.z * w0; acc[2][1] += dv.z * w1; acc[3][0] += dv.w * w0; acc[3][1] += dv.w * w1;
        }
        const float s0 = A.in[13][gi * 128 + lane], s1 = A.in[13][gi * 128 + lane + 64];
#pragma unroll
        for (int tk = 0; tk < 4; ++tk) { bf16* o = ((bf16*)(A.ws + WS_MIX)) + (size_t)(tok0 + tk) * DM + 512 + gi * 128;
            o[lane] = (bf16)f2bf(acc[tk][0] * s0); o[lane + 64] = (bf16)f2bf(acc[tk][1] * s1); }
    }
    __syncthreads();
}

__device__ __forceinline__ void p4_cmp_w2(const Frame& F, const Args& A) {
    LAS float* w2l = (LAS float*)F.lds;
    LAS float* hl = (LAS float*)(F.lds + 65536 + F.wave * 512);
    for (int i = F.tid; i < 2 * 128 * 64 / 4; i += NTHR) ((LAS f32x4*)w2l)[i] = ((const f32x4*)A.in[11])[i];
    __syncthreads();
    const int gw = F.bid * NWAVES + F.wave, NGW = F.G * NWAVES, lane = F.lane;
    for (int it = gw; it < 2 * CMP_R_END; it += NGW) {
        const int c = it / CMP_R_END, r = it % CMP_R_END;
        const float* hrow = ((float*)(A.ws + WS_HID)) + ((size_t)c * CMP_SEC + r) * 128;
        hl[lane] = hrow[lane]; hl[lane + 64] = hrow[lane + 64];
        LDS_WAIT(); asm volatile("" ::: "memory");
        float a = 0.f;
#pragma unroll 8
        for (int h = 0; h < 128; ++h) a += hl[h] * w2l[(c * 128 + h) * 64 + lane];
        float* dst;
        if (r < CMP_R_PROMPT) { const int b = r >> 9, n = (r & 511) >> 1, g = r & 1; dst = ((float*)(A.ws + WS_COMPS)) + ((((size_t)b * NBS + n) * 2 + g) * 2 + c) * 64; }
        else if (r < CMP_R_NEW) { const int q = r - CMP_R_PROMPT, b = q >> 7, n = (q & 127) >> 1, g = q & 1; dst = ((float*)(A.ws + WS_COMPP)) + ((((size_t)b * NBP + n) * 2 + g) * 2 + c) * 64; }
        else { const int q = r - CMP_R_NEW, b = q >> 1, g = q & 1; dst = ((float*)(A.ws + WS_COMPS)) + ((((size_t)b * NBS + 256) * 2 + g) * 2 + c) * 64; }
        dst[lane] = a;
        LDS_WAIT(); asm volatile("" ::: "memory");
    }
    __syncthreads();
}

namespace att {
typedef short bf16x8 __attribute__((ext_vector_type(8)));
typedef short s16x4 __attribute__((ext_vector_type(4)));
typedef float f32x16 __attribute__((ext_vector_type(16)));
typedef float f32x2 __attribute__((ext_vector_type(2)));
typedef __bf16 bf16x2v __attribute__((ext_vector_type(2)));
constexpr int KP = 144, VP = 192, BUFB = 64 * KP + 64 * VP;
constexpr int AT_T = 2 * BUFB, T_WAVE = 8704, AT_SCORE = AT_T + 8 * T_WAVE, AT_ML = AT_SCORE + 16384, AT_SEL = AT_ML + 2048, AT_UNI = AT_SEL + 4096, AT_TILES = AT_UNI + 64, AT_MISC = AT_TILES + 4096, AT_END = AT_MISC + 64;
static_assert(AT_END <= LDSCTL_OFF, "attention LDS map");
constexpr int NUNITS = 576;
struct TileEnt { unsigned long long base; int pitch, kpos0, kind, blk, nrows, n0; };
static_assert(sizeof(TileEnt) == 32, "TileEnt");
__device__ __forceinline__ unsigned cvtpk(float lo, float hi) { f32x2 a = {lo, hi}; return __builtin_bit_cast(unsigned, __builtin_convertvector(a, bf16x2v)); }
#define ATT_KR(r) (((r) & 3) + 8 * ((r) >> 2))
#define ATT_MFMA(a, b, c) __builtin_amdgcn_mfma_f32_32x32x16_bf16((a), (b), (c), 0, 0, 0)

__device__ __forceinline__ void attn_phase(const Frame& F, const Args& A, int qslot) {
#if defined(__HIP_DEVICE_COMPILE__)
    LAS unsigned char* L = F.lds;
    const int tid = F.tid, lane = F.lane, wave = F.wave;
    const int r32 = lane & 31, h = lane >> 5, tl = r32 >> 2, p = r32 & 3;
    unsigned* qctr = (unsigned*)(A.ws + WS_CTL) + CW_QUEUE + 64 * qslot;
    const float* PROJ = (const float*)(A.ws + WS_PROJ);
    LAS TileEnt* TILES = (LAS TileEnt*)(L + AT_TILES);
    volatile LAS int* MISC = (volatile LAS int*)(L + AT_MISC);
    LAS unsigned long long* UNI = (LAS unsigned long long*)(L + AT_UNI);
    LAS unsigned long long* SEL = (LAS unsigned long long*)(L + AT_SEL);
    LAS float* SCORE = (LAS float*)(L + AT_SCORE);
    LAS float* ML = (LAS float*)(L + AT_ML);
    for (;;) {
        __syncthreads();
        if (tid == 0) {
            const int unit = (int)__hip_atomic_fetch_add(qctr, 1u, __ATOMIC_RELAXED, __HIP_MEMORY_SCOPE_AGENT);
            MISC[0] = unit;
            for (int c = 0; c < 8; ++c) UNI[c] = 0ull;
            if (unit < NUNITS) {
                if (unit < 64) { const int b = unit >> 1, g = unit & 1;
                    for (int i = 0; i < 4; ++i) { TileEnt e; e.base = (unsigned long long)((const float*)(A.ws + WS_COMPS) + (((size_t)b * NBS + 64 * i) * 2 + g) * 128); e.pitch = 256; e.kpos0 = 0; e.kind = 0; e.blk = 0; e.nrows = 64; e.n0 = 64 * i; TILES[i] = e; }
                    MISC[1] = 4;
                } else { const int u2 = unit - 64, rem = u2 & 7, b = rem >> 1, g = rem & 1;
                    TileEnt e; e.base = (unsigned long long)((const float*)(A.ws + WS_COMPP) + (((size_t)b * NBP) * 2 + g) * 128); e.pitch = 256; e.kpos0 = 0; e.kind = 0; e.blk = 0; e.nrows = 64; e.n0 = 0; TILES[0] = e;
                    MISC[1] = 1;
                }
            }
        }
        __syncthreads();
        const int unit = MISC[0];
        if (unit >= NUNITS) break;
        const bool is_s = unit < 64;
        int b, g, qt;
        if (is_s) { b = unit >> 1; g = unit & 1; qt = 256; } else { const int u2 = unit - 64, rem = u2 & 7; qt = 63 - (u2 >> 3); b = rem >> 1; g = rem & 1; }
        const bool active = is_s ? (wave == 0) : true;
        const int cur = qt;
        const int tokrow = is_s ? (NPR + b * 8 + tl) : (b * SEQ + qt * 64 + wave * 8 + tl);
        const int qpos = is_s ? (PAST + tl) : (qt * 64 + wave * 8 + tl);
        const int mytok = is_s ? tl : (wave * 8 + tl);
        const int ncmp = is_s ? 4 : 1;
        const int TP = is_s ? 264 : 68;
        LAS float* Tm = (LAS float*)(L + AT_T + (is_s ? 0 : wave * T_WAVE));
        bf16x8 Q[4];
        float gate0 = 0.f, gate1 = 0.f, gate2 = 0.f;
        const float slope2 = exp2f(-(float)(g * 4 + p + 1)) * 1.4426950408889634f;
        if (active) {
            const float* prow = PROJ + (size_t)tokrow * PW;
            const float qs = 0.125f * 1.4426950408889634f;
#pragma unroll
            for (int ks = 0; ks < 4; ++ks) { const f32x4 a = *(const f32x4*)(prow + C_Q + g * 256 + p * 64 + 16 * ks + 8 * h), c = *(const f32x4*)(prow + C_Q + g * 256 + p * 64 + 16 * ks + 8 * h + 4);
                v4u w; w.x = cvtpk(a.x * qs, a.y * qs); w.y = cvtpk(a.z * qs, a.w * qs); w.z = cvtpk(c.x * qs, c.y * qs); w.w = cvtpk(c.z * qs, c.w * qs);
                Q[ks] = __builtin_bit_cast(bf16x8, w); }
            gate0 = 1.0f / (1.0f + __expf(-prow[C_G + 0 + g * 4 + p])); gate1 = 1.0f / (1.0f + __expf(-prow[C_G + 8 + g * 4 + p])); gate2 = 1.0f / (1.0f + __expf(-prow[C_G + 16 + g * 4 + p]));
        } else {
#pragma unroll
            for (int ks = 0; ks < 4; ++ks) Q[ks] = (bf16x8){0, 0, 0, 0, 0, 0, 0, 0};
        }
        f32x16 O0, O1, T0, T1;
#pragma unroll
        for (int i = 0; i < 16; ++i) { O0[i] = 0.f; O1[i] = 0.f; T0[i] = 0.f; T1[i] = 0.f; }
        float m_run = -1e20f, l_run = 0.f;
        int curkind = 0;
        int ntiles = ncmp;
        f32x4 R0, R1, R2, R3;
#define ATT_LOAD(idx) do { const TileEnt e_ = TILES[(idx)]; const float* bp_ = (const float*)e_.base; const int nr_ = e_.nrows - 1; \
            { const int f_ = tid;        int row_ = f_ >> 5; row_ = row_ < nr_ ? row_ : nr_; R0 = *(const f32x4*)(bp_ + (size_t)row_ * e_.pitch + (f_ & 31) * 4); } \
            { const int f_ = tid + 512;  int row_ = f_ >> 5; row_ = row_ < nr_ ? row_ : nr_; R1 = *(const f32x4*)(bp_ + (size_t)row_ * e_.pitch + (f_ & 31) * 4); } \
            { const int f_ = tid + 1024; int row_ = f_ >> 5; row_ = row_ < nr_ ? row_ : nr_; R2 = *(const f32x4*)(bp_ + (size_t)row_ * e_.pitch + (f_ & 31) * 4); } \
            { const int f_ = tid + 1536; int row_ = f_ >> 5; row_ = row_ < nr_ ? row_ : nr_; R3 = *(const f32x4*)(bp_ + (size_t)row_ * e_.pitch + (f_ & 31) * 4); } } while (0)
#define ATT_ST1(buf, f_, Rv) do { const int row_ = (f_) >> 5, c4_ = (f_) & 31; v2u o_; o_.x = cvtpk(Rv.x, Rv.y); o_.y = cvtpk(Rv.z, Rv.w); \
            const int off_ = (buf) * BUFB + (c4_ < 16 ? row_ * KP + c4_ * 8 : 64 * KP + row_ * VP + (c4_ - 16) * 8); *(LAS v2u*)(L + off_) = o_; } while (0)
#define ATT_STORE(buf) do { ATT_ST1(buf, tid, R0); ATT_ST1(buf, tid + 512, R1); ATT_ST1(buf, tid + 1024, R2); ATT_ST1(buf, tid + 1536, R3); } while (0)
        ATT_LOAD(0); ATT_STORE(0);
        __syncthreads();
        for (int i = 0; i < ntiles; ++i) {
            const int buf = i & 1;
            const bool has_next = (i + 1 < ntiles) && (i + 1 != ncmp);
            if (has_next) ATT_LOAD(i + 1);
            if (active) {
                const TileEnt e = TILES[i];
                const int kind = __builtin_amdgcn_readfirstlane(e.kind), kpos0 = __builtin_amdgcn_readfirstlane(e.kpos0), blk = __builtin_amdgcn_readfirstlane(e.blk), n0 = __builtin_amdgcn_readfirstlane(e.n0);
                if (kind != curkind) {
                    const float sc = gate1 / fmaxf(l_run, 1e-30f);
#pragma unroll
                    for (int r = 0; r < 16; ++r) { T0[r] += sc * O0[r]; T1[r] += sc * O1[r]; O0[r] = 0.f; O1[r] = 0.f; }
                    m_run = -1e20f; l_run = 0.f; curkind = kind;
                }
                int dq_hi, dq_lo = -1; float sstep = slope2, rowc;
                if (kind == 0) { dq_hi = (qpos - 63 - 64 * n0) >> 6; sstep = slope2 * 64.f; rowc = slope2 * (float)(64 * n0 + 63 - qpos); }
                else if (kind == 1) { const unsigned long long w = SEL[mytok * 8 + (blk >> 6)]; const bool sb = (w >> (blk & 63)) & 1ull; dq_hi = sb ? (qpos - kpos0) : -1; rowc = slope2 * (float)(kpos0 - qpos); }
                else { dq_hi = qpos - kpos0; dq_lo = qpos - 512 - kpos0; rowc = slope2 * (float)(kpos0 - qpos); }
                const bool lane_any = (dq_hi >= 0) && (dq_lo < 63);
                if (kind == 0 || __any(lane_any)) {
                    const LAS unsigned char* Kb = L + buf * BUFB; const LAS unsigned char* Vb = Kb + 64 * KP;
                    f32x16 X0, X1;
#pragma unroll
                    for (int r = 0; r < 16; ++r) { X0[r] = 0.f; X1[r] = 0.f; }
#pragma unroll
                    for (int ks = 0; ks < 4; ++ks) {
                        const bf16x8 a0 = *(const LAS bf16x8*)(Kb + r32 * KP + (16 * ks + 8 * h) * 2);
                        const bf16x8 a1 = *(const LAS bf16x8*)(Kb + (32 + r32) * KP + (16 * ks + 8 * h) * 2);
                        X0 = ATT_MFMA(a0, Q[ks], X0); X1 = ATT_MFMA(a1, Q[ks], X1);
                    }
                    const float cb = rowc + sstep * (float)(4 * h);
#pragma unroll
                    for (int r = 0; r < 16; ++r) { X0[r] += fmaf(sstep, (float)ATT_KR(r), cb); X1[r] += fmaf(sstep, (float)(32 + ATT_KR(r)), cb); }
                    const bool lane_full = (dq_hi >= 63) && (dq_lo < 0);
                    if (!__all(lane_full)) {
                        const int hi2 = dq_hi - 4 * h, lo2 = dq_lo - 4 * h;
#pragma unroll
                        for (int r = 0; r < 16; ++r) { const int k0 = ATT_KR(r), k1 = 32 + ATT_KR(r);
                            X0[r] = (k0 <= hi2 && k0 > lo2) ? X0[r] : -1e30f; X1[r] = (k1 <= hi2 && k1 > lo2) ? X1[r] : -1e30f; }
                    }
                    if (kind == 0) {
#pragma unroll
                        for (int q4 = 0; q4 < 4; ++q4) {
                            *(LAS f32x4*)(Tm + r32 * TP + n0 + 8 * q4 + 4 * h) = (f32x4){X0[4 * q4], X0[4 * q4 + 1], X0[4 * q4 + 2], X0[4 * q4 + 3]};
                            *(LAS f32x4*)(Tm + r32 * TP + n0 + 32 + 8 * q4 + 4 * h) = (f32x4){X1[4 * q4], X1[4 * q4 + 1], X1[4 * q4 + 2], X1[4 * q4 + 3]}; }
                    }
                    float mx = -1e30f;
#pragma unroll
                    for (int r = 0; r < 16; ++r) mx = fmaxf(mx, fmaxf(X0[r], X1[r]));
                    mx = fmaxf(mx, __shfl_xor(mx, 32));
                    const float m_new = fmaxf(m_run, mx);
                    if (__any(m_new > m_run)) {
                        const float alpha = exp2f(m_run - m_new);
#pragma unroll
                        for (int r = 0; r < 16; ++r) { O0[r] *= alpha; O1[r] *= alpha; }
                        l_run *= alpha; m_run = m_new;
                    }
                    float ls = 0.f;
#pragma unroll
                    for (int r = 0; r < 16; ++r) { X0[r] = __builtin_amdgcn_exp2f(X0[r] - m_run); X1[r] = __builtin_amdgcn_exp2f(X1[r] - m_run); ls += X0[r] + X1[r]; }
                    ls += __shfl_xor(ls, 32);
                    l_run += ls;
#pragma unroll
                    for (int kt = 0; kt < 2; ++kt) {
#pragma unroll
                        for (int s = 0; s < 2; ++s) {
                            v4u pw;
                            if (kt == 0) { pw.x = cvtpk(X0[8 * s], X0[8 * s + 1]); pw.y = cvtpk(X0[8 * s + 2], X0[8 * s + 3]); pw.z = cvtpk(X0[8 * s + 4], X0[8 * s + 5]); pw.w = cvtpk(X0[8 * s + 6], X0[8 * s + 7]); }
                            else         { pw.x = cvtpk(X1[8 * s], X1[8 * s + 1]); pw.y = cvtpk(X1[8 * s + 2], X1[8 * s + 3]); pw.z = cvtpk(X1[8 * s + 4], X1[8 * s + 5]); pw.w = cvtpk(X1[8 * s + 6], X1[8 * s + 7]); }
                            const bf16x8 pf = __builtin_bit_cast(bf16x8, pw);
                            const int key0 = kt * 32 + 16 * s + 4 * h, i16 = lane & 15, q = i16 >> 2, pp = i16 & 3, blk16 = (lane >> 4) & 1;
#pragma unroll
                            for (int dt = 0; dt < 2; ++dt) {
                                const LAS unsigned char* va = Vb + (key0 + q) * VP + (dt * 32 + 16 * blk16 + 4 * pp) * 2;
                                const s16x4 lo = __builtin_amdgcn_ds_read_tr16_b64_v4i16((LAS s16x4*)va);
                                const s16x4 hi = __builtin_amdgcn_ds_read_tr16_b64_v4i16((LAS s16x4*)(va + 8 * VP));
                                const bf16x8 vf = __builtin_shufflevector(lo, hi, 0, 1, 2, 3, 4, 5, 6, 7);
                                if (dt == 0) O0 = ATT_MFMA(vf, pf, O0); else O1 = ATT_MFMA(vf, pf, O1);
                            }
                        }
                    }
                }
            }
            if (has_next) ATT_STORE(buf ^ 1);
            __syncthreads();
            if (i + 1 == ncmp) {
                if (active) {
                    const float il = 1.0f / fmaxf(l_run, 1e-30f), sc = gate0 * il;
#pragma unroll
                    for (int r = 0; r < 16; ++r) { T0[r] += sc * O0[r]; T1[r] += sc * O1[r]; O0[r] = 0.f; O1[r] = 0.f; }
                    if (h == 0) { ML[(wave * 32 + r32) * 2] = m_run; ML[(wave * 32 + r32) * 2 + 1] = il; }
                    m_run = -1e20f; l_run = 0.f; curkind = 1;
                }
                __syncthreads();
                if (!is_s) {
                    const LAS float* Tw = (const LAS float*)(L + AT_T + wave * T_WAVE);
                    for (int k = 0; k < 8; ++k) { const int tok = wave * 8 + k, n = lane; float imp = 0.f;
#pragma unroll
                        for (int pq = 0; pq < 4; ++pq) { const int row = k * 4 + pq; imp += exp2f(Tw[row * 68 + n] - ML[(wave * 32 + row) * 2]) * ML[(wave * 32 + row) * 2 + 1]; }
                        float s = imp; if (n == 0 || n == cur || n == cur - 1) s = 5.0f; if (n > cur) s = -1.0f;
                        SCORE[tok * 64 + n] = s; }
                } else {
                    const LAS float* Tw = (const LAS float*)(L + AT_T);
                    const int tok = wave;
                    for (int c = 0; c < 5; ++c) { const int n = lane + 64 * c; if (n < 264) { float s;
                        if (n < 256) { float imp = 0.f;
#pragma unroll
                            for (int pq = 0; pq < 4; ++pq) { const int row = tok * 4 + pq; imp += exp2f(Tw[row * 264 + n] - ML[row * 2]) * ML[row * 2 + 1]; }
                            s = imp; if (n == 0 || n == 255) s = 5.0f; }
                        else if (n == 256) s = 5.0f; else s = -2.0f;
                        SCORE[tok * 264 + n] = s; } }
                }
                __syncthreads();
                if (!is_s) {
                    for (int k = 0; k < 8; ++k) { const int tok = wave * 8 + k, n = lane; const float sn = SCORE[tok * 64 + n]; int cnt = 0;
#pragma unroll 4
                        for (int m4 = 0; m4 < 16; ++m4) { const f32x4 sm = *(const LAS f32x4*)(SCORE + tok * 64 + 4 * m4);
                            cnt += (sm.x > sn || (sm.x == sn && 4 * m4 < n)) ? 1 : 0; cnt += (sm.y > sn || (sm.y == sn && 4 * m4 + 1 < n)) ? 1 : 0;
                            cnt += (sm.z > sn || (sm.z == sn && 4 * m4 + 2 < n)) ? 1 : 0; cnt += (sm.w > sn || (sm.w == sn && 4 * m4 + 3 < n)) ? 1 : 0; }
                        const unsigned long long bal = __ballot(n <= cur && cnt < 16);
                        if (lane == 0) { SEL[tok * 8] = bal; __hip_atomic_fetch_or(&UNI[0], bal, __ATOMIC_RELAXED, __HIP_MEMORY_SCOPE_WORKGROUP); } }
                } else {
                    const int tok = wave;
                    for (int c = 0; c < 5; ++c) { const int n = lane + 64 * c; const float sn = (n < 264) ? SCORE[tok * 264 + n] : -2.0f; int cnt = 0;
#pragma unroll 2
                        for (int m4 = 0; m4 < 66; ++m4) { const f32x4 sm = *(const LAS f32x4*)(SCORE + tok * 264 + 4 * m4);
                            cnt += (sm.x > sn || (sm.x == sn && 4 * m4 < n)) ? 1 : 0; cnt += (sm.y > sn || (sm.y == sn && 4 * m4 + 1 < n)) ? 1 : 0;
                            cnt += (sm.z > sn || (sm.z == sn && 4 * m4 + 2 < n)) ? 1 : 0; cnt += (sm.w > sn || (sm.w == sn && 4 * m4 + 3 < n)) ? 1 : 0; }
                        const unsigned long long bal = __ballot(n <= 256 && cnt < 16);
                        if (lane == 0) { SEL[tok * 8 + c] = bal; __hip_atomic_fetch_or(&UNI[c], bal, __ATOMIC_RELAXED, __HIP_MEMORY_SCOPE_WORKGROUP); } }
                }
                __syncthreads();
                if (tid == 0) {
                    int nt = ncmp;
                    for (int c = 4; c >= 0; --c) { unsigned long long w = UNI[c];
                        while (w) { const int bit = 63 - __builtin_clzll(w); w &= ~(1ull << bit); const int j = c * 64 + bit; TileEnt e; e.kind = 1; e.blk = j; e.kpos0 = j * 64; e.n0 = 0;
                            if (!is_s) { e.base = (unsigned long long)(PROJ + ((size_t)b * SEQ + j * 64) * PW + C_KS + g * 128); e.pitch = PW; e.nrows = 64; }
                            else if (j < 256) { const int page = ((const int*)A.in[6])[b * NPG + (j >> 1)]; e.base = (unsigned long long)(A.in[3] + ((size_t)page * 128 + (j & 1) * 64) * 256 + g * 128); e.pitch = 256; e.nrows = 64; }
                            else { e.base = (unsigned long long)(PROJ + ((size_t)NPR + b * 8) * PW + C_KS + g * 128); e.pitch = PW; e.nrows = 8; }
                            TILES[nt++] = e; } }
                    if (!is_s) { for (int tw = qt; tw >= 0 && tw >= qt - 8; --tw) { TileEnt e; e.kind = 2; e.blk = 0; e.n0 = 0; e.kpos0 = tw * 64; e.base = (unsigned long long)(PROJ + ((size_t)b * SEQ + tw * 64) * PW + C_KW + g * 128); e.pitch = PW; e.nrows = 64; TILES[nt++] = e; } }
                    else { { TileEnt e; e.kind = 2; e.blk = 0; e.n0 = 0; e.kpos0 = PAST; e.base = (unsigned long long)(PROJ + ((size_t)NPR + b * 8) * PW + C_KW + g * 128); e.pitch = PW; e.nrows = 8; TILES[nt++] = e; }
                        for (int ti = 7; ti >= 0; --ti) { TileEnt e; e.kind = 2; e.blk = 0; e.n0 = 0; e.kpos0 = PAST - 512 + ti * 64; e.base = (unsigned long long)(A.in[4] + ((size_t)b * 512 + ti * 64) * 256 + g * 128); e.pitch = 256; e.nrows = 64; TILES[nt++] = e; } }
                    MISC[1] = nt;
                }
                __syncthreads();
                ntiles = MISC[1];
                ATT_LOAD(i + 1); ATT_STORE(buf ^ 1);
                __syncthreads();
            }
        }
        if (active) {
            const float sc = gate2 / fmaxf(l_run, 1e-30f);
#pragma unroll
            for (int r = 0; r < 16; ++r) { T0[r] += sc * O0[r]; T1[r] += sc * O1[r]; }
            bf16* orow = (bf16*)(A.ws + WS_MIX) + (size_t)tokrow * DM + g * 256 + p * 64;
#pragma unroll
            for (int q4 = 0; q4 < 4; ++q4) {
                v2u o; o.x = cvtpk(T0[4 * q4], T0[4 * q4 + 1]); o.y = cvtpk(T0[4 * q4 + 2], T0[4 * q4 + 3]); *(v2u*)(orow + 8 * q4 + 4 * h) = o;
                v2u o2; o2.x = cvtpk(T1[4 * q4], T1[4 * q4 + 1]); o2.y = cvtpk(T1[4 * q4 + 2], T1[4 * q4 + 3]); *(v2u*)(orow + 32 + 8 * q4 + 4 * h) = o2; }
        }
    }
#undef ATT_LOAD
#undef ATT_ST1
#undef ATT_STORE
#endif
}
#undef ATT_KR
#undef ATT_MFMA
}

namespace cmpk {
typedef short bf16x8 __attribute__((ext_vector_type(8)));
typedef float f32x16 __attribute__((ext_vector_type(16)));
constexpr int AP = 144, A_BYTES = 128 * AP, B_BYTES = 256 * AP, STG = A_BYTES + B_BYTES;
static_assert(2 * STG <= LDSCTL_OFF && 131072 <= LDSCTL_OFF, "compress LDS map");
constexpr int NUNITS_PAST = 256, NUNITS_ALL = 265;
__device__ __forceinline__ void cmp_unit(const Frame& F, const Args& A, int unit) {
#if defined(__HIP_DEVICE_COMPILE__)
    LAS unsigned char* L = F.lds;
    const int tid = F.tid, lane = F.lane, wave = F.wave, r32 = lane & 31, h = lane >> 5;
    const float* PROJ = (const float*)(A.ws + WS_PROJ);
    const int* pt = (const int*)A.in[6];
    const float* bp0; const float* bp1; const float* bp2; const float* bp3; int pitch, nvalid;
    {
        const float* bpp[4];
#pragma unroll
        for (int i = 0; i < 4; ++i) { const int blk = wave + 8 * i;
            if (unit < 256) { const int b = unit >> 3, n = (unit & 7) * 32 + blk; const int page = pt[b * NPG + (n >> 1)]; bpp[i] = A.in[2] + ((size_t)page * 128 + (n & 1) * 64) * 256; }
            else if (unit < 264) { const int pu = unit - 256, b = pu >> 1, n = (pu & 1) * 32 + blk; bpp[i] = PROJ + ((size_t)b * SEQ + n * 64) * PW + C_KC; }
            else bpp[i] = PROJ + ((size_t)NPR + blk * 8) * PW + C_KC; }
        bp0 = bpp[0]; bp1 = bpp[1]; bp2 = bpp[2]; bp3 = bpp[3];
        pitch = unit < 256 ? 256 : PW; nvalid = unit < 264 ? 64 : 8;
    }
    const int gc = lane >> 4, g = gc >> 1, c = gc & 1, d0 = (lane & 15) * 4;
    const float* pep = A.in[9] + c * 64 + d0;
    const int a_off = (c * 64 + wave * 2 + g) * AP + d0 * 2;
    const bf16* bsrc = (const bf16*)(A.ws + WS_W1S) + (size_t)(tid >> 3) * 4096 + (tid & 7) * 8;
    const int b_off = A_BYTES + (tid >> 3) * AP + (tid & 7) * 16;
    const int cw = wave >> 2, rh = (wave >> 1) & 1, ch = wave & 1;
    const int fa_off = (cw * 64 + rh * 32 + r32) * AP + 16 * h, fb_off = A_BYTES + (cw * 128 + ch * 64 + r32) * AP + 16 * h;
    f32x16 acc0, acc1;
#pragma unroll
    for (int r = 0; r < 16; ++r) { acc0[r] = 0.f; acc1[r] = 0.f; }
    f32x4 RA0[4], RA1[4], RP0, RP1; v4u RB[4];
    const f32x4 z4 = {0.f, 0.f, 0.f, 0.f};
#define CK_LA(l, RA, RP) do { const size_t ro_ = (size_t)(l) * pitch + lane * 4; const bool ok_ = (l) < nvalid; \
        RA[0] = ok_ ? *(const f32x4*)(bp0 + ro_) : z4; RA[1] = ok_ ? *(const f32x4*)(bp1 + ro_) : z4; RA[2] = ok_ ? *(const f32x4*)(bp2 + ro_) : z4; RA[3] = ok_ ? *(const f32x4*)(bp3 + ro_) : z4; \
        RP = *(const f32x4*)(pep + (l) * 128); } while (0)
#define CK_LB(l) do { _Pragma("unroll") for (int i_ = 0; i_ < 4; ++i_) RB[i_] = *(const v4u*)(bsrc + (size_t)i_ * 64 * 4096 + (l) * 64); } while (0)
#define CK_SA(buf, RA, RP) do { _Pragma("unroll") for (int i_ = 0; i_ < 4; ++i_) { const f32x4 v_ = RA[i_] + RP; v2u o_; o_.x = att::cvtpk(v_.x, v_.y); o_.y = att::cvtpk(v_.z, v_.w); \
        *(LAS v2u*)(L + (buf) * STG + a_off + i_ * 16 * AP) = o_; } } while (0)
#define CK_SB(buf) do { _Pragma("unroll") for (int i_ = 0; i_ < 4; ++i_) *(LAS v4u*)(L + (buf) * STG + b_off + i_ * 64 * AP) = RB[i_]; } while (0)
#define CK_MMA(buf) do { _Pragma("unroll") for (int ks_ = 0; ks_ < 4; ++ks_) { \
        const bf16x8 a_ = *(const LAS bf16x8*)(L + (buf) * STG + fa_off + 32 * ks_); \
        const bf16x8 b0_ = *(const LAS bf16x8*)(L + (buf) * STG + fb_off + 32 * ks_); const bf16x8 b1_ = *(const LAS bf16x8*)(L + (buf) * STG + fb_off + 32 * AP + 32 * ks_); \
        acc0 = __builtin_amdgcn_mfma_f32_32x32x16_bf16(a_, b0_, acc0, 0, 0, 0); acc1 = __builtin_amdgcn_mfma_f32_32x32x16_bf16(a_, b1_, acc1, 0, 0, 0); } } while (0)
    __syncthreads();
    CK_LA(0, RA0, RP0); CK_LA(1, RA1, RP1); CK_LB(0);
    CK_SA(0, RA0, RP0); CK_SB(0); CK_LA(2, RA0, RP0); CK_LB(1);
    __syncthreads();
    for (int l = 0; l < 64; l += 2) {
        CK_MMA(0);
        CK_SA(1, RA1, RP1); CK_SB(1);
        if (l + 3 < 64) CK_LA(l + 3, RA1, RP1);
        if (l + 2 < 64) CK_LB(l + 2);
        __syncthreads();
        CK_MMA(1);
        if (l + 2 < 64) { CK_SA(0, RA0, RP0); CK_SB(0); }
        if (l + 4 < 64) CK_LA(l + 4, RA0, RP0);
        if (l + 3 < 64) CK_LB(l + 3);
        __syncthreads();
    }
#undef CK_LA
#undef CK_LB
#undef CK_SA
#undef CK_SB
#undef CK_MMA
    LAS float* HL = (LAS float*)L; LAS float* W2L = (LAS float*)(L + 65536);
#pragma unroll
    for (int r = 0; r < 16; ++r) { const int row = rh * 32 + (r & 3) + 8 * (r >> 2) + 4 * h;
        HL[(cw * 64 + row) * 128 + ch * 64 + r32] = pg8::gelu_tanh(acc0[r]); HL[(cw * 64 + row) * 128 + ch * 64 + 32 + r32] = pg8::gelu_tanh(acc1[r]); }
    for (int i = tid; i < 2 * 128 * 64 / 4; i += NTHR) ((LAS f32x4*)W2L)[i] = ((const f32x4*)A.in[11])[i];
    __syncthreads();
    {
        const int c2 = wave >> 2, row0 = (wave & 3) * 16;
        float o[16];
#pragma unroll
        for (int rr = 0; rr < 16; ++rr) o[rr] = 0.f;
        for (int h4 = 0; h4 < 32; ++h4) {
            const float w0 = W2L[(c2 * 128 + 4 * h4) * 64 + lane], w1 = W2L[(c2 * 128 + 4 * h4 + 1) * 64 + lane], w2 = W2L[(c2 * 128 + 4 * h4 + 2) * 64 + lane], w3 = W2L[(c2 * 128 + 4 * h4 + 3) * 64 + lane];
#pragma unroll
            for (int rr = 0; rr < 16; ++rr) { const f32x4 hv = *(const LAS f32x4*)(HL + (c2 * 64 + row0 + rr) * 128 + 4 * h4); o[rr] += (hv.x * w0 + hv.y * w1) + (hv.z * w2 + hv.w * w3); }
        }
#pragma unroll
        for (int rr = 0; rr < 16; ++rr) { const int row = row0 + rr, blk = row >> 1, gg = row & 1; float* dst;
            if (unit < 256) { const int b = unit >> 3, n = (unit & 7) * 32 + blk; dst = (float*)(A.ws + WS_COMPS) + ((((size_t)b * NBS + n) * 2 + gg) * 2 + c2) * 64; }
            else if (unit < 264) { const int pu = unit - 256, b = pu >> 1, n = (pu & 1) * 32 + blk; dst = (float*)(A.ws + WS_COMPP) + ((((size_t)b * NBP + n) * 2 + gg) * 2 + c2) * 64; }
            else dst = (float*)(A.ws + WS_COMPS) + ((((size_t)blk * NBS + 256) * 2 + gg) * 2 + c2) * 64;
            dst[lane] = o[rr]; }
    }
    __syncthreads();
#endif
}
}

namespace poolk {
typedef short bf16x8 __attribute__((ext_vector_type(8)));
typedef float f32x16 __attribute__((ext_vector_type(16)));
typedef float f32x2 __attribute__((ext_vector_type(2)));
constexpr int DP = 272;
constexpr int WAVE_LDS = 32 * DP;
constexpr int NITEMS = 4 * 512 + 4 * 32;
template <int W>
__device__ __forceinline__ void pool_d(const f32x2 (&C)[48], int ntok, int pos0, bool is_s, LAS unsigned char* dl, int lane) {
#pragma unroll
    for (int tk = 0; tk < 32; ++tk) {
        f32x2 d = {0.f, 0.f};
        if (tk < ntok) {
            const float cnt = is_s ? (float)W : (float)((pos0 + tk + 1 < W) ? pos0 + tk + 1 : W);
            const f32x2 win = C[16 + tk] - C[16 + tk - W], own = C[16 + tk] - C[15 + tk];
            d = win / cnt - own;
        }
        *(LAS unsigned*)(dl + tk * DP + lane * 4) = att::cvtpk(d.x, d.y);
    }
}
__device__ __forceinline__ void pool_phase(const Frame& F, const Args& A) {
#if defined(__HIP_DEVICE_COMPILE__)
    const int lane = F.lane, wave = F.wave, r32 = lane & 31, h = lane >> 5;
    LAS unsigned char* dl = F.lds + wave * WAVE_LDS;
    const float* PROJ = (const float*)(A.ws + WS_PROJ);
    const int gw = F.bid * NWAVES + wave, NGW = F.G * NWAVES;
    for (int it = gw; it < NITEMS; it += NGW) {
        int gi, row0, ntok, pos0; bool is_s; int sb = 0;
        if (it < 2048) { gi = it >> 9; const int ch = it & 511; row0 = ch * 32; ntok = 32; pos0 = row0 & (SEQ - 1); is_s = false; }
        else { const int q = it - 2048; gi = q >> 5; sb = q & 31; row0 = NPR + sb * 8; ntok = 8; pos0 = PAST; is_s = true; }
        f32x2 C[48];
        {
            f32x2 R[47];
            const int coff = C_U + gi * 128 + lane * 2;
#pragma unroll
            for (int i = 0; i < 47; ++i) {
                f32x2 v = {0.f, 0.f};
                if (!is_s) { const int t = pos0 - 15 + i; if (t >= 0) v = *(const f32x2*)(PROJ + (size_t)(row0 - 15 + i) * PW + coff); }
                else if (i < 15) v = *(const f32x2*)(A.in[5] + ((size_t)sb * 15 + i) * 512 + gi * 128 + lane * 2);
                else if (i < 23) v = *(const f32x2*)(PROJ + (size_t)(row0 + i - 15) * PW + coff);
                R[i] = v;
            }
            C[0] = (f32x2){0.f, 0.f};
#pragma unroll
            for (int i = 0; i < 47; ++i) C[i + 1] = C[i] + R[i];
        }
        switch (gi) { case 0: pool_d<2>(C, ntok, pos0, is_s, dl, lane); break; case 1: pool_d<4>(C, ntok, pos0, is_s, dl, lane); break;
                      case 2: pool_d<8>(C, ntok, pos0, is_s, dl, lane); break; default: pool_d<16>(C, ntok, pos0, is_s, dl, lane); break; }
        LDS_WAIT(); asm volatile("" ::: "memory");
        f32x16 acc[4];
#pragma unroll
        for (int t = 0; t < 4; ++t)
#pragma unroll
            for (int r = 0; r < 16; ++r) acc[t][r] = 0.f;
        const bf16* wp = (const bf16*)(A.ws + WS_WPOOL) + (size_t)gi * 16384;
#pragma unroll
        for (int ks = 0; ks < 8; ++ks) {
            const bf16x8 bfr = *(const LAS bf16x8*)(dl + r32 * DP + (16 * ks + 8 * h) * 2);
#pragma unroll
            for (int t = 0; t < 4; ++t) { const bf16x8 afr = *(const bf16x8*)(wp + (size_t)(t * 32 + r32) * 128 + 16 * ks + 8 * h);
                acc[t] = __builtin_amdgcn_mfma_f32_32x32x16_bf16(afr, bfr, acc[t], 0, 0, 0); }
        }
        if (r32 < ntok) {
            bf16* orow = (bf16*)(A.ws + WS_MIX) + (size_t)(row0 + r32) * DM + 512 + gi * 128;
            const float* ps = A.in[13] + gi * 128;
#pragma unroll
            for (int t = 0; t < 4; ++t)
#pragma unroll
                for (int q4 = 0; q4 < 4; ++q4) { const int dd = t * 32 + 8 * q4 + 4 * h; const f32x4 sc = *(const f32x4*)(ps + dd);
                    v2u o; o.x = att::cvtpk(acc[t][4 * q4] * sc.x, acc[t][4 * q4 + 1] * sc.y); o.y = att::cvtpk(acc[t][4 * q4 + 2] * sc.z, acc[t][4 * q4 + 3] * sc.w);
                    *(v2u*)(orow + dd) = o; }
        }
        LDS_WAIT(); asm volatile("" ::: "memory");
    }
#endif
}
}

namespace sg {
typedef short bf16x8 __attribute__((ext_vector_type(8)));
typedef float f32x16 __attribute__((ext_vector_type(16)));
struct EpiF32 { float* C; int ldc; __device__ __forceinline__ void operator()(int row, int col, float v) const { C[(size_t)row * ldc + col] = v; } };
struct EpiRes { const float* base; float* out; int ldc; __device__ __forceinline__ void operator()(int row, int col, float v) const { out[(size_t)row * ldc + col] = base[(size_t)row * ldc + col] + v; } };
struct EpiRelu2 { bf16* O; int ldc; __device__ __forceinline__ void operator()(int row, int col, float v) const { const float a = fmaxf(v, 0.f); O[(size_t)row * ldc + col] = (bf16)f2bf(a * a); } };
template <class Epi>
__device__ __forceinline__ void sgemm(const Frame& F, const bf16* Arows, const bf16* Bt, int K, int N, const Epi& E) {
#if defined(__HIP_DEVICE_COMPILE__)
    const int lane = F.lane, wave = F.wave, r32 = lane & 31, h = lane >> 5, split = wave & 3, tsel = wave >> 2;
    LAS float* red = (LAS float*)F.lds;
    const int nitems = 8 * (N / 32) / 2, kq = K / 4, nk = kq / 16;
    for (int it = F.bid; it < nitems; it += F.G) {
        const int tile = it * 2 + tsel, tm = tile & 7, tn = tile >> 3;
        const bf16* ap = Arows + (size_t)(tm * 32 + r32) * K + split * kq + 8 * h;
        const bf16* bp = Bt + (size_t)(tn * 32 + r32) * K + split * kq + 8 * h;
        f32x16 acc;
#pragma unroll
        for (int r = 0; r < 16; ++r) acc[r] = 0.f;
#pragma unroll 8
        for (int ks = 0; ks < nk; ++ks) { const bf16x8 a = *(const bf16x8*)(ap + 16 * ks); const bf16x8 b = *(const bf16x8*)(bp + 16 * ks); acc = __builtin_amdgcn_mfma_f32_32x32x16_bf16(a, b, acc, 0, 0, 0); }
        __syncthreads();
        if (split != 0) {
#pragma unroll
            for (int r = 0; r < 16; ++r) red[wave * 1024 + r * 64 + lane] = acc[r]; }
        __syncthreads();
        if (split == 0) {
#pragma unroll
            for (int s = 1; s < 4; ++s)
#pragma unroll
                for (int r = 0; r < 16; ++r) acc[r] += red[(wave + s) * 1024 + r * 64 + lane];
#pragma unroll
            for (int r = 0; r < 16; ++r) E(tm * 32 + (r & 3) + 8 * (r >> 2) + 4 * h, tn * 32 + r32, acc[r]);
        }
    }
    __syncthreads();
#endif
}
}


__device__ __forceinline__ void p7_hb(const Frame& F, const Args& A) {
    const int gw = F.bid * NWAVES + F.wave, NGW = F.G * NWAVES;
    for (int m = gw; m < MTOK; m += NGW) rms_row_to_bf16(((float*)(A.ws + WS_H)) + (size_t)m * DM, A.in[15], ((bf16*)(A.ws + WS_HB)) + (size_t)m * DM, F.lane);
}
__device__ __forceinline__ void p10_final(const Frame& F, const Args& A) {
    const int gw = F.bid * NWAVES + F.wave, NGW = F.G * NWAVES, lane = F.lane;
    for (int m = gw; m < MTOK; m += NGW) {
        f32x4* xr = (f32x4*)(A.out + (size_t)m * DM) + lane; const f32x4* gr = (const f32x4*)A.in[18] + lane;
        f32x4 v[4]; float s = 0.f;
#pragma unroll
        for (int j = 0; j < 4; ++j) { v[j] = xr[64 * j]; s += (v[j].x * v[j].x + v[j].y * v[j].y) + (v[j].z * v[j].z + v[j].w * v[j].w); }
        const float rstd = 1.0f / sqrtf(wave_sum(s) * (1.f / DM) + 1e-6f);
#pragma unroll
        for (int j = 0; j < 4; ++j) xr[64 * j] = v[j] * rstd * gr[64 * j];
    }
}

__global__ void __launch_bounds__(NTHR, 2) fwd_kernel(Args A) {
    extern __shared__ __attribute__((aligned(16))) unsigned char lds_raw[];
    Frame F;
    F.lds = (LAS unsigned char*)lds_raw;
    F.tid = threadIdx.x; F.lane = F.tid & 63; F.wave = __builtin_amdgcn_readfirstlane(F.tid >> 6); F.G = gridDim.x; F.bid = blockIdx.x;
    unsigned char* ws = A.ws;
    for (int u = F.tid; u < (LDS_BYTES - LDSCTL_OFF) / 4; u += NTHR) ((LAS unsigned*)(F.lds + LDSCTL_OFF))[u] = 0u;
    __syncthreads();
    const int lo = A.ph_lo, hi = A.ph_hi;
    const bool multi = (hi - lo) > 1;
    XcdBarrier bar; bar.bar = (unsigned*)(ws + WS_CTL) + CW_BAR; bar.x = 0; bar.st = nullptr;
    if (multi) bar = xcd_barrier_post((unsigned*)(ws + WS_CTL) + CW_BAR, (volatile LAS unsigned*)(F.lds + MISC_OFF));
#define IN(k) (lo <= (k) && (k) < hi)
#define SEAM(k) do { if (IN(k) && IN((k) + 1)) xcd_barrier(bar); } while (0)

#ifndef REP_PHASE
#define REP_PHASE -1
#endif
#define RUN(k, ...) if (IN(k)) { __VA_ARGS__; if (REP_PHASE == (k)) { xcd_barrier(bar); __VA_ARGS__; } } SEAM(k)
#define GEMM_BODY(EPI, Aptr, Bptr, M_, N_, K_, ...) do { pg8::Gemm g{Aptr, Bptr, M_, N_, K_}; pg8::StaticOrder S; S.init(M_, N_, F.G, F.bid); pg8::EPI E{__VA_ARGS__}; pg8::gemm_phase<pg8::EPI, pg8::StaticOrder>(F.lds, g, S, E, nullptr); } while (0)
    RUN(0, p0_prologue(F, A));
    RUN(1, do { for (int u = F.bid; u < cmpk::NUNITS_PAST; u += F.G) cmpk::cmp_unit(F, A, u);
                sg::sgemm(F, ((const bf16*)(A.ws + WS_XN)) + (size_t)NPR * DM, ((const bf16*)(A.ws + WS_WIN)), DM, PW, sg::EpiF32{((float*)(A.ws + WS_PROJ)) + (size_t)NPR * PW, PW});
                GEMM_BODY(EpiF32, ((bf16*)(A.ws + WS_XN)), ((bf16*)(A.ws + WS_WIN)), NPR, PW, DM, ((float*)(A.ws + WS_PROJ)), PW); } while (0));
    RUN(2, do { for (int u = cmpk::NUNITS_PAST + F.bid; u < cmpk::NUNITS_ALL; u += F.G) cmpk::cmp_unit(F, A, u); p2_copies(F, A); poolk::pool_phase(F, A); } while (0));
    if (IN(3)) { att::attn_phase(F, A, 0); if (REP_PHASE == 3) { xcd_barrier(bar); att::attn_phase(F, A, 1); } } SEAM(3);
    RUN(4, do { sg::sgemm(F, ((const bf16*)(A.ws + WS_MIX)) + (size_t)NPR * DM, ((const bf16*)(A.ws + WS_WOUT)), DM, DM, sg::EpiRes{A.in[1], ((float*)(A.ws + WS_H)) + (size_t)NPR * DM, DM});
                GEMM_BODY(EpiResF32, ((bf16*)(A.ws + WS_MIX)), ((bf16*)(A.ws + WS_WOUT)), NPR, DM, DM, A.in[0], A.in[0], 1 << 20, ((float*)(A.ws + WS_H)), DM); } while (0));
    RUN(5, p7_hb(F, A));
    RUN(6, do { sg::sgemm(F, ((const bf16*)(A.ws + WS_HB)) + (size_t)NPR * DM, ((const bf16*)(A.ws + WS_WUP)), DM, DFF, sg::EpiRelu2{((bf16*)(A.ws + WS_ACT)) + (size_t)NPR * DFF, DFF});
                GEMM_BODY(EpiRelu2Bf16, ((bf16*)(A.ws + WS_HB)), ((bf16*)(A.ws + WS_WUP)), NPR, DFF, DM, ((bf16*)(A.ws + WS_ACT)), DFF); } while (0));
    RUN(7, do { sg::sgemm(F, ((const bf16*)(A.ws + WS_ACT)) + (size_t)NPR * DFF, ((const bf16*)(A.ws + WS_WDN)), DFF, DM, sg::EpiRes{((const float*)(A.ws + WS_H)) + (size_t)NPR * DM, A.out + (size_t)NPR * DM, DM});
                GEMM_BODY(EpiResF32, ((bf16*)(A.ws + WS_ACT)), ((bf16*)(A.ws + WS_WDN)), NPR, DM, DFF, ((float*)(A.ws + WS_H)), ((float*)(A.ws + WS_H)), 1 << 20, A.out, DM); } while (0));
    if (IN(8)) { p10_final(F, A); }
#undef IN
#undef SEAM
}

#ifndef MK_ONE_LAUNCH
#define MK_ONE_LAUNCH 1
#endif
extern "C" void kernel_launch(void* const* d_in, const int* in_sizes, int n_in, void* d_out, int out_size, void* d_ws, size_t ws_size, hipStream_t stream) {
    static int grid = 0;
    if (grid == 0) {
        if (n_in != 19 || (size_t)out_size != O_END || ws_size < WS_END) { fprintf(stderr, "kernel_launch: unexpected shapes n_in %d out %d ws %zu\n", n_in, out_size, ws_size); grid = -1; return; }
        int dev = 0, cus = 0, per_cu = 0;
        if (hipGetDevice(&dev) != hipSuccess || hipDeviceGetAttribute(&cus, hipDeviceAttributeMultiprocessorCount, dev) != hipSuccess) { grid = -1; return; }
        if (hipFuncSetAttribute((const void*)fwd_kernel, hipFuncAttributeMaxDynamicSharedMemorySize, LDS_BYTES) != hipSuccess) { fprintf(stderr, "kernel_launch: hipFuncSetAttribute failed\n"); grid = -1; return; }
        if (hipOccupancyMaxActiveBlocksPerMultiprocessor(&per_cu, (const void*)fwd_kernel, NTHR, LDS_BYTES) != hipSuccess || per_cu < 1) fprintf(stderr, "kernel_launch: occupancy query says %d\n", per_cu);
        (void)hipGetLastError();
        grid = cus;
    }
    if (grid < 0) return;
    if (hipMemsetAsync((char*)d_ws + WS_CTL, 0, CTL_ZERO_BYTES, stream) != hipSuccess) return;
    Args a{};
    for (int i = 0; i < 19; ++i) a.in[i] = (const float*)d_in[i];
    a.out = (float*)d_out; a.ws = (unsigned char*)d_ws;
#if MK_ONE_LAUNCH
    a.ph_lo = 0; a.ph_hi = NPHASES;
    hipLaunchKernelGGL(fwd_kernel, dim3(grid), dim3(NTHR), LDS_BYTES, stream, a);
#else
    for (int p = 0; p < NPHASES; ++p) { a.ph_lo = p; a.ph_hi = p + 1; hipLaunchKernelGGL(fwd_kernel, dim3(grid), dim3(NTHR), LDS_BYTES, stream, a); }
#endif
}
```

```cpp
#include <hip/hip_runtime.h>
#include <cstdio>
#include <cstdint>
namespace pg8 {
#define PG8_LAS __attribute__((address_space(3)))
typedef unsigned short bf16_t;
typedef short bf16x8 __attribute__((ext_vector_type(8)));
typedef float f32x4 __attribute__((ext_vector_type(4)));
typedef unsigned u32x4 __attribute__((ext_vector_type(4)));
constexpr int BM = 256, BK = 64, HALF = 128, HTB = HALF * BK * 2  , STAGE_BYTES = 8 * HTB, NXCD = 8, WGM = 8;

__host__ __device__ __forceinline__ int lds_byte(int r, int c) { const int st = (r >> 4) * 2 + (c >> 5), rr = r & 15, cc = c & 31, ob = rr * 64 + cc * 2; return st * 1024 + (ob ^ (((ob >> 9) & 1) << 5)); }
__host__ __device__ __forceinline__ void stage_rc(int b, int& R, int& C) { const int st = b / 1024, sb = b % 1024, swz = sb ^ (((sb >> 9) & 1) << 5); R = (st >> 1) * 16 + swz / 64; C = (st & 1) * 32 + (swz % 64) / 2; }
__host__ __device__ __forceinline__ int perm32(int rho) { const int n = rho >> 4, i = rho & 15; return 8 * (i >> 2) + 4 * n + (i & 3); }

struct Unit { int pm, pn; };
struct Gemm { const bf16_t* A; const bf16_t* Bt; int M, N, K; };

struct StaticOrder {
    int nM, nN, nwg, G, c;
    __host__ __device__ void init(int M, int N, int G_, int c_) { nM = M / BM; nN = N / BM; nwg = nM * nN; G = G_; c = c_; }
    __host__ __device__ bool next(int i, Unit& u) const {
        const long L = (long)i * G + c; if (L >= nwg) return false;
        int wgid = (int)L; { const int q = nwg / NXCD, r = nwg % NXCD, xcd = wgid % NXCD, off = wgid / NXCD; wgid = (xcd < r ? xcd * (q + 1) : r * (q + 1) + (xcd - r) * q) + off; }
        const int nig = WGM * nN, gid = wgid / nig, fm = gid * WGM, gsz = (nM - fm) < WGM ? (nM - fm) : WGM;
        u.pm = fm + ((wgid % nig) % gsz); u.pn = (wgid % nig) / gsz; return true;
    }
    __device__ __forceinline__ void a_ready(const Unit&) const {}
    __device__ __forceinline__ void done(const Unit&) const {}
};
struct CountedOrder : StaticOrder {
    const unsigned* ready; unsigned need; unsigned* tmo;
    __device__ __forceinline__ void a_ready(const Unit& u) const {
        if (threadIdx.x < 64) {
            const unsigned long long t0 = __builtin_amdgcn_s_memrealtime(); unsigned polls = 0;
            while ((unsigned)__builtin_amdgcn_readfirstlane(__hip_atomic_load(ready + 64 * u.pm, __ATOMIC_RELAXED, __HIP_MEMORY_SCOPE_AGENT)) < need) {
                if ((++polls & 255u) == 0u && __builtin_amdgcn_readfirstlane(__hip_atomic_load(tmo, __ATOMIC_RELAXED, __HIP_MEMORY_SCOPE_AGENT)) != 0u) break;
                if (__builtin_amdgcn_s_memrealtime() - t0 > 2000000ull) {
                    if (threadIdx.x == 0) { unsigned expect = 0u; __hip_atomic_compare_exchange_strong(tmo + 1, &expect, 0x600u | (unsigned)(u.pm & 0xff), __ATOMIC_RELAXED, __ATOMIC_RELAXED, __HIP_MEMORY_SCOPE_AGENT); __hip_atomic_store(tmo, 1u, __ATOMIC_RELAXED, __HIP_MEMORY_SCOPE_AGENT); }
                    break; }
                __builtin_amdgcn_s_sleep(2); }
            __builtin_amdgcn_fence(__ATOMIC_ACQUIRE, "agent");
            asm volatile("s_waitcnt vmcnt(0)" ::: "memory");
        }
#if !defined(BROKEN_HOOK_NO_BARRIER)
        asm volatile("" ::: "memory"); __builtin_amdgcn_s_barrier(); asm volatile("" ::: "memory");
#endif
    }
};

__device__ __forceinline__ unsigned cvt_pk_bf16(float lo, float hi) { unsigned r; asm volatile("v_cvt_pk_bf16_f32 %0, %1, %2" : "=v"(r) : "v"(lo), "v"(hi)); return r; }
struct EpiF32 {
    static constexpr bool PERM = false, AFTER_DRAIN = false;
    float* C; int ldc;
    __device__ __forceinline__ void operator()(const f32x4 (&acc)[2][2][4][2], const Unit& u, int wr, int wc, int fr, int fq) const {
        const int row0 = u.pm * BM + wr * 64 + fr, col0 = u.pn * BM + wc * 32 + 4 * fq;
#pragma unroll
        for (int ai = 0; ai < 2; ++ai)
#pragma unroll
            for (int m = 0; m < 4; ++m) { float* rowp = C + (size_t)(row0 + ai * HALF + m * 16) * ldc + col0;
#pragma unroll
                for (int bj = 0; bj < 2; ++bj)
#pragma unroll
                    for (int n = 0; n < 2; ++n) *(f32x4*)(rowp + bj * HALF + n * 16) = acc[ai][bj][m][n]; }
    }
};
struct EpiResF32 {
    static constexpr bool PERM = false, AFTER_DRAIN = false;
    const float* base0; const float* base1; int split; float* out; int ldc;
    __device__ __forceinline__ void operator()(const f32x4 (&acc)[2][2][4][2], const Unit& u, int wr, int wc, int fr, int fq) const {
        const int row0 = u.pm * BM + wr * 64 + fr, col0 = u.pn * BM + wc * 32 + 4 * fq;
        const float* bb = (u.pm < split) ? base0 : (base1 - (size_t)split * BM * ldc);
#pragma unroll
        for (int ai = 0; ai < 2; ++ai)
#pragma unroll
            for (int m = 0; m < 4; ++m) { const size_t off = (size_t)(row0 + ai * HALF + m * 16) * ldc + col0;
#pragma unroll
                for (int bj = 0; bj < 2; ++bj)
#pragma unroll
                    for (int n = 0; n < 2; ++n) { const f32x4 b = *(const f32x4*)(bb + off + bj * HALF + n * 16); *(f32x4*)(out + off + bj * HALF + n * 16) = acc[ai][bj][m][n] + b; } }
    }
};
struct EpiRelu2Bf16 {
    static constexpr bool PERM = true, AFTER_DRAIN = false;
    bf16_t* O; int ldc;
    __device__ __forceinline__ void operator()(const f32x4 (&acc)[2][2][4][2], const Unit& u, int wr, int wc, int fr, int fq) const {
        const int row0 = u.pm * BM + wr * 64 + fr, col0 = u.pn * BM + wc * 32 + 8 * fq;
#pragma unroll
        for (int ai = 0; ai < 2; ++ai)
#pragma unroll
            for (int m = 0; m < 4; ++m) { bf16_t* rowp = O + (size_t)(row0 + ai * HALF + m * 16) * ldc + col0;
#pragma unroll
                for (int bj = 0; bj < 2; ++bj) { f32x4 v0 = acc[ai][bj][m][0], v1 = acc[ai][bj][m][1];
#pragma unroll
                    for (int j = 0; j < 4; ++j) { const float a = fmaxf(v0[j], 0.f), b = fmaxf(v1[j], 0.f); v0[j] = a * a; v1[j] = b * b; }
                    u32x4 w; w.x = cvt_pk_bf16(v0[0], v0[1]); w.y = cvt_pk_bf16(v0[2], v0[3]); w.z = cvt_pk_bf16(v1[0], v1[1]); w.w = cvt_pk_bf16(v1[2], v1[3]);
                    *(u32x4*)(rowp + bj * HALF) = w; } }
    }
};
__device__ __forceinline__ float gelu_tanh(float x) {
    const float y = 0.7978845608028654f * (x + 0.044715f * x * x * x);
    const float t = 1.0f - 2.0f / (__expf(2.0f * y) + 1.0f);
    return 0.5f * x * (1.0f + t);
}
struct EpiCmpHid {
    static constexpr bool PERM = false, AFTER_DRAIN = false;
    float* H; int csplit;
    __device__ __forceinline__ void operator()(const f32x4 (&acc)[2][2][4][2], const Unit& u, int wr, int wc, int fr, int fq) const {
        const int row0 = u.pm * BM + wr * 64 + fr, col0 = wc * 32 + 4 * fq;
        const bool c1 = u.pm >= csplit;
#pragma unroll
        for (int ai = 0; ai < 2; ++ai)
#pragma unroll
            for (int m = 0; m < 4; ++m) { float* rowp = H + (size_t)(row0 + ai * HALF + m * 16) * 128 + col0;
#pragma unroll
                for (int n = 0; n < 2; ++n) { f32x4 v = c1 ? acc[ai][1][m][n] : acc[ai][0][m][n];
#pragma unroll
                    for (int j = 0; j < 4; ++j) v[j] = gelu_tanh(v[j]);
                    *(f32x4*)(rowp + n * 16) = v; } }
    }
};
template <class Epi, class Sched, bool STAMP = false>
__device__ __forceinline__ void gemm_phase(PG8_LAS unsigned char* lds, const Gemm g, const Sched& S, const Epi& E, unsigned long long* stamps) {
    const int tid = threadIdx.x, wid = __builtin_amdgcn_readfirstlane(tid >> 6), lane = tid & 63, wr = wid >> 2, wc = wid & 3, fr = lane & 15, fq = lane >> 4;
    const int K = g.K, nt = K / BK;
    int ts_lo = 0, ts_hi = 0, nts = 0; const unsigned long long rt_entry = STAMP ? (unsigned long long)wall_clock64() : 0ull;
#define PG8_STAMP() do { if (STAMP && wid == 0 && nts < 64) { const unsigned long long _c = (unsigned long long)clock64(); \
        ts_lo = (lane == nts) ? (int)(unsigned)_c : ts_lo; ts_hi = (lane == nts) ? (int)(unsigned)(_c >> 32) : ts_hi; ++nts; } } while (0)
    PG8_STAMP();
    unsigned voffA[2], voffB[2];
#pragma unroll
    for (int i = 0; i < 2; ++i) { int R, C; stage_rc(tid * 16 + i * 8192, R, C); const int Rb = Epi::PERM ? ((R & ~31) + perm32(R & 31)) : R;
        voffA[i] = (unsigned)(R * K + C) * 2u; voffB[i] = (unsigned)(Rb * K + C) * 2u; }
    const size_t kstep = (size_t)(BK * 2);
    const size_t hstep = (size_t)HALF * K * 2;
    const size_t tstep = 2 * hstep;
    const unsigned ldsw = (unsigned)wid * 1024u;
    const int aoff = lds_byte(wr * 64 + fr, fq * 8), boff = lds_byte(wc * 32 + fr, fq * 8);
#define PG8_SA(b, h) (((b) * 2 + (h)) * HTB)
#define PG8_SB(b, h) ((4 + (b) * 2 + (h)) * HTB)
#define PG8_STAGE(bufoff, gbase, voff) do { _Pragma("unroll") for (int _i = 0; _i < 2; ++_i) \
        __builtin_amdgcn_global_load_lds((const unsigned*)((const char*)(gbase) + (voff)[_i]), (PG8_LAS unsigned*)(lds + (bufoff) + ldsw + _i * 8192), 16, 0, 0); } while (0)
#define PG8_LDA(dst, b, h) do { _Pragma("unroll") for (int m = 0; m < 4; ++m) _Pragma("unroll") for (int k = 0; k < 2; ++k) dst[m][k] = *(const PG8_LAS bf16x8*)(lds + PG8_SA(b, h) + aoff + m * 2048 + k * 1024); } while (0)
#define PG8_LDB(dst, b, h) do { _Pragma("unroll") for (int n = 0; n < 2; ++n) _Pragma("unroll") for (int k = 0; k < 2; ++k) dst[n][k] = *(const PG8_LAS bf16x8*)(lds + PG8_SB(b, h) + boff + n * 2048 + k * 1024); } while (0)
#define PG8_MMA(ai, bj, At, Bt) do { __builtin_amdgcn_s_setprio(1); _Pragma("unroll") for (int m = 0; m < 4; ++m) _Pragma("unroll") for (int n = 0; n < 2; ++n) _Pragma("unroll") for (int k = 0; k < 2; ++k) \
        acc[ai][bj][m][n] = __builtin_amdgcn_mfma_f32_16x16x32_bf16(Bt[n][k], At[m][k], acc[ai][bj][m][n], 0, 0, 0); __builtin_amdgcn_s_setprio(0); } while (0)
#define PG8_WAIT_V(n) asm volatile("s_waitcnt vmcnt(" #n ")" ::: "memory")
#define PG8_WAIT_L(n) asm volatile("s_waitcnt lgkmcnt(" #n ")" ::: "memory")
#define PG8_BAR __builtin_amdgcn_s_barrier()
#define PG8_SCHED __builtin_amdgcn_sched_barrier(0)
    Unit cur, nxt; int ui = 0;
    if (!S.next(0, cur)) return;
    f32x4 acc[2][2][4][2];
#pragma unroll
    for (int a = 0; a < 2; ++a)
#pragma unroll
        for (int b = 0; b < 2; ++b)
#pragma unroll
            for (int m = 0; m < 4; ++m)
#pragma unroll
                for (int n = 0; n < 2; ++n) acc[a][b][m][n] = (f32x4){0.f, 0.f, 0.f, 0.f};
    bf16x8 At[4][2], B0[2][2], B1[2][2];
    const char* cA = (const char*)g.A + (size_t)cur.pm * tstep; const char* cB = (const char*)g.Bt + (size_t)cur.pn * tstep;
    S.a_ready(cur);
    PG8_STAGE(PG8_SB(0, 0), cB, voffB); PG8_STAGE(PG8_SA(0, 0), cA, voffA); PG8_STAGE(PG8_SB(0, 1), cB + hstep, voffB); PG8_STAGE(PG8_SA(0, 1), cA + hstep, voffA);
    if (wr == 1) PG8_BAR;
    PG8_WAIT_V(4); PG8_BAR;
    PG8_STAGE(PG8_SB(1, 0), cB + kstep, voffB); PG8_STAGE(PG8_SA(1, 0), cA + kstep, voffA); PG8_STAGE(PG8_SB(1, 1), cB + hstep + kstep, voffB);
    PG8_WAIT_V(6); PG8_BAR;
    PG8_STAMP();
    for (;;) {
        const bool has_next = S.next(ui + 1, nxt);
        const char* nA = has_next ? (const char*)g.A + (size_t)nxt.pm * tstep : cA; const char* nB = has_next ? (const char*)g.Bt + (size_t)nxt.pn * tstep : cB;
        for (int t = 0; t < nt; t += 2) {
            const bool last = (t == nt - 2);
            const char* a1 = cA + (size_t)(t + 1) * kstep;
            const char* a2 = last ? nA : cA + (size_t)(t + 2) * kstep; const char* b2 = last ? nB : cB + (size_t)(t + 2) * kstep;
            const char* a3 = a2 + kstep; const char* b3 = b2 + kstep;
            if (last && has_next) S.a_ready(nxt);
            PG8_LDB(B0, 0, 0); PG8_SCHED; PG8_LDA(At, 0, 0); PG8_STAGE(PG8_SA(1, 1), a1 + hstep, voffA);
            PG8_WAIT_L(8); PG8_BAR; PG8_WAIT_L(0); PG8_MMA(0, 0, At, B0); PG8_BAR; PG8_SCHED;
            PG8_LDB(B1, 0, 1); PG8_STAGE(PG8_SB(0, 0), b2, voffB);
            PG8_BAR; PG8_WAIT_L(0); PG8_MMA(0, 1, At, B1); PG8_BAR;
            PG8_LDA(At, 0, 1); PG8_STAGE(PG8_SA(0, 0), a2, voffA);
            PG8_BAR; PG8_WAIT_L(0); PG8_MMA(1, 0, At, B0); PG8_BAR; PG8_SCHED;
            PG8_STAGE(PG8_SB(0, 1), b2 + hstep, voffB);
            PG8_WAIT_V(6); PG8_BAR; PG8_MMA(1, 1, At, B1); PG8_BAR;
            PG8_LDB(B0, 1, 0); PG8_SCHED; PG8_LDA(At, 1, 0); PG8_STAGE(PG8_SA(0, 1), a2 + hstep, voffA);
            PG8_WAIT_L(8); PG8_BAR; PG8_WAIT_L(0); PG8_MMA(0, 0, At, B0); PG8_BAR; PG8_SCHED;
            PG8_LDB(B1, 1, 1); PG8_STAGE(PG8_SB(1, 0), b3, voffB);
            PG8_BAR; PG8_WAIT_L(0); PG8_MMA(0, 1, At, B1); PG8_BAR;
            PG8_LDA(At, 1, 1); PG8_STAGE(PG8_SA(1, 0), a3, voffA);
            PG8_BAR; PG8_WAIT_L(0); PG8_MMA(1, 0, At, B0); PG8_BAR; PG8_SCHED;
            PG8_STAGE(PG8_SB(1, 1), b3 + hstep, voffB);
            PG8_WAIT_V(6); PG8_BAR; PG8_MMA(1, 1, At, B1); PG8_BAR;
        }
        PG8_STAMP();
        if constexpr (!Epi::AFTER_DRAIN) { E(acc, cur, wr, wc, fr, fq); S.done(cur); }
        PG8_STAMP();
        if (!has_next) break;
#pragma unroll
        for (int a = 0; a < 2; ++a)
#pragma unroll
            for (int b = 0; b < 2; ++b)
#pragma unroll
                for (int m = 0; m < 4; ++m)
#pragma unroll
                    for (int n = 0; n < 2; ++n) acc[a][b][m][n] = (f32x4){0.f, 0.f, 0.f, 0.f};
        cur = nxt; cA = nA; cB = nB; ++ui;
    }
    PG8_WAIT_V(0);
    if (wr == 0) PG8_BAR;
    PG8_BAR;
    if constexpr (Epi::AFTER_DRAIN) { E.fused(acc, cur, wr, wc, fr, fq, lds, wid, lane); S.done(cur); }
    PG8_STAMP();
    if (STAMP && wid == 0) { stamps[lane] = lane < nts ? (((unsigned long long)(unsigned)ts_hi << 32) | (unsigned)ts_lo) : 0ull;
        if (lane == 62) stamps[62] = rt_entry; if (lane == 63) stamps[63] = (unsigned long long)wall_clock64(); }
#undef PG8_STAMP
#undef PG8_SA
#undef PG8_SB
#undef PG8_STAGE
#undef PG8_LDA
#undef PG8_LDB
#undef PG8_MMA
#undef PG8_WAIT_V
#undef PG8_WAIT_L
#undef PG8_BAR
#undef PG8_SCHED
}
}

constexpr int DM = 1024, NPR = 16384, NSM = 256, MTOK = NPR + NSM, SEQ = 4096, NBP = 64, PAST = 16384, NBS = 257, NPG = 128, DFF = 4096;
constexpr int PW = 2048;
constexpr int C_Q = 0, C_KC = 512, C_KS = 768, C_KW = 1024, C_U = 1280, C_G = 1792;
constexpr int CMP_SEC = 17152, CMP_ROWS = 2 * CMP_SEC;
constexpr int CMP_R_PROMPT = 16384, CMP_R_NEW = 16896, CMP_R_END = 16960;
constexpr size_t O_YP = 0, O_YS = 16777216, O_PCMP = 17039360, O_PSLC = 21233664, O_PWIN = 25427968, O_PPOOL = 25952256,
                 O_SCMP = 25982976, O_SSLC = 26048512, O_SWIN = 26114048, O_SPOOL = 30308352, O_END = 30554112;
constexpr size_t MiB = 1u << 20;
constexpr size_t WS_CTL = 0, CTL_ZERO_BYTES = 1 * MiB;
constexpr size_t WS_WIN = 2 * MiB, WS_WOUT = 6 * MiB, WS_WUP = 8 * MiB, WS_WDN = 16 * MiB, WS_W1S = 24 * MiB, WS_WPOOL = 26 * MiB;
constexpr size_t WS_XN = 32 * MiB, WS_PROJ = 66 * MiB, WS_ACMP = 200 * MiB, WS_HID = 470 * MiB, WS_COMPS = 490 * MiB, WS_COMPP = 500 * MiB;
constexpr size_t WS_MIX = 502 * MiB, WS_H = 536 * MiB, WS_HB = 602 * MiB, WS_ACT = 636 * MiB, WS_END = 768 * MiB;
static_assert(WS_XN + (size_t)MTOK * DM * 2 <= WS_PROJ && WS_PROJ + (size_t)MTOK * PW * 4 <= WS_ACMP && WS_ACMP + (size_t)CMP_ROWS * 4096 * 2 <= WS_HID, "ws map 1");
static_assert(WS_HID + (size_t)CMP_ROWS * 128 * 4 <= WS_COMPS && WS_COMPS + (size_t)32 * NBS * 256 * 4 <= WS_COMPP && WS_COMPP + (size_t)4 * NBP * 256 * 4 <= WS_MIX, "ws map 2");
static_assert(WS_MIX + (size_t)MTOK * DM * 2 <= WS_H && WS_H + (size_t)MTOK * DM * 4 <= WS_HB && WS_HB + (size_t)MTOK * DM * 2 <= WS_ACT && WS_ACT + (size_t)MTOK * DFF * 2 <= WS_END, "ws map 3");
constexpr int CW_BAR = 4096, CW_QUEUE = 8192;

constexpr int NWAVES = 8, NTHR = NWAVES * 64;
constexpr int RING_BYTES = 131072, LDSCTL_OFF = 143360, MISC_OFF = LDSCTL_OFF + 320, LDS_BYTES = 147456;
constexpr int NPHASES = 9;

#define GAS __attribute__((address_space(1)))
#define LAS __attribute__((address_space(3)))
typedef unsigned short bf16;
typedef unsigned v4u __attribute__((ext_vector_type(4)));
typedef unsigned v2u __attribute__((ext_vector_type(2)));
typedef float f32x4 __attribute__((ext_vector_type(4)));
#define LDS_WAIT() asm volatile("s_waitcnt lgkmcnt(0)" ::: "memory")
__device__ __forceinline__ unsigned f2bf(float f) { unsigned u = __builtin_bit_cast(unsigned, f); return (u + 0x7fffu + ((u >> 16) & 1u)) >> 16; }
__device__ __forceinline__ unsigned pk2(float lo, float hi) { return f2bf(lo) | (f2bf(hi) << 16); }
__device__ __forceinline__ float wave_sum(float v) {
#pragma unroll
    for (int o = 1; o < 64; o <<= 1) v += __shfl_xor(v, o);
    return v;
}
__device__ __forceinline__ float wave_max(float v) {
#pragma unroll
    for (int o = 1; o < 64; o <<= 1) v = fmaxf(v, __shfl_xor(v, o));
    return v;
}

#define XB_TMO      128
#define XB_XCNT(j)  (256  + 64 * (j))
#define XB_XSUB(j)  (1280 + 64 * (j))
#define XB_XGEN(j)  (2304 + 64 * (j))
#define XB_TOP      3328
#define XB_TOPGEN   3392
#define XCD_BAR_WORDS 3456
#define XB_SPIN_CAP (1u << 18)
__device__ __forceinline__ unsigned xb_ld(unsigned* p)              { return __hip_atomic_load(p, __ATOMIC_RELAXED, __HIP_MEMORY_SCOPE_AGENT); }
__device__ __forceinline__ unsigned xb_add(unsigned* p, unsigned v) { return __hip_atomic_fetch_add(p, v, __ATOMIC_RELAXED, __HIP_MEMORY_SCOPE_AGENT); }
__device__ __forceinline__ unsigned xb_xcc_id() { return (unsigned)__builtin_amdgcn_s_getreg((3 << 11) | 20) & 0xFu; }
#define XB_SPIN(cond, bar) do { unsigned _sp = 0; while (cond) { __builtin_amdgcn_s_sleep(1); \
    if ((++_sp & 255u) == 0u) { if (xb_ld(&(bar)[XB_TMO])) break; if (_sp > XB_SPIN_CAP) { atomicAdd(&(bar)[XB_TMO], 1u); break; } } } } while (0)
struct XcdBarrier { unsigned* bar; unsigned x; volatile LAS unsigned* st; };
__device__ __forceinline__ XcdBarrier xcd_barrier_post(unsigned* bar, volatile LAS unsigned* st) {
    XcdBarrier b; b.bar = bar; b.x = xb_xcc_id(); b.st = st;
    if (threadIdx.x == 0) (void)xb_add(&bar[XB_XCNT(b.x)], 1u);
    return b;
}
__device__ __forceinline__ void xcd_barrier_complete(unsigned* bar, unsigned x, unsigned& nloc, unsigned& nx) {
    const unsigned G = gridDim.x * gridDim.y * gridDim.z;
    unsigned sum, cnt, mine, sp = 0u;
    for (;;) {
        sum = 0u; cnt = 0u; mine = 0u;
#pragma unroll
        for (unsigned j = 0; j < 16; ++j) { const unsigned c = xb_ld(&bar[XB_XCNT(j)]); sum += c; cnt += (c > 0u) ? 1u : 0u; mine = (j == x) ? c : mine; }
        if (sum == G) break;
        __builtin_amdgcn_s_sleep(1);
        if ((++sp & 255u) == 0u) { if (xb_ld(&bar[XB_TMO])) break; if (sp > XB_SPIN_CAP) { atomicAdd(&bar[XB_TMO], 1u); break; } }
    }
    nloc = mine > 0u ? mine : 1u; nx = cnt > 0u ? cnt : 1u;
}
__device__ __forceinline__ void xcd_barrier(const XcdBarrier& b) {
    asm volatile("s_waitcnt vmcnt(0)" ::: "memory");
    __syncthreads();
    if (threadIdx.x == 0) {
        unsigned* bar = b.bar;
        __builtin_amdgcn_s_waitcnt(0);
        unsigned nloc = b.st[0], nx = b.st[1];
        if (nloc == 0u) { xcd_barrier_complete(bar, b.x, nloc, nx); b.st[0] = nloc; b.st[1] = nx; }
        const unsigned old = xb_add(&bar[XB_XSUB(b.x)], 1u);
        const unsigned gen = old / nloc;
        if (old + 1u == (gen + 1u) * nloc) {
            __builtin_amdgcn_fence(__ATOMIC_RELEASE, "agent");
            asm volatile("s_waitcnt vmcnt(0)" ::: "memory");
            const unsigned og = xb_add(&bar[XB_TOP], 1u);
            const unsigned tg = og / nx;
            if (og + 1u == (tg + 1u) * nx) xb_add(&bar[XB_TOPGEN], 1u);
            else XB_SPIN(xb_ld(&bar[XB_TOPGEN]) == tg, bar);
            __builtin_amdgcn_fence(__ATOMIC_ACQUIRE, "agent");
            xb_add(&bar[XB_XGEN(b.x)], 1u);
            asm volatile("s_waitcnt vmcnt(0)" ::: "memory");
        } else {
            XB_SPIN(xb_ld(&bar[XB_XGEN(b.x)]) == gen, bar);
            __builtin_amdgcn_fence(__ATOMIC_ACQUIRE, "agent");
            asm volatile("s_waitcnt vmcnt(0)" ::: "memory");
        }
    }
    __syncthreads();
}

struct Args { const float* in[19]; float* out; unsigned char* ws; int ph_lo, ph_hi; };
struct Frame {
    LAS unsigned char* lds;
    int tid, lane, wave, G, bid;
};

template <int MAP>
__device__ __forceinline__ void p0_transpose_item(const float* W, int K, int ldw, int nblk, bf16* WT, int row_off, LAS float* scr, int item, int lane) {
    const int kb = item / nblk, nb = item % nblk, k0 = 64 * kb, n0 = 32 * nb;
    const int nd = n0 + (lane & 31);
    int sc = nd;
    if (MAP == 1) { if (nd < 1280) sc = nd; else if (nd < 1792) sc = nd + 24; else if (nd < 1816) sc = nd - 512; else sc = -1; }
#pragma unroll 8
    for (int i = 0; i < 32; ++i) { const int kk = 2 * i + (lane >> 5); scr[kk * 33 + (lane & 31)] = (sc >= 0) ? W[(size_t)(k0 + kk) * ldw + sc] : 0.f; }
    LDS_WAIT(); asm volatile("" ::: "memory");
    const int c = lane & 7;
#pragma unroll
    for (int j = 0; j < 4; ++j) { const int n = (lane >> 3) + 8 * j; const LAS float* s = scr + (8 * c) * 33 + n;
        v4u o; o.x = pk2(s[0 * 33], s[1 * 33]); o.y = pk2(s[2 * 33], s[3 * 33]); o.z = pk2(s[4 * 33], s[5 * 33]); o.w = pk2(s[6 * 33], s[7 * 33]);
        *(v4u*)(WT + (size_t)(row_off + n0 + n) * K + k0 + 8 * c) = o; }
    LDS_WAIT(); asm volatile("" ::: "memory");
}
__device__ __forceinline__ void rms_row_to_bf16(const float* xrow, const float* g, bf16* orow, int lane) {
    const f32x4* xr = (const f32x4*)xrow + lane; const f32x4* gr = (const f32x4*)g + lane;
    f32x4 v[4]; float s = 0.f;
#pragma unroll
    for (int j = 0; j < 4; ++j) { v[j] = xr[64 * j]; s += (v[j].x * v[j].x + v[j].y * v[j].y) + (v[j].z * v[j].z + v[j].w * v[j].w); }
    const float rstd = 1.0f / sqrtf(wave_sum(s) * (1.f / DM) + 1e-6f);
    unsigned long long* o8 = (unsigned long long*)orow + lane;
#pragma unroll
    for (int j = 0; j < 4; ++j) { const f32x4 gg = gr[64 * j];
        o8[64 * j] = (unsigned long long)pk2(v[j].x * rstd * gg.x, v[j].y * rstd * gg.y) | ((unsigned long long)pk2(v[j].z * rstd * gg.z, v[j].w * rstd * gg.w) << 32); }
}

__device__ __forceinline__ void p0_prologue(const Frame& F, const Args& A) {
    LAS float* scr = (LAS float*)(F.lds + F.wave * 16384);
    const int gw = F.bid * NWAVES + F.wave, NGW = F.G * NWAVES;
    constexpr int I_IN = (DM / 64) * (PW / 32), I_OUT = (DM / 64) * (DM / 32), I_UP = (DM / 64) * (DFF / 32), I_DN = (DFF / 64) * (DM / 32), I_W1 = (4096 / 64) * (128 / 32);
    constexpr int I_WP = 32;
    constexpr int NITEMS = I_IN + I_OUT + I_UP + I_DN + 2 * I_W1 + I_WP;
    for (int it = gw; it < NITEMS; it += NGW) {
        int r = it;
        if (r < I_IN) { p0_transpose_item<1>(A.in[8], DM, 1816, PW / 32, ((bf16*)(A.ws + WS_WIN)), 0, scr, r, F.lane); continue; } r -= I_IN;
        if (r < I_OUT) { p0_transpose_item<0>(A.in[14], DM, DM, DM / 32, ((bf16*)(A.ws + WS_WOUT)), 0, scr, r, F.lane); continue; } r -= I_OUT;
        if (r < I_UP) { p0_transpose_item<0>(A.in[16], DM, DFF, DFF / 32, ((bf16*)(A.ws + WS_WUP)), 0, scr, r, F.lane); continue; } r -= I_UP;
        if (r < I_DN) { p0_transpose_item<0>(A.in[17], DFF, DM, DM / 32, ((bf16*)(A.ws + WS_WDN)), 0, scr, r, F.lane); continue; } r -= I_DN;
        if (r < I_W1) { p0_transpose_item<0>(A.in[10], 4096, 128, 4, ((bf16*)(A.ws + WS_W1S)), 0, scr, r, F.lane); continue; } r -= I_W1;
        if (r < I_W1) { p0_transpose_item<0>(A.in[10] + (size_t)4096 * 128, 4096, 128, 4, ((bf16*)(A.ws + WS_W1S)), 128, scr, r, F.lane); continue; } r -= I_W1;
        p0_transpose_item<0>(A.in[12] + (size_t)(r >> 3) * 16384, 128, 128, 4, ((bf16*)(A.ws + WS_WPOOL)), (r >> 3) * 128, scr, r & 7, F.lane);
    }
    for (int m = gw; m < MTOK; m += NGW) {
        const float* xr = m < NPR ? A.in[0] + (size_t)m * DM : A.in[1] + (size_t)(m - NPR) * DM;
        rms_row_to_bf16(xr, A.in[7], ((bf16*)(A.ws + WS_XN)) + (size_t)m * DM, F.lane);
    }
}

__device__ __forceinline__ void p2_copies(const Frame& F, const Args& A) {
    const size_t gt = (size_t)F.bid * NTHR + F.tid, NT = (size_t)F.G * NTHR;
    const f32x4* P4 = (const f32x4*)((float*)(A.ws + WS_PROJ));
    f32x4* O4 = (f32x4*)A.out;
    for (size_t i = gt; i < (size_t)NPR * 64; i += NT) { const size_t r = i >> 6, c = i & 63;
        O4[O_PCMP / 4 + i] = P4[r * 512 + C_KC / 4 + c]; O4[O_PSLC / 4 + i] = P4[r * 512 + C_KS / 4 + c]; }
    for (size_t i = gt; i < (size_t)4 * 512 * 64; i += NT) { const size_t c = i & 63, r = (i >> 6) & 511, b = i >> 15;
        O4[O_PWIN / 4 + i] = P4[(b * SEQ + SEQ - 512 + r) * 512 + C_KW / 4 + c]; }
    for (size_t i = gt; i < (size_t)4 * 15 * 128; i += NT) { const size_t c = i & 127, r = (i >> 7) % 15, b = (i >> 7) / 15;
        O4[O_PPOOL / 4 + i] = P4[(b * SEQ + SEQ - 15 + r) * 512 + C_U / 4 + c]; }
    for (size_t i = gt; i < (size_t)NSM * 64; i += NT) { const size_t r = i >> 6, c = i & 63;
        O4[O_SCMP / 4 + i] = P4[(NPR + r) * 512 + C_KC / 4 + c]; O4[O_SSLC / 4 + i] = P4[(NPR + r) * 512 + C_KS / 4 + c]; }
    const f32x4* SW4 = (const f32x4*)A.in[4];
    for (size_t i = gt; i < (size_t)32 * 512 * 64; i += NT) { const size_t c = i & 63, r = (i >> 6) & 511, b = i >> 15;
        O4[O_SWIN / 4 + i] = (r < 504) ? SW4[(b * 512 + r + 8) * 64 + c] : P4[(NPR + b * 8 + (r - 504)) * 512 + C_KW / 4 + c]; }
    const f32x4* SP4 = (const f32x4*)A.in[5];
    for (size_t i = gt; i < (size_t)32 * 15 * 128; i += NT) { const size_t c = i & 127, r = (i >> 7) % 15, b = (i >> 7) / 15;
        O4[O_SPOOL / 4 + i] = (r < 7) ? SP4[(b * 15 + r + 8) * 128 + c] : P4[(NPR + b * 8 + (r - 7)) * 512 + C_U / 4 + c]; }
}
__device__ __forceinline__ void p2_cmp_gather(const Frame& F, const Args& A) {
    const int gw = F.bid * NWAVES + F.wave, NGW = F.G * NWAVES;
    constexpr int NBLK = 8192 + 256 + 32;
    const int lane = F.lane, gc = lane >> 4, g = gc >> 1, c = gc & 1, d0 = (lane & 15) * 4;
    for (int it = gw; it < NBLK * 64; it += NGW) {
        const int blk = it >> 6, l = it & 63;
        f32x4 v; int rsec;
        if (blk < 8192) { const int b = blk >> 8, n = blk & 255; const int page = ((const int*)A.in[6])[b * NPG + (n >> 1)];
            v = *(const f32x4*)(A.in[2] + ((size_t)page * 128 + (n & 1) * 64 + l) * 256 + lane * 4); rsec = (b * 256 + n) * 2 + g; }
        else if (blk < 8192 + 256) { const int q = blk - 8192, b = q >> 6, n = q & 63;
            v = *(const f32x4*)(((float*)(A.ws + WS_PROJ)) + ((size_t)b * SEQ + n * 64 + l) * PW + C_KC + lane * 4); rsec = CMP_R_PROMPT + (b * 64 + n) * 2 + g; }
        else { const int b = blk - 8192 - 256;
            v = (l < 8) ? *(const f32x4*)(((float*)(A.ws + WS_PROJ)) + ((size_t)NPR + b * 8 + l) * PW + C_KC + lane * 4) : (f32x4){0.f, 0.f, 0.f, 0.f}; rsec = CMP_R_NEW + b * 2 + g; }
        const f32x4 pe = *(const f32x4*)(A.in[9] + (l * 2 + c) * 64 + d0);
        v = v + pe;
        v2u o; o.x = pk2(v.x, v.y); o.y = pk2(v.z, v.w);
        *(v2u*)(((bf16*)(A.ws + WS_ACMP)) + ((size_t)c * CMP_SEC + rsec) * 4096 + l * 64 + d0) = o;
    }
}
__device__ __forceinline__ void p2_pool(const Frame& F, const Args& A) {
    LAS float* wl = (LAS float*)F.lds;
    LAS float* dl = (LAS float*)(F.lds + 65536 + F.wave * 2048);
    constexpr int NCH = MTOK / 32;
    const int lane = F.lane;
    for (int unit = F.bid; unit < 4 * NCH; unit += F.G) {
        const int gi = unit / NCH, ch = unit % NCH, w = 2 << gi;
        __syncthreads();
        for (int i = F.tid; i < 128 * 128 / 4; i += NTHR) ((LAS f32x4*)wl)[i] = ((const f32x4*)(A.in[12] + (size_t)gi * 16384))[i];
        const int tok0 = ch * 32 + F.wave * 4;
#pragma unroll
        for (int tk = 0; tk < 4; ++tk) {
            const int row = tok0 + tk;
#pragma unroll
            for (int hh = 0; hh < 2; ++hh) {
                const int cc = gi * 128 + lane + 64 * hh;
                float own, sum = 0.f, cnt;
                if (row < NPR) { const int t = row & (SEQ - 1);
                    own = ((float*)(A.ws + WS_PROJ))[(size_t)row * PW + C_U + cc];
                    for (int j = 0; j < w; ++j) if (t - j >= 0) sum += ((float*)(A.ws + WS_PROJ))[(size_t)(row - j) * PW + C_U + cc];
                    cnt = (float)((t + 1 < w) ? t + 1 : w);
                } else { const int q = row - NPR, b = q >> 3, i = q & 7;
                    own = ((float*)(A.ws + WS_PROJ))[(size_t)row * PW + C_U + cc];
                    for (int j = 0; j < w; ++j) { const int idx = 15 + i - j;
                        sum += (idx >= 15) ? ((float*)(A.ws + WS_PROJ))[(size_t)(NPR + b * 8 + idx - 15) * PW + C_U + cc] : A.in[5][((size_t)b * 15 + idx) * 512 + cc]; }
                    cnt = (float)w;
                }
                dl[(lane + 64 * hh) * 4 + tk] = sum / cnt - own;
            }
        }
        __syncthreads();
        float acc[4][2];
#pragma unroll
        for (int tk = 0; tk < 4; ++tk) { acc[tk][0] = 0.f; acc[tk][1] = 0.f; }
#pragma unroll 4
        for (int c = 0; c < 128; ++c) {
            const f32x4 dv = *(const LAS f32x4*)(dl + c * 4);
            const float w0 = wl[c * 128 + lane], w1 = wl[c * 128 + lane + 64];
            acc[0][0] += dv.x * w0; acc[0][1] += dv.x * w1; acc[1][0] += dv.y * w0; acc[1][1] += dv.y * w1;
            acc[2][0] += dv.z * w0; acc[2][1] += dv.z * w1; acc[3][0] += dv.w * w0; acc[3][1] += dv.w * w1;
        }
        const float s0 = A.in[13][gi * 128 + lane], s1 = A.in[13][gi * 128 + lane + 64];
#pragma unroll
        for (int tk = 0; tk < 4; ++tk) { bf16* o = ((bf16*)(A.ws + WS_MIX)) + (size_t)(tok0 + tk) * DM + 512 + gi * 128;
            o[lane] = (bf16)f2bf(acc[tk][0] * s0); o[lane + 64] = (bf16)f2bf(acc[tk][1] * s1); }
    }
    __syncthreads();
}

__device__ __forceinline__ void p4_cmp_w2(const Frame& F, const Args& A) {
    LAS float* w2l = (LAS float*)F.lds;
    LAS float* hl = (LAS float*)(F.lds + 65536 + F.wave * 512);
    for (int i = F.tid; i < 2 * 128 * 64 / 4; i += NTHR) ((LAS f32x4*)w2l)[i] = ((const f32x4*)A.in[11])[i];
    __syncthreads();
    const int gw = F.bid * NWAVES + F.wave, NGW = F.G * NWAVES, lane = F.lane;
    for (int it = gw; it < 2 * CMP_R_END; it += NGW) {
        const int c = it / CMP_R_END, r = it % CMP_R_END;
        const float* hrow = ((float*)(A.ws + WS_HID)) + ((size_t)c * CMP_SEC + r) * 128;
        hl[lane] = hrow[lane]; hl[lane + 64] = hrow[lane + 64];
        LDS_WAIT(); asm volatile("" ::: "memory");
        float a = 0.f;
#pragma unroll 8
        for (int h = 0; h < 128; ++h) a += hl[h] * w2l[(c * 128 + h) * 64 + lane];
        float* dst;
        if (r < CMP_R_PROMPT) { const int b = r >> 9, n = (r & 511) >> 1, g = r & 1; dst = ((float*)(A.ws + WS_COMPS)) + ((((size_t)b * NBS + n) * 2 + g) * 2 + c) * 64; }
        else if (r < CMP_R_NEW) { const int q = r - CMP_R_PROMPT, b = q >> 7, n = (q & 127) >> 1, g = q & 1; dst = ((float*)(A.ws + WS_COMPP)) + ((((size_t)b * NBP + n) * 2 + g) * 2 + c) * 64; }
        else { const int q = r - CMP_R_NEW, b = q >> 1, g = q & 1; dst = ((float*)(A.ws + WS_COMPS)) + ((((size_t)b * NBS + 256) * 2 + g) * 2 + c) * 64; }
        dst[lane] = a;
        LDS_WAIT(); asm volatile("" ::: "memory");
    }
    __syncthreads();
}

namespace att {
typedef short bf16x8 __attribute__((ext_vector_type(8)));
typedef short s16x4 __attribute__((ext_vector_type(4)));
typedef float f32x16 __attribute__((ext_vector_type(16)));
typedef float f32x2 __attribute__((ext_vector_type(2)));
typedef __bf16 bf16x2v __attribute__((ext_vector_type(2)));
constexpr int KP = 144, VP = 192, BUFB = 64 * KP + 64 * VP;
constexpr int AT_T = 2 * BUFB, T_WAVE = 8704, AT_ML = AT_T + 8 * T_WAVE, AT_SEL = AT_ML + 2048, AT_UNI = AT_SEL + 4096, AT_TILES = AT_UNI + 64, AT_MISC = AT_TILES + 4608, AT_KAUG = AT_MISC + 64, AT_END = AT_KAUG + 2048;
static_assert(AT_END <= LDSCTL_OFF, "attention LDS map");
constexpr int NUNITS = 576;
struct TileEnt { unsigned long long base; int pitch, kpos0, kind, blk, nrows, n0; };
static_assert(sizeof(TileEnt) == 32, "TileEnt");
__device__ __forceinline__ unsigned cvtpk(float lo, float hi) { f32x2 a = {lo, hi}; return __builtin_bit_cast(unsigned, __builtin_convertvector(a, bf16x2v)); }
__device__ __forceinline__ unsigned okey(float x) { const unsigned u = __builtin_bit_cast(unsigned, x); return (u & 0x80000000u) ? ~u : (u | 0x80000000u); }
#define ATT_KR(r) (((r) & 3) + 8 * ((r) >> 2))
#define ATT_MFMA(a, b, c) __builtin_amdgcn_mfma_f32_32x32x16_bf16((a), (b), (c), 0, 0, 0)

template <int VAR>
__device__ __forceinline__ void attn_phase(const Frame& F, const Args& A, int qslot) {
#if defined(__HIP_DEVICE_COMPILE__)
    LAS unsigned char* L = F.lds;
    const int tid = F.tid, lane = F.lane, wave = F.wave;
    const int r32 = lane & 31, h = lane >> 5, tl = r32 >> 2, p = r32 & 3;
    unsigned* qctr = (unsigned*)(A.ws + WS_CTL) + CW_QUEUE + 512 * qslot;
    const int myq = (int)(xb_xcc_id() & 7u);
    const float* PROJ = (const float*)(A.ws + WS_PROJ);
    LAS TileEnt* TILES = (LAS TileEnt*)(L + AT_TILES);
    volatile LAS int* MISC = (volatile LAS int*)(L + AT_MISC);
    LAS unsigned long long* UNI = (LAS unsigned long long*)(L + AT_UNI);
    LAS unsigned long long* SEL = (LAS unsigned long long*)(L + AT_SEL);
    LAS float* ML = (LAS float*)(L + AT_ML);
    constexpr float LOG2E = 1.4426950408889634f;
    if (tid < 64) { v4u z = {0u, 0u, 0u, 0u}; v4u w0 = z; w0.x = f2bf((float)tid); *(LAS v4u*)(L + AT_KAUG + tid * 32) = w0; *(LAS v4u*)(L + AT_KAUG + tid * 32 + 16) = z; }
    for (;;) {
        __syncthreads();
        if (tid == 0) {
            int unit = NUNITS;
            for (int k = 0; k < 8; ++k) { const int qi = (myq + k) & 7;
                if (__hip_atomic_load(qctr + 64 * qi, __ATOMIC_RELAXED, __HIP_MEMORY_SCOPE_AGENT) >= 72u) continue;
                const unsigned u = __hip_atomic_fetch_add(qctr + 64 * qi, 1u, __ATOMIC_RELAXED, __HIP_MEMORY_SCOPE_AGENT);
                if (u < 72u) { unit = (u < 8u) ? (qi * 8 + (int)u) : (64 + ((int)u - 8) * 8 + qi); break; } }
            MISC[0] = unit;
            for (int c = 0; c < 8; ++c) UNI[c] = 0ull;
        }
        __syncthreads();
        const int unit = MISC[0];
        if (unit >= NUNITS) break;
        const bool is_s = unit < 64;
        int b, g, qt;
        if (is_s) { b = unit >> 1; g = unit & 1; qt = 256; } else { const int u2 = unit - 64, rem = u2 & 7; qt = 63 - (u2 >> 3); b = rem >> 1; g = rem & 1; }
        const bool active = is_s ? (wave == 0) : true;
        const int cur = qt;
        const int tokrow = is_s ? (NPR + b * 8 + tl) : (b * SEQ + qt * 64 + wave * 8 + tl);
        const int qpos = is_s ? (PAST + tl) : (qt * 64 + wave * 8 + tl);
        const int mytok = is_s ? tl : (wave * 8 + tl);
        const int ncmp = is_s ? 4 : 1;
        const int nwin = is_s ? 9 : (qt < 8 ? qt + 1 : 9);
        const int TP = is_s ? 264 : 68;
        LAS float* Tm = (LAS float*)(L + AT_T + (is_s ? 0 : wave * T_WAVE));
        if (wave == 0 && lane < ncmp + nwin) {
            TileEnt e; e.blk = 0; e.n0 = 0; e.kpos0 = 0; e.nrows = 64; e.pitch = 256;
            if (lane < ncmp) { e.kind = 0; e.n0 = 64 * lane;
                e.base = is_s ? (unsigned long long)((const float*)(A.ws + WS_COMPS) + (((size_t)b * NBS + 64 * lane) * 2 + g) * 128) : (unsigned long long)((const float*)(A.ws + WS_COMPP) + (((size_t)b * NBP) * 2 + g) * 128); }
            else { const int w = lane - ncmp; e.kind = 2;
                if (!is_s) { const int tw = qt - w; e.kpos0 = tw * 64; e.base = (unsigned long long)(PROJ + ((size_t)b * SEQ + tw * 64) * PW + C_KW + g * 128); e.pitch = PW; }
                else if (w == 0) { e.kpos0 = PAST; e.base = (unsigned long long)(PROJ + ((size_t)NPR + b * 8) * PW + C_KW + g * 128); e.pitch = PW; e.nrows = 8; }
                else { const int ti = 8 - w; e.kpos0 = PAST - 512 + ti * 64; e.base = (unsigned long long)(A.in[4] + ((size_t)b * 512 + ti * 64) * 256 + g * 128); } }
            TILES[lane] = e;
        }
        bf16x8 Q[4];
        float gate0 = 0.f, gate1 = 0.f, gate2 = 0.f;
        const float slope = exp2f(-(float)(g * 4 + p + 1));
        if (active) {
            const float* prow = PROJ + (size_t)tokrow * PW;
            const float qs = 0.125f;
#pragma unroll
            for (int ks = 0; ks < 4; ++ks) { const f32x4 a = *(const f32x4*)(prow + C_Q + g * 256 + p * 64 + 16 * ks + 8 * h), c = *(const f32x4*)(prow + C_Q + g * 256 + p * 64 + 16 * ks + 8 * h + 4);
                v4u w; w.x = cvtpk(a.x * qs, a.y * qs); w.y = cvtpk(a.z * qs, a.w * qs); w.z = cvtpk(c.x * qs, c.y * qs); w.w = cvtpk(c.z * qs, c.w * qs);
                Q[ks] = __builtin_bit_cast(bf16x8, w); }
            gate0 = 1.0f / (1.0f + __expf(-prow[C_G + 0 + g * 4 + p])); gate1 = 1.0f / (1.0f + __expf(-prow[C_G + 8 + g * 4 + p])); gate2 = 1.0f / (1.0f + __expf(-prow[C_G + 16 + g * 4 + p]));
        } else {
#pragma unroll
            for (int ks = 0; ks < 4; ++ks) Q[ks] = (bf16x8){0, 0, 0, 0, 0, 0, 0, 0};
        }
        f32x16 O0, O1;
#pragma unroll
        for (int i = 0; i < 16; ++i) { O0[i] = 0.f; O1[i] = 0.f; }
        LAS f32x4* PA = (LAS f32x4*)(L + AT_T + (is_s ? 0 : wave * T_WAVE));
        float sc_c = 0.f;
#define ATT_CLOSE(scv, FIRST) do { _Pragma("unroll") for (int q4_ = 0; q4_ < 4; ++q4_) { \
            f32x4 a_ = (f32x4){O0[4 * q4_], O0[4 * q4_ + 1], O0[4 * q4_ + 2], O0[4 * q4_ + 3]} * (scv), b_ = (f32x4){O1[4 * q4_], O1[4 * q4_ + 1], O1[4 * q4_ + 2], O1[4 * q4_ + 3]} * (scv); \
            if (!(FIRST)) { a_ += PA[q4_ * 64 + lane]; b_ += PA[(4 + q4_) * 64 + lane]; } \
            PA[q4_ * 64 + lane] = a_; PA[(4 + q4_) * 64 + lane] = b_; } \
            _Pragma("unroll") for (int r_ = 0; r_ < 16; ++r_) { O0[r_] = 0.f; O1[r_] = 0.f; } } while (0)
        float m_run = -1e20f, l_run = 0.f;
        int curkind = 0;
        int ntiles = ncmp + nwin;
        f32x4 R0 = {0.f, 0.f, 0.f, 0.f}, R1 = R0, R2 = R0, R3 = R0;
#define ATT_LOAD(idx) do { if ((VAR == 2 || VAR == 3) && (idx) >= ncmp) break; const TileEnt e_ = TILES[(idx)]; const GAS float* bp_ = (const GAS float*)e_.base; const int nr_ = e_.nrows - 1; \
            { const int f_ = tid;        int row_ = f_ >> 5; row_ = row_ < nr_ ? row_ : nr_; R0 = *(const GAS f32x4*)(bp_ + (size_t)row_ * e_.pitch + (f_ & 31) * 4); } \
            { const int f_ = tid + 512;  int row_ = f_ >> 5; row_ = row_ < nr_ ? row_ : nr_; R1 = *(const GAS f32x4*)(bp_ + (size_t)row_ * e_.pitch + (f_ & 31) * 4); } \
            { const int f_ = tid + 1024; int row_ = f_ >> 5; row_ = row_ < nr_ ? row_ : nr_; R2 = *(const GAS f32x4*)(bp_ + (size_t)row_ * e_.pitch + (f_ & 31) * 4); } \
            { const int f_ = tid + 1536; int row_ = f_ >> 5; row_ = row_ < nr_ ? row_ : nr_; R3 = *(const GAS f32x4*)(bp_ + (size_t)row_ * e_.pitch + (f_ & 31) * 4); } } while (0)
#define ATT_ST1(buf, f_, Rv) do { const int row_ = (f_) >> 5, c4_ = (f_) & 31; v2u o_; o_.x = cvtpk(Rv.x, Rv.y); o_.y = cvtpk(Rv.z, Rv.w); \
            const int off_ = (buf) * BUFB + (c4_ < 16 ? row_ * KP + c4_ * 8 : 64 * KP + row_ * VP + (c4_ - 16) * 8); *(LAS v2u*)(L + off_) = o_; } while (0)
#define ATT_STORE(buf) do { ATT_ST1(buf, tid, R0); ATT_ST1(buf, tid + 512, R1); ATT_ST1(buf, tid + 1024, R2); ATT_ST1(buf, tid + 1536, R3); } while (0)
        __syncthreads();
        ATT_LOAD(0); ATT_STORE(0);
        __syncthreads();
        for (int i = 0; i < ntiles; ++i) {
            const int buf = i & 1;
            const bool has_next = (i + 1 < ntiles);
            if (has_next) ATT_LOAD(i + 1);
            if (active && ((VAR != 1 && VAR != 3) || i < ncmp)) {
                const TileEnt e = TILES[i];
                const int kind = __builtin_amdgcn_readfirstlane(e.kind), kpos0 = __builtin_amdgcn_readfirstlane(e.kpos0), blk = __builtin_amdgcn_readfirstlane(e.blk), n0 = __builtin_amdgcn_readfirstlane(e.n0);
                if (kind != curkind) {
                    if (curkind != 0) { const float sc = gate2 / fmaxf(l_run, 1e-30f); ATT_CLOSE(sc, false); m_run = -1e20f; l_run = 0.f; }
                    curkind = kind;
                }
                int dq_hi, dq_lo = -1; float rowc;
                if (kind == 0) { dq_hi = (qpos - 63 - 64 * n0) >> 6; rowc = slope * (float)(64 * n0 + 63 - qpos); }
                else if (kind == 1) { const unsigned long long w = SEL[mytok * 8 + (blk >> 6)]; const bool sb = (w >> (blk & 63)) & 1ull; dq_hi = sb ? (qpos - kpos0) : -1; rowc = slope * (float)(kpos0 - qpos); }
                else { dq_hi = qpos - kpos0; dq_lo = qpos - 512 - kpos0; rowc = slope * (float)(kpos0 - qpos); }
                const bool lane_any = (dq_hi >= 0) && (dq_lo < 63);
                if (kind == 0 || __any(lane_any)) {
                    const LAS unsigned char* Kb = L + buf * BUFB; const LAS unsigned char* Vb = Kb + 64 * KP;
                    f32x16 X0, X1;
#pragma unroll
                    for (int r = 0; r < 16; ++r) { X0[r] = 0.f; X1[r] = 0.f; }
#pragma unroll
                    for (int ks = 0; ks < 4; ++ks) {
                        const bf16x8 a0 = *(const LAS bf16x8*)(Kb + r32 * KP + (16 * ks + 8 * h) * 2);
                        const bf16x8 a1 = *(const LAS bf16x8*)(Kb + (32 + r32) * KP + (16 * ks + 8 * h) * 2);
                        X0 = ATT_MFMA(a0, Q[ks], X0); X1 = ATT_MFMA(a1, Q[ks], X1);
                    }
                    { v4u qa = {0u, 0u, 0u, 0u}; if (h == 0) qa.x = f2bf(kind == 0 ? slope * 64.f : slope);
                      const bf16x8 Qaug = __builtin_bit_cast(bf16x8, qa);
                      const bf16x8 ka0 = *(const LAS bf16x8*)(L + AT_KAUG + r32 * 32 + 16 * h), ka1 = *(const LAS bf16x8*)(L + AT_KAUG + (32 + r32) * 32 + 16 * h);
                      X0 = ATT_MFMA(ka0, Qaug, X0); X1 = ATT_MFMA(ka1, Qaug, X1); }
                    const float c0 = lane_any ? rowc * LOG2E : -1e30f;
#pragma unroll
                    for (int r = 0; r < 16; ++r) { X0[r] = fmaf(X0[r], LOG2E, c0); X1[r] = fmaf(X1[r], LOG2E, c0); }
                    const bool lane_edge = lane_any && !((dq_hi >= 63) && (dq_lo < 0));
                    if (__any(lane_edge)) {
                        const int hi2 = dq_hi - 4 * h, lo2 = dq_lo - 4 * h;
#pragma unroll
                        for (int r = 0; r < 16; ++r) { const int k0 = ATT_KR(r), k1 = 32 + ATT_KR(r);
                            X0[r] = (k0 <= hi2 && k0 > lo2) ? X0[r] : -1e30f; X1[r] = (k1 <= hi2 && k1 > lo2) ? X1[r] : -1e30f; }
                    }
                    if (kind == 0) {
#pragma unroll
                        for (int q4 = 0; q4 < 4; ++q4) {
                            *(LAS f32x4*)(Tm + r32 * TP + n0 + 8 * q4 + 4 * h) = (f32x4){X0[4 * q4], X0[4 * q4 + 1], X0[4 * q4 + 2], X0[4 * q4 + 3]};
                            *(LAS f32x4*)(Tm + r32 * TP + n0 + 32 + 8 * q4 + 4 * h) = (f32x4){X1[4 * q4], X1[4 * q4 + 1], X1[4 * q4 + 2], X1[4 * q4 + 3]}; }
                    }
                    float mx = -1e30f;
#pragma unroll
                    for (int r = 0; r < 16; r += 2) mx = fmaxf(fmaxf(mx, fmaxf(X0[r], X0[r + 1])), fmaxf(X1[r], X1[r + 1]));
                    mx = fmaxf(mx, __shfl_xor(mx, 32));
                    const float m_new = fmaxf(m_run, mx);
                    if (__any(m_new > m_run)) {
                        const float alpha = __builtin_amdgcn_exp2f(m_run - m_new);
#pragma unroll
                        for (int r = 0; r < 16; ++r) { O0[r] *= alpha; O1[r] *= alpha; }
                        l_run *= alpha; m_run = m_new;
                    }
                    float ls = 0.f;
#pragma unroll
                    for (int r = 0; r < 16; ++r) { X0[r] = __builtin_amdgcn_exp2f(X0[r] - m_run); X1[r] = __builtin_amdgcn_exp2f(X1[r] - m_run); ls += X0[r] + X1[r]; }
                    ls += __shfl_xor(ls, 32);
                    l_run += ls;
#pragma unroll
                    for (int kt = 0; kt < 2; ++kt) {
#pragma unroll
                        for (int s = 0; s < 2; ++s) {
                            v4u pw;
                            if (kt == 0) { pw.x = cvtpk(X0[8 * s], X0[8 * s + 1]); pw.y = cvtpk(X0[8 * s + 2], X0[8 * s + 3]); pw.z = cvtpk(X0[8 * s + 4], X0[8 * s + 5]); pw.w = cvtpk(X0[8 * s + 6], X0[8 * s + 7]); }
                            else         { pw.x = cvtpk(X1[8 * s], X1[8 * s + 1]); pw.y = cvtpk(X1[8 * s + 2], X1[8 * s + 3]); pw.z = cvtpk(X1[8 * s + 4], X1[8 * s + 5]); pw.w = cvtpk(X1[8 * s + 6], X1[8 * s + 7]); }
                            const bf16x8 pf = __builtin_bit_cast(bf16x8, pw);
                            const int key0 = kt * 32 + 16 * s + 4 * h, i16 = lane & 15, q = i16 >> 2, pp = i16 & 3, blk16 = (lane >> 4) & 1;
#pragma unroll
                            for (int dt = 0; dt < 2; ++dt) {
                                const LAS unsigned char* va = Vb + (key0 + q) * VP + (dt * 32 + 16 * blk16 + 4 * pp) * 2;
                                const s16x4 lo = __builtin_amdgcn_ds_read_tr16_b64_v4i16((LAS s16x4*)va);
                                const s16x4 hi = __builtin_amdgcn_ds_read_tr16_b64_v4i16((LAS s16x4*)(va + 8 * VP));
                                const bf16x8 vf = __builtin_shufflevector(lo, hi, 0, 1, 2, 3, 4, 5, 6, 7);
                                if (dt == 0) O0 = ATT_MFMA(vf, pf, O0); else O1 = ATT_MFMA(vf, pf, O1);
                            }
                        }
                    }
                }
                if (i + 1 == ncmp) {
                    const float il = 1.0f / fmaxf(l_run, 1e-30f); sc_c = gate0 * il;
                    if (h == 0) { ML[(wave * 32 + r32) * 2] = m_run; ML[(wave * 32 + r32) * 2 + 1] = il; }
                    m_run = -1e20f; l_run = 0.f;
                }
            }
            if (has_next) ATT_STORE(buf ^ 1);
            __syncthreads();
            if (i + 1 == ncmp) {
                if (!is_s) {
                    const LAS float* Tw = (const LAS float*)(L + AT_T + wave * T_WAVE);
                    for (int k = 0; k < 8; ++k) { const int tok = wave * 8 + k, n = lane; float imp = 0.f;
#pragma unroll
                        for (int pq = 0; pq < 4; ++pq) { const int row = k * 4 + pq; imp += __builtin_amdgcn_exp2f(Tw[row * 68 + n] - ML[(wave * 32 + row) * 2]) * ML[(wave * 32 + row) * 2 + 1]; }
                        float s = imp; if (n == 0 || n == cur || n == cur - 1) s = 5.0f; if (n > cur) s = -1.0f;
                        const unsigned key = okey(s); unsigned pre = 0u;
                        for (int bt = 31; bt >= 0; --bt) { const unsigned T = pre | (1u << bt); if (__popcll(__ballot(key >= T)) >= 16) pre = T; }
                        const unsigned long long gt = __ballot(key > pre), eq = __ballot(key == pre); const int need = 16 - __popcll(gt);
                        const bool pick = (key > pre) || (key == pre && __popcll(eq & ((1ull << lane) - 1ull)) < need);
                        const unsigned long long bal = __ballot(pick && n <= cur);
                        if (lane == 0) { SEL[tok * 8] = bal; __hip_atomic_fetch_or(&UNI[0], bal, __ATOMIC_RELAXED, __HIP_MEMORY_SCOPE_WORKGROUP); } }
                } else {
                    const LAS float* Tw = (const LAS float*)(L + AT_T);
                    const int tok = wave; unsigned key[5];
#pragma unroll
                    for (int c = 0; c < 5; ++c) { const int n = lane + 64 * c; float s = -2.0f;
                        if (n < 256) { float imp = 0.f;
#pragma unroll
                            for (int pq = 0; pq < 4; ++pq) { const int row = tok * 4 + pq; imp += __builtin_amdgcn_exp2f(Tw[row * 264 + n] - ML[row * 2]) * ML[row * 2 + 1]; }
                            s = imp; if (n == 0 || n == 255) s = 5.0f; }
                        else if (n == 256) s = 5.0f;
                        key[c] = okey(s); }
                    unsigned pre = 0u;
                    for (int bt = 31; bt >= 0; --bt) { const unsigned T = pre | (1u << bt); int cnt = 0;
#pragma unroll
                        for (int c = 0; c < 5; ++c) cnt += __popcll(__ballot(key[c] >= T));
                        if (cnt >= 16) pre = T; }
                    int ngt = 0;
#pragma unroll
                    for (int c = 0; c < 5; ++c) ngt += __popcll(__ballot(key[c] > pre));
                    int need = 16 - ngt;
#pragma unroll
                    for (int c = 0; c < 5; ++c) { const int n = lane + 64 * c; const unsigned long long eq = __ballot(key[c] == pre);
                        const bool pick = (key[c] > pre) || (key[c] == pre && __popcll(eq & ((1ull << lane) - 1ull)) < need);
                        need -= __popcll(eq);
                        const unsigned long long bal = __ballot(pick && n <= 256);
                        if (lane == 0) { SEL[tok * 8 + c] = bal; __hip_atomic_fetch_or(&UNI[c], bal, __ATOMIC_RELAXED, __HIP_MEMORY_SCOPE_WORKGROUP); } }
                }
                __syncthreads();
                if (active) ATT_CLOSE(sc_c, true);
                if (wave == 0) {
                    int base = ncmp + nwin;
                    for (int c = 4; c >= 0; --c) { const unsigned long long w = UNI[c];
                        if ((w >> lane) & 1ull) { const int j = c * 64 + lane; const int idx = base + (lane == 63 ? 0 : __popcll(w >> (lane + 1)));
                            TileEnt e; e.kind = 1; e.blk = j; e.kpos0 = j * 64; e.n0 = 0; e.nrows = 64; e.pitch = 256;
                            if (!is_s) { e.base = (unsigned long long)(PROJ + ((size_t)b * SEQ + j * 64) * PW + C_KS + g * 128); e.pitch = PW; }
                            else if (j < 256) { const int page = ((const int*)A.in[6])[b * NPG + (j >> 1)]; e.base = (unsigned long long)(A.in[3] + ((size_t)page * 128 + (j & 1) * 64) * 256 + g * 128); }
                            else { e.base = (unsigned long long)(PROJ + ((size_t)NPR + b * 8) * PW + C_KS + g * 128); e.pitch = PW; e.nrows = 8; }
                            TILES[idx] = e; }
                        base += __popcll(w); }
                    if (lane == 0) MISC[1] = base;
                }
                __syncthreads();
                ntiles = MISC[1];
            }
        }
        if (active) {
            const float sc = (curkind == 1 ? gate1 : gate2) / fmaxf(l_run, 1e-30f);
            bf16* orow = (bf16*)(A.ws + (VAR == 0 ? WS_MIX : WS_ACMP)) + (size_t)tokrow * DM + g * 256 + p * 64;
#pragma unroll
            for (int q4 = 0; q4 < 4; ++q4) {
                const f32x4 a = PA[q4 * 64 + lane] + (f32x4){O0[4 * q4], O0[4 * q4 + 1], O0[4 * q4 + 2], O0[4 * q4 + 3]} * sc, c = PA[(4 + q4) * 64 + lane] + (f32x4){O1[4 * q4], O1[4 * q4 + 1], O1[4 * q4 + 2], O1[4 * q4 + 3]} * sc;
                v2u o; o.x = cvtpk(a.x, a.y); o.y = cvtpk(a.z, a.w); *(v2u*)(orow + 8 * q4 + 4 * h) = o;
                v2u o2; o2.x = cvtpk(c.x, c.y); o2.y = cvtpk(c.z, c.w); *(v2u*)(orow + 32 + 8 * q4 + 4 * h) = o2; }
        }
    }
#undef ATT_CLOSE
#undef ATT_LOAD
#undef ATT_ST1
#undef ATT_STORE
#endif
}
#undef ATT_KR
#undef ATT_MFMA
}

namespace cmpk {
typedef short bf16x8 __attribute__((ext_vector_type(8)));
typedef float f32x16 __attribute__((ext_vector_type(16)));
constexpr int AP = 144, A_BYTES = 128 * AP, B_BYTES = 256 * AP, STG = A_BYTES + B_BYTES;
static_assert(2 * STG <= LDSCTL_OFF && 131072 <= LDSCTL_OFF, "compress LDS map");
constexpr int NUNITS_PAST = 256, NUNITS_ALL = 265;
__device__ __forceinline__ void cmp_unit(const Frame& F, const Args& A, int unit) {
#if defined(__HIP_DEVICE_COMPILE__)
    LAS unsigned char* L = F.lds;
    const int tid = F.tid, lane = F.lane, wave = F.wave, r32 = lane & 31, h = lane >> 5;
    const float* PROJ = (const float*)(A.ws + WS_PROJ);
    const int* pt = (const int*)A.in[6];
    const float* bp0; const float* bp1; const float* bp2; const float* bp3; int pitch, nvalid;
    {
        const float* bpp[4];
#pragma unroll
        for (int i = 0; i < 4; ++i) { const int blk = wave + 8 * i;
            if (unit < 256) { const int b = unit >> 3, n = (unit & 7) * 32 + blk; const int page = pt[b * NPG + (n >> 1)]; bpp[i] = A.in[2] + ((size_t)page * 128 + (n & 1) * 64) * 256; }
            else if (unit < 264) { const int pu = unit - 256, b = pu >> 1, n = (pu & 1) * 32 + blk; bpp[i] = PROJ + ((size_t)b * SEQ + n * 64) * PW + C_KC; }
            else bpp[i] = PROJ + ((size_t)NPR + blk * 8) * PW + C_KC; }
        bp0 = bpp[0]; bp1 = bpp[1]; bp2 = bpp[2]; bp3 = bpp[3];
        pitch = unit < 256 ? 256 : PW; nvalid = unit < 264 ? 64 : 8;
    }
    const int gc = lane >> 4, g = gc >> 1, c = gc & 1, d0 = (lane & 15) * 4;
    const float* pep = A.in[9] + c * 64 + d0;
    const int a_off = (c * 64 + wave * 2 + g) * AP + d0 * 2;
    const bf16* bsrc = (const bf16*)(A.ws + WS_W1S) + (size_t)(tid >> 3) * 4096 + (tid & 7) * 8;
    const int b_off = A_BYTES + (tid >> 3) * AP + (tid & 7) * 16;
    const int cw = wave >> 2, rh = (wave >> 1) & 1, ch = wave & 1;
    const int fa_off = (cw * 64 + rh * 32 + r32) * AP + 16 * h, fb_off = A_BYTES + (cw * 128 + ch * 64 + r32) * AP + 16 * h;
    f32x16 acc0, acc1;
#pragma unroll
    for (int r = 0; r < 16; ++r) { acc0[r] = 0.f; acc1[r] = 0.f; }
    f32x4 RA0[4], RA1[4], RP0, RP1; v4u RB[4];
    const f32x4 z4 = {0.f, 0.f, 0.f, 0.f};
#define CK_LA(l, RA, RP) do { const size_t ro_ = (size_t)(l) * pitch + lane * 4; const bool ok_ = (l) < nvalid; \
        RA[0] = ok_ ? *(const f32x4*)(bp0 + ro_) : z4; RA[1] = ok_ ? *(const f32x4*)(bp1 + ro_) : z4; RA[2] = ok_ ? *(const f32x4*)(bp2 + ro_) : z4; RA[3] = ok_ ? *(const f32x4*)(bp3 + ro_) : z4; \
        RP = *(const f32x4*)(pep + (l) * 128); } while (0)
#define CK_LB(l) do { _Pragma("unroll") for (int i_ = 0; i_ < 4; ++i_) RB[i_] = *(const v4u*)(bsrc + (size_t)i_ * 64 * 4096 + (l) * 64); } while (0)
#define CK_SA(buf, RA, RP) do { _Pragma("unroll") for (int i_ = 0; i_ < 4; ++i_) { const f32x4 v_ = RA[i_] + RP; v2u o_; o_.x = att::cvtpk(v_.x, v_.y); o_.y = att::cvtpk(v_.z, v_.w); \
        *(LAS v2u*)(L + (buf) * STG + a_off + i_ * 16 * AP) = o_; } } while (0)
#define CK_SB(buf) do { _Pragma("unroll") for (int i_ = 0; i_ < 4; ++i_) *(LAS v4u*)(L + (buf) * STG + b_off + i_ * 64 * AP) = RB[i_]; } while (0)
#define CK_MMA(buf) do { _Pragma("unroll") for (int ks_ = 0; ks_ < 4; ++ks_) { \
        const bf16x8 a_ = *(const LAS bf16x8*)(L + (buf) * STG + fa_off + 32 * ks_); \
        const bf16x8 b0_ = *(const LAS bf16x8*)(L + (buf) * STG + fb_off + 32 * ks_); const bf16x8 b1_ = *(const LAS bf16x8*)(L + (buf) * STG + fb_off + 32 * AP + 32 * ks_); \
        acc0 = __builtin_amdgcn_mfma_f32_32x32x16_bf16(a_, b0_, acc0, 0, 0, 0); acc1 = __builtin_amdgcn_mfma_f32_32x32x16_bf16(a_, b1_, acc1, 0, 0, 0); } } while (0)
    __syncthreads();
    CK_LA(0, RA0, RP0); CK_LA(1, RA1, RP1); CK_LB(0);
    CK_SA(0, RA0, RP0); CK_SB(0); CK_LA(2, RA0, RP0); CK_LB(1);
    __syncthreads();
    for (int l = 0; l < 64; l += 2) {
        CK_MMA(0);
        CK_SA(1, RA1, RP1); CK_SB(1);
        if (l + 3 < 64) CK_LA(l + 3, RA1, RP1);
        if (l + 2 < 64) CK_LB(l + 2);
        __syncthreads();
        CK_MMA(1);
        if (l + 2 < 64) { CK_SA(0, RA0, RP0); CK_SB(0); }
        if (l + 4 < 64) CK_LA(l + 4, RA0, RP0);
        if (l + 3 < 64) CK_LB(l + 3);
        __syncthreads();
    }
#undef CK_LA
#undef CK_LB
#undef CK_SA
#undef CK_SB
#undef CK_MMA
    LAS float* HL = (LAS float*)L; LAS float* W2L = (LAS float*)(L + 65536);
#pragma unroll
    for (int r = 0; r < 16; ++r) { const int row = rh * 32 + (r & 3) + 8 * (r >> 2) + 4 * h;
        HL[(cw * 64 + row) * 128 + ch * 64 + r32] = pg8::gelu_tanh(acc0[r]); HL[(cw * 64 + row) * 128 + ch * 64 + 32 + r32] = pg8::gelu_tanh(acc1[r]); }
    for (int i = tid; i < 2 * 128 * 64 / 4; i += NTHR) ((LAS f32x4*)W2L)[i] = ((const f32x4*)A.in[11])[i];
    __syncthreads();
    {
        const int c2 = wave >> 2, row0 = (wave & 3) * 16;
        float o[16];
#pragma unroll
        for (int rr = 0; rr < 16; ++rr) o[rr] = 0.f;
        for (int h4 = 0; h4 < 32; ++h4) {
            const float w0 = W2L[(c2 * 128 + 4 * h4) * 64 + lane], w1 = W2L[(c2 * 128 + 4 * h4 + 1) * 64 + lane], w2 = W2L[(c2 * 128 + 4 * h4 + 2) * 64 + lane], w3 = W2L[(c2 * 128 + 4 * h4 + 3) * 64 + lane];
#pragma unroll
            for (int rr = 0; rr < 16; ++rr) { const f32x4 hv = *(const LAS f32x4*)(HL + (c2 * 64 + row0 + rr) * 128 + 4 * h4); o[rr] += (hv.x * w0 + hv.y * w1) + (hv.z * w2 + hv.w * w3); }
        }
#pragma unroll
        for (int rr = 0; rr < 16; ++rr) { const int row = row0 + rr, blk = row >> 1, gg = row & 1; float* dst;
            if (unit < 256) { const int b = unit >> 3, n = (unit & 7) * 32 + blk; dst = (float*)(A.ws + WS_COMPS) + ((((size_t)b * NBS + n) * 2 + gg) * 2 + c2) * 64; }
            else if (unit < 264) { const int pu = unit - 256, b = pu >> 1, n = (pu & 1) * 32 + blk; dst = (float*)(A.ws + WS_COMPP) + ((((size_t)b * NBP + n) * 2 + gg) * 2 + c2) * 64; }
            else dst = (float*)(A.ws + WS_COMPS) + ((((size_t)blk * NBS + 256) * 2 + gg) * 2 + c2) * 64;
            dst[lane] = o[rr]; }
    }
    __syncthreads();
#endif
}
}

namespace poolk {
typedef short bf16x8 __attribute__((ext_vector_type(8)));
typedef float f32x16 __attribute__((ext_vector_type(16)));
typedef float f32x2 __attribute__((ext_vector_type(2)));
constexpr int DP = 272;
constexpr int WAVE_LDS = 32 * DP;
constexpr int NITEMS = 4 * 512 + 4 * 32;
template <int W>
__device__ __forceinline__ void pool_d(const f32x2 (&C)[48], int ntok, int pos0, bool is_s, LAS unsigned char* dl, int lane) {
#pragma unroll
    for (int tk = 0; tk < 32; ++tk) {
        f32x2 d = {0.f, 0.f};
        if (tk < ntok) {
            const float cnt = is_s ? (float)W : (float)((pos0 + tk + 1 < W) ? pos0 + tk + 1 : W);
            const f32x2 win = C[16 + tk] - C[16 + tk - W], own = C[16 + tk] - C[15 + tk];
            d = win / cnt - own;
        }
        *(LAS unsigned*)(dl + tk * DP + lane * 4) = att::cvtpk(d.x, d.y);
    }
}
__device__ __forceinline__ void pool_phase(const Frame& F, const Args& A) {
#if defined(__HIP_DEVICE_COMPILE__)
    const int lane = F.lane, wave = F.wave, r32 = lane & 31, h = lane >> 5;
    LAS unsigned char* dl = F.lds + wave * WAVE_LDS;
    const float* PROJ = (const float*)(A.ws + WS_PROJ);
    const int gw = F.bid * NWAVES + wave, NGW = F.G * NWAVES;
    for (int it = gw; it < NITEMS; it += NGW) {
        int gi, row0, ntok, pos0; bool is_s; int sb = 0;
        if (it < 2048) { gi = it >> 9; const int ch = it & 511; row0 = ch * 32; ntok = 32; pos0 = row0 & (SEQ - 1); is_s = false; }
        else { const int q = it - 2048; gi = q >> 5; sb = q & 31; row0 = NPR + sb * 8; ntok = 8; pos0 = PAST; is_s = true; }
        f32x2 C[48];
        {
            f32x2 R[47];
            const int coff = C_U + gi * 128 + lane * 2;
#pragma unroll
            for (int i = 0; i < 47; ++i) {
                f32x2 v = {0.f, 0.f};
                if (!is_s) { const int t = pos0 - 15 + i; if (t >= 0) v = *(const f32x2*)(PROJ + (size_t)(row0 - 15 + i) * PW + coff); }
                else if (i < 15) v = *(const f32x2*)(A.in[5] + ((size_t)sb * 15 + i) * 512 + gi * 128 + lane * 2);
                else if (i < 23) v = *(const f32x2*)(PROJ + (size_t)(row0 + i - 15) * PW + coff);
                R[i] = v;
            }
            C[0] = (f32x2){0.f, 0.f};
#pragma unroll
            for (int i = 0; i < 47; ++i) C[i + 1] = C[i] + R[i];
        }
        switch (gi) { case 0: pool_d<2>(C, ntok, pos0, is_s, dl, lane); break; case 1: pool_d<4>(C, ntok, pos0, is_s, dl, lane); break;
                      case 2: pool_d<8>(C, ntok, pos0, is_s, dl, lane); break; default: pool_d<16>(C, ntok, pos0, is_s, dl, lane); break; }
        LDS_WAIT(); asm volatile("" ::: "memory");
        f32x16 acc[4];
#pragma unroll
        for (int t = 0; t < 4; ++t)
#pragma unroll
            for (int r = 0; r < 16; ++r) acc[t][r] = 0.f;
        const bf16* wp = (const bf16*)(A.ws + WS_WPOOL) + (size_t)gi * 16384;
#pragma unroll
        for (int ks = 0; ks < 8; ++ks) {
            const bf16x8 bfr = *(const LAS bf16x8*)(dl + r32 * DP + (16 * ks + 8 * h) * 2);
#pragma unroll
            for (int t = 0; t < 4; ++t) { const bf16x8 afr = *(const bf16x8*)(wp + (size_t)(t * 32 + r32) * 128 + 16 * ks + 8 * h);
                acc[t] = __builtin_amdgcn_mfma_f32_32x32x16_bf16(afr, bfr, acc[t], 0, 0, 0); }
        }
        if (r32 < ntok) {
            bf16* orow = (bf16*)(A.ws + WS_MIX) + (size_t)(row0 + r32) * DM + 512 + gi * 128;
            const float* ps = A.in[13] + gi * 128;
#pragma unroll
            for (int t = 0; t < 4; ++t)
#pragma unroll
                for (int q4 = 0; q4 < 4; ++q4) { const int dd = t * 32 + 8 * q4 + 4 * h; const f32x4 sc = *(const f32x4*)(ps + dd);
                    v2u o; o.x = att::cvtpk(acc[t][4 * q4] * sc.x, acc[t][4 * q4 + 1] * sc.y); o.y = att::cvtpk(acc[t][4 * q4 + 2] * sc.z, acc[t][4 * q4 + 3] * sc.w);
                    *(v2u*)(orow + dd) = o; }
        }
        LDS_WAIT(); asm volatile("" ::: "memory");
    }
#endif
}
}

namespace sg {
typedef short bf16x8 __attribute__((ext_vector_type(8)));
typedef float f32x16 __attribute__((ext_vector_type(16)));
struct EpiF32 { float* C; int ldc; __device__ __forceinline__ void operator()(int row, int col, float v) const { C[(size_t)row * ldc + col] = v; } };
struct EpiRes { const float* base; float* out; int ldc; __device__ __forceinline__ void operator()(int row, int col, float v) const { out[(size_t)row * ldc + col] = base[(size_t)row * ldc + col] + v; } };
struct EpiRelu2 { bf16* O; int ldc; __device__ __forceinline__ void operator()(int row, int col, float v) const { const float a = fmaxf(v, 0.f); O[(size_t)row * ldc + col] = (bf16)f2bf(a * a); } };
template <class Epi>
__device__ __forceinline__ void sgemm(const Frame& F, const bf16* Arows, const bf16* Bt, int K, int N, const Epi& E) {
#if defined(__HIP_DEVICE_COMPILE__)
    const int lane = F.lane, wave = F.wave, r32 = lane & 31, h = lane >> 5, split = wave & 3, tsel = wave >> 2;
    LAS float* red = (LAS float*)F.lds;
    const int nitems = 8 * (N / 32) / 2, kq = K / 4, nk = kq / 16;
    for (int it = F.bid; it < nitems; it += F.G) {
        const int tile = it * 2 + tsel, tm = tile & 7, tn = tile >> 3;
        const bf16* ap = Arows + (size_t)(tm * 32 + r32) * K + split * kq + 8 * h;
        const bf16* bp = Bt + (size_t)(tn * 32 + r32) * K + split * kq + 8 * h;
        f32x16 acc;
#pragma unroll
        for (int r = 0; r < 16; ++r) acc[r] = 0.f;
#pragma unroll 8
        for (int ks = 0; ks < nk; ++ks) { const bf16x8 a = *(const bf16x8*)(ap + 16 * ks); const bf16x8 b = *(const bf16x8*)(bp + 16 * ks); acc = __builtin_amdgcn_mfma_f32_32x32x16_bf16(a, b, acc, 0, 0, 0); }
        __syncthreads();
        if (split != 0) {
#pragma unroll
            for (int r = 0; r < 16; ++r) red[wave * 1024 + r * 64 + lane] = acc[r]; }
        __syncthreads();
        if (split == 0) {
#pragma unroll
            for (int s = 1; s < 4; ++s)
#pragma unroll
                for (int r = 0; r < 16; ++r) acc[r] += red[(wave + s) * 1024 + r * 64 + lane];
#pragma unroll
            for (int r = 0; r < 16; ++r) E(tm * 32 + (r & 3) + 8 * (r >> 2) + 4 * h, tn * 32 + r32, acc[r]);
        }
    }
    __syncthreads();
#endif
}
}


__device__ __forceinline__ void p7_hb(const Frame& F, const Args& A) {
    const int gw = F.bid * NWAVES + F.wave, NGW = F.G * NWAVES;
    for (int m = gw; m < MTOK; m += NGW) rms_row_to_bf16(((float*)(A.ws + WS_H)) + (size_t)m * DM, A.in[15], ((bf16*)(A.ws + WS_HB)) + (size_t)m * DM, F.lane);
}
__device__ __forceinline__ void p10_final(const Frame& F, const Args& A) {
    const int gw = F.bid * NWAVES + F.wave, NGW = F.G * NWAVES, lane = F.lane;
    for (int m = gw; m < MTOK; m += NGW) {
        f32x4* xr = (f32x4*)(A.out + (size_t)m * DM) + lane; const f32x4* gr = (const f32x4*)A.in[18] + lane;
        f32x4 v[4]; float s = 0.f;
#pragma unroll
        for (int j = 0; j < 4; ++j) { v[j] = xr[64 * j]; s += (v[j].x * v[j].x + v[j].y * v[j].y) + (v[j].z * v[j].z + v[j].w * v[j].w); }
        const float rstd = 1.0f / sqrtf(wave_sum(s) * (1.f / DM) + 1e-6f);
#pragma unroll
        for (int j = 0; j < 4; ++j) xr[64 * j] = v[j] * rstd * gr[64 * j];
    }
}

__global__ void __launch_bounds__(NTHR, 2) fwd_kernel(Args A) {
    extern __shared__ __attribute__((aligned(16))) unsigned char lds_raw[];
    Frame F;
    F.lds = (LAS unsigned char*)lds_raw;
    F.tid = threadIdx.x; F.lane = F.tid & 63; F.wave = __builtin_amdgcn_readfirstlane(F.tid >> 6); F.G = gridDim.x; F.bid = blockIdx.x;
    unsigned char* ws = A.ws;
    for (int u = F.tid; u < (LDS_BYTES - LDSCTL_OFF) / 4; u += NTHR) ((LAS unsigned*)(F.lds + LDSCTL_OFF))[u] = 0u;
    __syncthreads();
    const int lo = A.ph_lo, hi = A.ph_hi;
    const bool multi = (hi - lo) > 1;
    XcdBarrier bar; bar.bar = (unsigned*)(ws + WS_CTL) + CW_BAR; bar.x = 0; bar.st = nullptr;
    if (multi) bar = xcd_barrier_post((unsigned*)(ws + WS_CTL) + CW_BAR, (volatile LAS unsigned*)(F.lds + MISC_OFF));
#define IN(k) (lo <= (k) && (k) < hi)
#define SEAM(k) do { if (IN(k) && IN((k) + 1)) xcd_barrier(bar); } while (0)

#ifndef REP_PHASE
#define REP_PHASE -1
#endif
#define RUN(k, ...) if (IN(k)) { __VA_ARGS__; if (REP_PHASE == (k)) { xcd_barrier(bar); __VA_ARGS__; } } SEAM(k)
#define GEMM_BODY(EPI, Aptr, Bptr, M_, N_, K_, ...) do { pg8::Gemm g{Aptr, Bptr, M_, N_, K_}; pg8::StaticOrder S; S.init(M_, N_, F.G, F.bid); pg8::EPI E{__VA_ARGS__}; pg8::gemm_phase<pg8::EPI, pg8::StaticOrder>(F.lds, g, S, E, nullptr); } while (0)
    RUN(0, p0_prologue(F, A));
    RUN(1, do { for (int rp = 0; rp < (REP_PHASE == 10 ? 2 : 1); ++rp) for (int u = F.bid; u < cmpk::NUNITS_PAST; u += F.G) cmpk::cmp_unit(F, A, u);
                sg::sgemm(F, ((const bf16*)(A.ws + WS_XN)) + (size_t)NPR * DM, ((const bf16*)(A.ws + WS_WIN)), DM, PW, sg::EpiF32{((float*)(A.ws + WS_PROJ)) + (size_t)NPR * PW, PW});
                GEMM_BODY(EpiF32, ((bf16*)(A.ws + WS_XN)), ((bf16*)(A.ws + WS_WIN)), NPR, PW, DM, ((float*)(A.ws + WS_PROJ)), PW); } while (0));
    RUN(2, do { for (int rp = 0; rp < (REP_PHASE == 20 ? 2 : 1); ++rp) for (int u = cmpk::NUNITS_PAST + F.bid; u < cmpk::NUNITS_ALL; u += F.G) cmpk::cmp_unit(F, A, u);
                p2_copies(F, A); if (REP_PHASE == 21) p2_copies(F, A); poolk::pool_phase(F, A); if (REP_PHASE == 22) poolk::pool_phase(F, A); } while (0));
    if (IN(3)) { att::attn_phase<0>(F, A, 0); if (REP_PHASE == 3) { xcd_barrier(bar); att::attn_phase<0>(F, A, 1); } if (REP_PHASE == 31) { xcd_barrier(bar); att::attn_phase<1>(F, A, 1); } if (REP_PHASE == 32) { xcd_barrier(bar); att::attn_phase<2>(F, A, 1); } if (REP_PHASE == 33) { xcd_barrier(bar); att::attn_phase<3>(F, A, 1); } } SEAM(3);
    RUN(4, do { sg::sgemm(F, ((const bf16*)(A.ws + WS_MIX)) + (size_t)NPR * DM, ((const bf16*)(A.ws + WS_WOUT)), DM, DM, sg::EpiRes{A.in[1], ((float*)(A.ws + WS_H)) + (size_t)NPR * DM, DM});
                GEMM_BODY(EpiResF32, ((bf16*)(A.ws + WS_MIX)), ((bf16*)(A.ws + WS_WOUT)), NPR, DM, DM, A.in[0], A.in[0], 1 << 20, ((float*)(A.ws + WS_H)), DM); } while (0));
    RUN(5, p7_hb(F, A));
    RUN(6, do { sg::sgemm(F, ((const bf16*)(A.ws + WS_HB)) + (size_t)NPR * DM, ((const bf16*)(A.ws + WS_WUP)), DM, DFF, sg::EpiRelu2{((bf16*)(A.ws + WS_ACT)) + (size_t)NPR * DFF, DFF});
                GEMM_BODY(EpiRelu2Bf16, ((bf16*)(A.ws + WS_HB)), ((bf16*)(A.ws + WS_WUP)), NPR, DFF, DM, ((bf16*)(A.ws + WS_ACT)), DFF); } while (0));
    RUN(7, do { sg::sgemm(F, ((const bf16*)(A.ws + WS_ACT)) + (size_t)NPR * DFF, ((const bf16*)(A.ws + WS_WDN)), DFF, DM, sg::EpiRes{((const float*)(A.ws + WS_H)) + (size_t)NPR * DM, A.out + (size_t)NPR * DM, DM});
                GEMM_BODY(EpiResF32, ((bf16*)(A.ws + WS_ACT)), ((bf16*)(A.ws + WS_WDN)), NPR, DM, DFF, ((float*)(A.ws + WS_H)), ((float*)(A.ws + WS_H)), 1 << 20, A.out, DM); } while (0));
    if (IN(8)) { p10_final(F, A); }
#undef IN
#undef SEAM
}

#ifndef MK_ONE_LAUNCH
#define MK_ONE_LAUNCH 1
#endif
extern "C" void kernel_launch(void* const* d_in, const int* in_sizes, int n_in, void* d_out, int out_size, void* d_ws, size_t ws_size, hipStream_t stream) {
    static int grid = 0;
    if (grid == 0) {
        if (n_in != 19 || (size_t)out_size != O_END || ws_size < WS_END) { fprintf(stderr, "kernel_launch: unexpected shapes n_in %d out %d ws %zu\n", n_in, out_size, ws_size); grid = -1; return; }
        int dev = 0, cus = 0, per_cu = 0;
        if (hipGetDevice(&dev) != hipSuccess || hipDeviceGetAttribute(&cus, hipDeviceAttributeMultiprocessorCount, dev) != hipSuccess) { grid = -1; return; }
        if (hipFuncSetAttribute((const void*)fwd_kernel, hipFuncAttributeMaxDynamicSharedMemorySize, LDS_BYTES) != hipSuccess) { fprintf(stderr, "kernel_launch: hipFuncSetAttribute failed\n"); grid = -1; return; }
        if (hipOccupancyMaxActiveBlocksPerMultiprocessor(&per_cu, (const void*)fwd_kernel, NTHR, LDS_BYTES) != hipSuccess || per_cu < 1) fprintf(stderr, "kernel_launch: occupancy query says %d\n", per_cu);
        (void)hipGetLastError();
        grid = cus;
    }
    if (grid < 0) return;
    if (hipMemsetAsync((char*)d_ws + WS_CTL, 0, CTL_ZERO_BYTES, stream) != hipSuccess) return;
    Args a{};
    for (int i = 0; i < 19; ++i) a.in[i] = (const float*)d_in[i];
    a.out = (float*)d_out; a.ws = (unsigned char*)d_ws;
#if MK_ONE_LAUNCH
    a.ph_lo = 0; a.ph_hi = NPHASES;
    hipLaunchKernelGGL(fwd_kernel, dim3(grid), dim3(NTHR), LDS_BYTES, stream, a);
#else
    for (int p = 0; p < NPHASES; ++p) { a.ph_lo = p; a.ph_hi = p + 1; hipLaunchKernelGGL(fwd_kernel, dim3(grid), dim3(NTHR), LDS_BYTES, stream, a); }
#endif
}
```

```cpp
#include <hip/hip_runtime.h>
#include <cstdio>
#include <cstdint>
namespace pg8 {
#define PG8_LAS __attribute__((address_space(3)))
typedef unsigned short bf16_t;
typedef short bf16x8 __attribute__((ext_vector_type(8)));
typedef float f32x4 __attribute__((ext_vector_type(4)));
typedef unsigned u32x4 __attribute__((ext_vector_type(4)));
constexpr int BM = 256, BK = 64, HALF = 128, HTB = HALF * BK * 2  , STAGE_BYTES = 8 * HTB, NXCD = 8, WGM = 8;

__host__ __device__ __forceinline__ int lds_byte(int r, int c) { const int st = (r >> 4) * 2 + (c >> 5), rr = r & 15, cc = c & 31, ob = rr * 64 + cc * 2; return st * 1024 + (ob ^ (((ob >> 9) & 1) << 5)); }
__host__ __device__ __forceinline__ void stage_rc(int b, int& R, int& C) { const int st = b / 1024, sb = b % 1024, swz = sb ^ (((sb >> 9) & 1) << 5); R = (st >> 1) * 16 + swz / 64; C = (st & 1) * 32 + (swz % 64) / 2; }
__host__ __device__ __forceinline__ int perm32(int rho) { const int n = rho >> 4, i = rho & 15; return 8 * (i >> 2) + 4 * n + (i & 3); }

struct Unit { int pm, pn; };
struct Gemm { const bf16_t* A; const bf16_t* Bt; int M, N, K; };

struct StaticOrder {
    int nM, nN, nwg, G, c;
    __host__ __device__ void init(int M, int N, int G_, int c_) { nM = M / BM; nN = N / BM; nwg = nM * nN; G = G_; c = c_; }
    __host__ __device__ bool next(int i, Unit& u) const {
        const long L = (long)i * G + c; if (L >= nwg) return false;
        int wgid = (int)L; { const int q = nwg / NXCD, r = nwg % NXCD, xcd = wgid % NXCD, off = wgid / NXCD; wgid = (xcd < r ? xcd * (q + 1) : r * (q + 1) + (xcd - r) * q) + off; }
        const int nig = WGM * nN, gid = wgid / nig, fm = gid * WGM, gsz = (nM - fm) < WGM ? (nM - fm) : WGM;
        u.pm = fm + ((wgid % nig) % gsz); u.pn = (wgid % nig) / gsz; return true;
    }
    __device__ __forceinline__ void a_ready(const Unit&) const {}
    __device__ __forceinline__ void done(const Unit&) const {}
};
struct CountedOrder : StaticOrder {
    const unsigned* ready; unsigned need; unsigned* tmo;
    __device__ __forceinline__ void a_ready(const Unit& u) const {
        if (threadIdx.x < 64) {
            const unsigned long long t0 = __builtin_amdgcn_s_memrealtime(); unsigned polls = 0;
            while ((unsigned)__builtin_amdgcn_readfirstlane(__hip_atomic_load(ready + 64 * u.pm, __ATOMIC_RELAXED, __HIP_MEMORY_SCOPE_AGENT)) < need) {
                if ((++polls & 255u) == 0u && __builtin_amdgcn_readfirstlane(__hip_atomic_load(tmo, __ATOMIC_RELAXED, __HIP_MEMORY_SCOPE_AGENT)) != 0u) break;
                if (__builtin_amdgcn_s_memrealtime() - t0 > 2000000ull) {
                    if (threadIdx.x == 0) { unsigned expect = 0u; __hip_atomic_compare_exchange_strong(tmo + 1, &expect, 0x600u | (unsigned)(u.pm & 0xff), __ATOMIC_RELAXED, __ATOMIC_RELAXED, __HIP_MEMORY_SCOPE_AGENT); __hip_atomic_store(tmo, 1u, __ATOMIC_RELAXED, __HIP_MEMORY_SCOPE_AGENT); }
                    break; }
                __builtin_amdgcn_s_sleep(2); }
            __builtin_amdgcn_fence(__ATOMIC_ACQUIRE, "agent");
            asm volatile("s_waitcnt vmcnt(0)" ::: "memory");
        }
#if !defined(BROKEN_HOOK_NO_BARRIER)
        asm volatile("" ::: "memory"); __builtin_amdgcn_s_barrier(); asm volatile("" ::: "memory");
#endif
    }
};

__device__ __forceinline__ unsigned cvt_pk_bf16(float lo, float hi) { unsigned r; asm volatile("v_cvt_pk_bf16_f32 %0, %1, %2" : "=v"(r) : "v"(lo), "v"(hi)); return r; }
struct EpiF32 {
    static constexpr bool PERM = false, AFTER_DRAIN = false;
    float* C; int ldc;
    __device__ __forceinline__ void operator()(const f32x4 (&acc)[2][2][4][2], const Unit& u, int wr, int wc, int fr, int fq) const {
        const int row0 = u.pm * BM + wr * 64 + fr, col0 = u.pn * BM + wc * 32 + 4 * fq;
#pragma unroll
        for (int ai = 0; ai < 2; ++ai)
#pragma unroll
            for (int m = 0; m < 4; ++m) { float* rowp = C + (size_t)(row0 + ai * HALF + m * 16) * ldc + col0;
#pragma unroll
                for (int bj = 0; bj < 2; ++bj)
#pragma unroll
                    for (int n = 0; n < 2; ++n) *(f32x4*)(rowp + bj * HALF + n * 16) = acc[ai][bj][m][n]; }
    }
};
struct EpiResF32 {
    static constexpr bool PERM = false, AFTER_DRAIN = false;
    const float* base0; const float* base1; int split; float* out; int ldc;
    __device__ __forceinline__ void operator()(const f32x4 (&acc)[2][2][4][2], const Unit& u, int wr, int wc, int fr, int fq) const {
        const int row0 = u.pm * BM + wr * 64 + fr, col0 = u.pn * BM + wc * 32 + 4 * fq;
        const float* bb = (u.pm < split) ? base0 : (base1 - (size_t)split * BM * ldc);
#pragma unroll
        for (int ai = 0; ai < 2; ++ai)
#pragma unroll
            for (int m = 0; m < 4; ++m) { const size_t off = (size_t)(row0 + ai * HALF + m * 16) * ldc + col0;
#pragma unroll
                for (int bj = 0; bj < 2; ++bj)
#pragma unroll
                    for (int n = 0; n < 2; ++n) { const f32x4 b = *(const f32x4*)(bb + off + bj * HALF + n * 16); *(f32x4*)(out + off + bj * HALF + n * 16) = acc[ai][bj][m][n] + b; } }
    }
};
struct EpiRelu2Bf16 {
    static constexpr bool PERM = true, AFTER_DRAIN = false;
    bf16_t* O; int ldc;
    __device__ __forceinline__ void operator()(const f32x4 (&acc)[2][2][4][2], const Unit& u, int wr, int wc, int fr, int fq) const {
        const int row0 = u.pm * BM + wr * 64 + fr, col0 = u.pn * BM + wc * 32 + 8 * fq;
#pragma unroll
        for (int ai = 0; ai < 2; ++ai)
#pragma unroll
            for (int m = 0; m < 4; ++m) { bf16_t* rowp = O + (size_t)(row0 + ai * HALF + m * 16) * ldc + col0;
#pragma unroll
                for (int bj = 0; bj < 2; ++bj) { f32x4 v0 = acc[ai][bj][m][0], v1 = acc[ai][bj][m][1];
#pragma unroll
                    for (int j = 0; j < 4; ++j) { const float a = fmaxf(v0[j], 0.f), b = fmaxf(v1[j], 0.f); v0[j] = a * a; v1[j] = b * b; }
                    u32x4 w; w.x = cvt_pk_bf16(v0[0], v0[1]); w.y = cvt_pk_bf16(v0[2], v0[3]); w.z = cvt_pk_bf16(v1[0], v1[1]); w.w = cvt_pk_bf16(v1[2], v1[3]);
                    *(u32x4*)(rowp + bj * HALF) = w; } }
    }
};
__device__ __forceinline__ float gelu_tanh(float x) {
    const float y = 0.7978845608028654f * (x + 0.044715f * x * x * x);
    const float t = 1.0f - 2.0f / (__expf(2.0f * y) + 1.0f);
    return 0.5f * x * (1.0f + t);
}
struct EpiCmpHid {
    static constexpr bool PERM = false, AFTER_DRAIN = false;
    float* H; int csplit;
    __device__ __forceinline__ void operator()(const f32x4 (&acc)[2][2][4][2], const Unit& u, int wr, int wc, int fr, int fq) const {
        const int row0 = u.pm * BM + wr * 64 + fr, col0 = wc * 32 + 4 * fq;
        const bool c1 = u.pm >= csplit;
#pragma unroll
        for (int ai = 0; ai < 2; ++ai)
#pragma unroll
            for (int m = 0; m < 4; ++m) { float* rowp = H + (size_t)(row0 + ai * HALF + m * 16) * 128 + col0;
#pragma unroll
                for (int n = 0; n < 2; ++n) { f32x4 v = c1 ? acc[ai][1][m][n] : acc[ai][0][m][n];
#pragma unroll
                    for (int j = 0; j < 4; ++j) v[j] = gelu_tanh(v[j]);
                    *(f32x4*)(rowp + n * 16) = v; } }
    }
};
template <class Epi, class Sched, bool STAMP = false>
__device__ __forceinline__ void gemm_phase(PG8_LAS unsigned char* lds, const Gemm g, const Sched& S, const Epi& E, unsigned long long* stamps) {
    const int tid = threadIdx.x, wid = __builtin_amdgcn_readfirstlane(tid >> 6), lane = tid & 63, wr = wid >> 2, wc = wid & 3, fr = lane & 15, fq = lane >> 4;
    const int K = g.K, nt = K / BK;
    int ts_lo = 0, ts_hi = 0, nts = 0; const unsigned long long rt_entry = STAMP ? (unsigned long long)wall_clock64() : 0ull;
#define PG8_STAMP() do { if (STAMP && wid == 0 && nts < 64) { const unsigned long long _c = (unsigned long long)clock64(); \
        ts_lo = (lane == nts) ? (int)(unsigned)_c : ts_lo; ts_hi = (lane == nts) ? (int)(unsigned)(_c >> 32) : ts_hi; ++nts; } } while (0)
    PG8_STAMP();
    unsigned voffA[2], voffB[2];
#pragma unroll
    for (int i = 0; i < 2; ++i) { int R, C; stage_rc(tid * 16 + i * 8192, R, C); const int Rb = Epi::PERM ? ((R & ~31) + perm32(R & 31)) : R;
        voffA[i] = (unsigned)(R * K + C) * 2u; voffB[i] = (unsigned)(Rb * K + C) * 2u; }
    const size_t kstep = (size_t)(BK * 2);
    const size_t hstep = (size_t)HALF * K * 2;
    const size_t tstep = 2 * hstep;
    const unsigned ldsw = (unsigned)wid * 1024u;
    const int aoff = lds_byte(wr * 64 + fr, fq * 8), boff = lds_byte(wc * 32 + fr, fq * 8);
#define PG8_SA(b, h) (((b) * 2 + (h)) * HTB)
#define PG8_SB(b, h) ((4 + (b) * 2 + (h)) * HTB)
#define PG8_STAGE(bufoff, gbase, voff) do { _Pragma("unroll") for (int _i = 0; _i < 2; ++_i) \
        __builtin_amdgcn_global_load_lds((const unsigned*)((const char*)(gbase) + (voff)[_i]), (PG8_LAS unsigned*)(lds + (bufoff) + ldsw + _i * 8192), 16, 0, 0); } while (0)
#define PG8_LDA(dst, b, h) do { _Pragma("unroll") for (int m = 0; m < 4; ++m) _Pragma("unroll") for (int k = 0; k < 2; ++k) dst[m][k] = *(const PG8_LAS bf16x8*)(lds + PG8_SA(b, h) + aoff + m * 2048 + k * 1024); } while (0)
#define PG8_LDB(dst, b, h) do { _Pragma("unroll") for (int n = 0; n < 2; ++n) _Pragma("unroll") for (int k = 0; k < 2; ++k) dst[n][k] = *(const PG8_LAS bf16x8*)(lds + PG8_SB(b, h) + boff + n * 2048 + k * 1024); } while (0)
#define PG8_MMA(ai, bj, At, Bt) do { __builtin_amdgcn_s_setprio(1); _Pragma("unroll") for (int m = 0; m < 4; ++m) _Pragma("unroll") for (int n = 0; n < 2; ++n) _Pragma("unroll") for (int k = 0; k < 2; ++k) \
        acc[ai][bj][m][n] = __builtin_amdgcn_mfma_f32_16x16x32_bf16(Bt[n][k], At[m][k], acc[ai][bj][m][n], 0, 0, 0); __builtin_amdgcn_s_setprio(0); } while (0)
#define PG8_WAIT_V(n) asm volatile("s_waitcnt vmcnt(" #n ")" ::: "memory")
#define PG8_WAIT_L(n) asm volatile("s_waitcnt lgkmcnt(" #n ")" ::: "memory")
#define PG8_BAR __builtin_amdgcn_s_barrier()
#define PG8_SCHED __builtin_amdgcn_sched_barrier(0)
    Unit cur, nxt; int ui = 0;
    if (!S.next(0, cur)) return;
    f32x4 acc[2][2][4][2];
#pragma unroll
    for (int a = 0; a < 2; ++a)
#pragma unroll
        for (int b = 0; b < 2; ++b)
#pragma unroll
            for (int m = 0; m < 4; ++m)
#pragma unroll
                for (int n = 0; n < 2; ++n) acc[a][b][m][n] = (f32x4){0.f, 0.f, 0.f, 0.f};
    bf16x8 At[4][2], B0[2][2], B1[2][2];
    const char* cA = (const char*)g.A + (size_t)cur.pm * tstep; const char* cB = (const char*)g.Bt + (size_t)cur.pn * tstep;
    S.a_ready(cur);
    PG8_STAGE(PG8_SB(0, 0), cB, voffB); PG8_STAGE(PG8_SA(0, 0), cA, voffA); PG8_STAGE(PG8_SB(0, 1), cB + hstep, voffB); PG8_STAGE(PG8_SA(0, 1), cA + hstep, voffA);
    if (wr == 1) PG8_BAR;
    PG8_WAIT_V(4); PG8_BAR;
    PG8_STAGE(PG8_SB(1, 0), cB + kstep, voffB); PG8_STAGE(PG8_SA(1, 0), cA + kstep, voffA); PG8_STAGE(PG8_SB(1, 1), cB + hstep + kstep, voffB);
    PG8_WAIT_V(6); PG8_BAR;
    PG8_STAMP();
    for (;;) {
        const bool has_next = S.next(ui + 1, nxt);
        const char* nA = has_next ? (const char*)g.A + (size_t)nxt.pm * tstep : cA; const char* nB = has_next ? (const char*)g.Bt + (size_t)nxt.pn * tstep : cB;
        for (int t = 0; t < nt; t += 2) {
            const bool last = (t == nt - 2);
            const char* a1 = cA + (size_t)(t + 1) * kstep;
            const char* a2 = last ? nA : cA + (size_t)(t + 2) * kstep; const char* b2 = last ? nB : cB + (size_t)(t + 2) * kstep;
            const char* a3 = a2 + kstep; const char* b3 = b2 + kstep;
            if (last && has_next) S.a_ready(nxt);
            PG8_LDB(B0, 0, 0); PG8_SCHED; PG8_LDA(At, 0, 0); PG8_STAGE(PG8_SA(1, 1), a1 + hstep, voffA);
            PG8_WAIT_L(8); PG8_BAR; PG8_WAIT_L(0); PG8_MMA(0, 0, At, B0); PG8_BAR; PG8_SCHED;
            PG8_LDB(B1, 0, 1); PG8_STAGE(PG8_SB(0, 0), b2, voffB);
            PG8_BAR; PG8_WAIT_L(0); PG8_MMA(0, 1, At, B1); PG8_BAR;
            PG8_LDA(At, 0, 1); PG8_STAGE(PG8_SA(0, 0), a2, voffA);
            PG8_BAR; PG8_WAIT_L(0); PG8_MMA(1, 0, At, B0); PG8_BAR; PG8_SCHED;
            PG8_STAGE(PG8_SB(0, 1), b2 + hstep, voffB);
            PG8_WAIT_V(6); PG8_BAR; PG8_MMA(1, 1, At, B1); PG8_BAR;
            PG8_LDB(B0, 1, 0); PG8_SCHED; PG8_LDA(At, 1, 0); PG8_STAGE(PG8_SA(0, 1), a2 + hstep, voffA);
            PG8_WAIT_L(8); PG8_BAR; PG8_WAIT_L(0); PG8_MMA(0, 0, At, B0); PG8_BAR; PG8_SCHED;
            PG8_LDB(B1, 1, 1); PG8_STAGE(PG8_SB(1, 0), b3, voffB);
            PG8_BAR; PG8_WAIT_L(0); PG8_MMA(0, 1, At, B1); PG8_BAR;
            PG8_LDA(At, 1, 1); PG8_STAGE(PG8_SA(1, 0), a3, voffA);
            PG8_BAR; PG8_WAIT_L(0); PG8_MMA(1, 0, At, B0); PG8_BAR; PG8_SCHED;
            PG8_STAGE(PG8_SB(1, 1), b3 + hstep, voffB);
            PG8_WAIT_V(6); PG8_BAR; PG8_MMA(1, 1, At, B1); PG8_BAR;
        }
        PG8_STAMP();
        if constexpr (!Epi::AFTER_DRAIN) { E(acc, cur, wr, wc, fr, fq); S.done(cur); }
        PG8_STAMP();
        if (!has_next) break;
#pragma unroll
        for (int a = 0; a < 2; ++a)
#pragma unroll
            for (int b = 0; b < 2; ++b)
#pragma unroll
                for (int m = 0; m < 4; ++m)
#pragma unroll
                    for (int n = 0; n < 2; ++n) acc[a][b][m][n] = (f32x4){0.f, 0.f, 0.f, 0.f};
        cur = nxt; cA = nA; cB = nB; ++ui;
    }
    PG8_WAIT_V(0);
    if (wr == 0) PG8_BAR;
    PG8_BAR;
    if constexpr (Epi::AFTER_DRAIN) { E.fused(acc, cur, wr, wc, fr, fq, lds, wid, lane); S.done(cur); }
    PG8_STAMP();
    if (STAMP && wid == 0) { stamps[lane] = lane < nts ? (((unsigned long long)(unsigned)ts_hi << 32) | (unsigned)ts_lo) : 0ull;
        if (lane == 62) stamps[62] = rt_entry; if (lane == 63) stamps[63] = (unsigned long long)wall_clock64(); }
#undef PG8_STAMP
#undef PG8_SA
#undef PG8_SB
#undef PG8_STAGE
#undef PG8_LDA
#undef PG8_LDB
#undef PG8_MMA
#undef PG8_WAIT_V
#undef PG8_WAIT_L
#undef PG8_BAR
#undef PG8_SCHED
}
}

constexpr int DM = 1024, NPR = 16384, NSM = 256, MTOK = NPR + NSM, SEQ = 4096, NBP = 64, PAST = 16384, NBS = 257, NPG = 128, DFF = 4096;
constexpr int PW = 2048;
constexpr int C_Q = 0, C_KC = 512, C_KS = 768, C_KW = 1024, C_U = 1280, C_G = 1792;
constexpr int CMP_SEC = 17152, CMP_ROWS = 2 * CMP_SEC;
constexpr int CMP_R_PROMPT = 16384, CMP_R_NEW = 16896, CMP_R_END = 16960;
constexpr size_t O_YP = 0, O_YS = 16777216, O_PCMP = 17039360, O_PSLC = 21233664, O_PWIN = 25427968, O_PPOOL = 25952256,
                 O_SCMP = 25982976, O_SSLC = 26048512, O_SWIN = 26114048, O_SPOOL = 30308352, O_END = 30554112;
constexpr size_t MiB = 1u << 20;
constexpr size_t WS_CTL = 0, CTL_ZERO_BYTES = 1 * MiB;
constexpr size_t WS_WIN = 2 * MiB, WS_WOUT = 6 * MiB, WS_WUP = 8 * MiB, WS_WDN = 16 * MiB, WS_W1S = 24 * MiB, WS_WPOOL = 26 * MiB;
constexpr size_t WS_XN = 32 * MiB, WS_PROJ = 66 * MiB, WS_ACMP = 200 * MiB, WS_HID = 470 * MiB, WS_COMPS = 490 * MiB, WS_COMPP = 500 * MiB;
constexpr size_t WS_MIX = 502 * MiB, WS_H = 536 * MiB, WS_HB = 602 * MiB, WS_ACT = 636 * MiB, WS_END = 768 * MiB;
static_assert(WS_XN + (size_t)MTOK * DM * 2 <= WS_PROJ && WS_PROJ + (size_t)MTOK * PW * 4 <= WS_ACMP && WS_ACMP + (size_t)CMP_ROWS * 4096 * 2 <= WS_HID, "ws map 1");
static_assert(WS_HID + (size_t)CMP_ROWS * 128 * 4 <= WS_COMPS && WS_COMPS + (size_t)32 * NBS * 256 * 4 <= WS_COMPP && WS_COMPP + (size_t)4 * NBP * 256 * 4 <= WS_MIX, "ws map 2");
static_assert(WS_MIX + (size_t)MTOK * DM * 2 <= WS_H && WS_H + (size_t)MTOK * DM * 4 <= WS_HB && WS_HB + (size_t)MTOK * DM * 2 <= WS_ACT && WS_ACT + (size_t)MTOK * DFF * 2 <= WS_END, "ws map 3");
constexpr int CW_BAR = 4096, CW_QUEUE = 8192, CW_CMPK = 12288;

constexpr int NWAVES = 8, NTHR = NWAVES * 64;
constexpr int RING_BYTES = 131072, LDSCTL_OFF = 143360, MISC_OFF = LDSCTL_OFF + 320, LDS_BYTES = 147456;
constexpr int NPHASES = 9;

#define GAS __attribute__((address_space(1)))
#define LAS __attribute__((address_space(3)))
typedef unsigned short bf16;
typedef unsigned v4u __attribute__((ext_vector_type(4)));
typedef unsigned v2u __attribute__((ext_vector_type(2)));
typedef float f32x4 __attribute__((ext_vector_type(4)));
#define LDS_WAIT() asm volatile("s_waitcnt lgkmcnt(0)" ::: "memory")
__device__ __forceinline__ unsigned f2bf(float f) { unsigned u = __builtin_bit_cast(unsigned, f); return (u + 0x7fffu + ((u >> 16) & 1u)) >> 16; }
__device__ __forceinline__ unsigned pk2(float lo, float hi) { return f2bf(lo) | (f2bf(hi) << 16); }
__device__ __forceinline__ float wave_sum(float v) {
#pragma unroll
    for (int o = 1; o < 64; o <<= 1) v += __shfl_xor(v, o);
    return v;
}
__device__ __forceinline__ float wave_max(float v) {
#pragma unroll
    for (int o = 1; o < 64; o <<= 1) v = fmaxf(v, __shfl_xor(v, o));
    return v;
}

#define XB_TMO      128
#define XB_XCNT(j)  (256  + 64 * (j))
#define XB_XSUB(j)  (1280 + 64 * (j))
#define XB_XGEN(j)  (2304 + 64 * (j))
#define XB_TOP      3328
#define XB_TOPGEN   3392
#define XCD_BAR_WORDS 3456
#define XB_SPIN_CAP (1u << 18)
__device__ __forceinline__ unsigned xb_ld(unsigned* p)              { return __hip_atomic_load(p, __ATOMIC_RELAXED, __HIP_MEMORY_SCOPE_AGENT); }
__device__ __forceinline__ unsigned xb_add(unsigned* p, unsigned v) { return __hip_atomic_fetch_add(p, v, __ATOMIC_RELAXED, __HIP_MEMORY_SCOPE_AGENT); }
__device__ __forceinline__ unsigned xb_xcc_id() { return (unsigned)__builtin_amdgcn_s_getreg((3 << 11) | 20) & 0xFu; }
#define XB_SPIN(cond, bar) do { unsigned _sp = 0; while (cond) { __builtin_amdgcn_s_sleep(1); \
    if ((++_sp & 255u) == 0u) { if (xb_ld(&(bar)[XB_TMO])) break; if (_sp > XB_SPIN_CAP) { atomicAdd(&(bar)[XB_TMO], 1u); break; } } } } while (0)
struct XcdBarrier { unsigned* bar; unsigned x; volatile LAS unsigned* st; };
__device__ __forceinline__ XcdBarrier xcd_barrier_post(unsigned* bar, volatile LAS unsigned* st) {
    XcdBarrier b; b.bar = bar; b.x = xb_xcc_id(); b.st = st;
    if (threadIdx.x == 0) (void)xb_add(&bar[XB_XCNT(b.x)], 1u);
    return b;
}
__device__ __forceinline__ void xcd_barrier_complete(unsigned* bar, unsigned x, unsigned& nloc, unsigned& nx) {
    const unsigned G = gridDim.x * gridDim.y * gridDim.z;
    unsigned sum, cnt, mine, sp = 0u;
    for (;;) {
        sum = 0u; cnt = 0u; mine = 0u;
#pragma unroll
        for (unsigned j = 0; j < 16; ++j) { const unsigned c = xb_ld(&bar[XB_XCNT(j)]); sum += c; cnt += (c > 0u) ? 1u : 0u; mine = (j == x) ? c : mine; }
        if (sum == G) break;
        __builtin_amdgcn_s_sleep(1);
        if ((++sp & 255u) == 0u) { if (xb_ld(&bar[XB_TMO])) break; if (sp > XB_SPIN_CAP) { atomicAdd(&bar[XB_TMO], 1u); break; } }
    }
    nloc = mine > 0u ? mine : 1u; nx = cnt > 0u ? cnt : 1u;
}
__device__ __forceinline__ void xcd_barrier(const XcdBarrier& b) {
    asm volatile("s_waitcnt vmcnt(0)" ::: "memory");
    __syncthreads();
    if (threadIdx.x == 0) {
        unsigned* bar = b.bar;
        __builtin_amdgcn_s_waitcnt(0);
        unsigned nloc = b.st[0], nx = b.st[1];
        if (nloc == 0u) { xcd_barrier_complete(bar, b.x, nloc, nx); b.st[0] = nloc; b.st[1] = nx; }
        const unsigned old = xb_add(&bar[XB_XSUB(b.x)], 1u);
        const unsigned gen = old / nloc;
        if (old + 1u == (gen + 1u) * nloc) {
            __builtin_amdgcn_fence(__ATOMIC_RELEASE, "agent");
            asm volatile("s_waitcnt vmcnt(0)" ::: "memory");
            const unsigned og = xb_add(&bar[XB_TOP], 1u);
            const unsigned tg = og / nx;
            if (og + 1u == (tg + 1u) * nx) xb_add(&bar[XB_TOPGEN], 1u);
            else XB_SPIN(xb_ld(&bar[XB_TOPGEN]) == tg, bar);
            __builtin_amdgcn_fence(__ATOMIC_ACQUIRE, "agent");
            xb_add(&bar[XB_XGEN(b.x)], 1u);
            asm volatile("s_waitcnt vmcnt(0)" ::: "memory");
        } else {
            XB_SPIN(xb_ld(&bar[XB_XGEN(b.x)]) == gen, bar);
            __builtin_amdgcn_fence(__ATOMIC_ACQUIRE, "agent");
            asm volatile("s_waitcnt vmcnt(0)" ::: "memory");
        }
    }
    __syncthreads();
}

struct Args { const float* in[19]; float* out; unsigned char* ws; int ph_lo, ph_hi; };
struct Frame {
    LAS unsigned char* lds;
    int tid, lane, wave, G, bid;
};

template <int MAP>
__device__ __forceinline__ void p0_transpose_item(const float* W, int K, int ldw, int nblk, bf16* WT, int row_off, LAS float* scr, int item, int lane) {
    const int kb = item / nblk, nb = item % nblk, k0 = 64 * kb, n0 = 32 * nb;
    const int nd = n0 + (lane & 31);
    int sc = nd;
    if (MAP == 1) { if (nd < 1280) sc = nd; else if (nd < 1792) sc = nd + 24; else if (nd < 1816) sc = nd - 512; else sc = -1; }
#pragma unroll 8
    for (int i = 0; i < 32; ++i) { const int kk = 2 * i + (lane >> 5); scr[kk * 33 + (lane & 31)] = (sc >= 0) ? W[(size_t)(k0 + kk) * ldw + sc] : 0.f; }
    LDS_WAIT(); asm volatile("" ::: "memory");
    const int c = lane & 7;
#pragma unroll
    for (int j = 0; j < 4; ++j) { const int n = (lane >> 3) + 8 * j; const LAS float* s = scr + (8 * c) * 33 + n;
        v4u o; o.x = pk2(s[0 * 33], s[1 * 33]); o.y = pk2(s[2 * 33], s[3 * 33]); o.z = pk2(s[4 * 33], s[5 * 33]); o.w = pk2(s[6 * 33], s[7 * 33]);
        *(v4u*)(WT + (size_t)(row_off + n0 + n) * K + k0 + 8 * c) = o; }
    LDS_WAIT(); asm volatile("" ::: "memory");
}
__device__ __forceinline__ void rms_row_to_bf16(const float* xrow, const float* g, bf16* orow, int lane) {
    const f32x4* xr = (const f32x4*)xrow + lane; const f32x4* gr = (const f32x4*)g + lane;
    f32x4 v[4]; float s = 0.f;
#pragma unroll
    for (int j = 0; j < 4; ++j) { v[j] = xr[64 * j]; s += (v[j].x * v[j].x + v[j].y * v[j].y) + (v[j].z * v[j].z + v[j].w * v[j].w); }
    const float rstd = 1.0f / sqrtf(wave_sum(s) * (1.f / DM) + 1e-6f);
    unsigned long long* o8 = (unsigned long long*)orow + lane;
#pragma unroll
    for (int j = 0; j < 4; ++j) { const f32x4 gg = gr[64 * j];
        o8[64 * j] = (unsigned long long)pk2(v[j].x * rstd * gg.x, v[j].y * rstd * gg.y) | ((unsigned long long)pk2(v[j].z * rstd * gg.z, v[j].w * rstd * gg.w) << 32); }
}

__device__ __forceinline__ void p0_prologue(const Frame& F, const Args& A) {
    LAS float* scr = (LAS float*)(F.lds + F.wave * 16384);
    const int gw = F.bid * NWAVES + F.wave, NGW = F.G * NWAVES;
    constexpr int I_IN = (DM / 64) * (PW / 32), I_OUT = (DM / 64) * (DM / 32), I_UP = (DM / 64) * (DFF / 32), I_DN = (DFF / 64) * (DM / 32), I_W1 = (4096 / 64) * (128 / 32);
    constexpr int I_WP = 32;
    constexpr int NITEMS = I_IN + I_OUT + I_UP + I_DN + 2 * I_W1 + I_WP;
    for (int it = gw; it < NITEMS; it += NGW) {
        int r = it;
        if (r < I_IN) { p0_transpose_item<1>(A.in[8], DM, 1816, PW / 32, ((bf16*)(A.ws + WS_WIN)), 0, scr, r, F.lane); continue; } r -= I_IN;
        if (r < I_OUT) { p0_transpose_item<0>(A.in[14], DM, DM, DM / 32, ((bf16*)(A.ws + WS_WOUT)), 0, scr, r, F.lane); continue; } r -= I_OUT;
        if (r < I_UP) { p0_transpose_item<0>(A.in[16], DM, DFF, DFF / 32, ((bf16*)(A.ws + WS_WUP)), 0, scr, r, F.lane); continue; } r -= I_UP;
        if (r < I_DN) { p0_transpose_item<0>(A.in[17], DFF, DM, DM / 32, ((bf16*)(A.ws + WS_WDN)), 0, scr, r, F.lane); continue; } r -= I_DN;
        if (r < I_W1) { p0_transpose_item<0>(A.in[10], 4096, 128, 4, ((bf16*)(A.ws + WS_W1S)), 0, scr, r, F.lane); continue; } r -= I_W1;
        if (r < I_W1) { p0_transpose_item<0>(A.in[10] + (size_t)4096 * 128, 4096, 128, 4, ((bf16*)(A.ws + WS_W1S)), 128, scr, r, F.lane); continue; } r -= I_W1;
        p0_transpose_item<0>(A.in[12] + (size_t)(r >> 3) * 16384, 128, 128, 4, ((bf16*)(A.ws + WS_WPOOL)), (r >> 3) * 128, scr, r & 7, F.lane);
    }
    for (int m = gw; m < MTOK; m += NGW) {
        const float* xr = m < NPR ? A.in[0] + (size_t)m * DM : A.in[1] + (size_t)(m - NPR) * DM;
        rms_row_to_bf16(xr, A.in[7], ((bf16*)(A.ws + WS_XN)) + (size_t)m * DM, F.lane);
    }
}

__device__ __forceinline__ void p2_copies(const Frame& F, const Args& A, int vbid, int vG) {
    const size_t gt = (size_t)vbid * NTHR + F.tid, NT = (size_t)vG * NTHR;
    const f32x4* P4 = (const f32x4*)((float*)(A.ws + WS_PROJ));
    f32x4* O4 = (f32x4*)A.out;
    for (size_t i = gt; i < (size_t)NPR * 64; i += NT) { const size_t r = i >> 6, c = i & 63;
        O4[O_PCMP / 4 + i] = P4[r * 512 + C_KC / 4 + c]; O4[O_PSLC / 4 + i] = P4[r * 512 + C_KS / 4 + c]; }
    for (size_t i = gt; i < (size_t)4 * 512 * 64; i += NT) { const size_t c = i & 63, r = (i >> 6) & 511, b = i >> 15;
        O4[O_PWIN / 4 + i] = P4[(b * SEQ + SEQ - 512 + r) * 512 + C_KW / 4 + c]; }
    for (size_t i = gt; i < (size_t)4 * 15 * 128; i += NT) { const size_t c = i & 127, r = (i >> 7) % 15, b = (i >> 7) / 15;
        O4[O_PPOOL / 4 + i] = P4[(b * SEQ + SEQ - 15 + r) * 512 + C_U / 4 + c]; }
    for (size_t i = gt; i < (size_t)NSM * 64; i += NT) { const size_t r = i >> 6, c = i & 63;
        O4[O_SCMP / 4 + i] = P4[(NPR + r) * 512 + C_KC / 4 + c]; O4[O_SSLC / 4 + i] = P4[(NPR + r) * 512 + C_KS / 4 + c]; }
    const f32x4* SW4 = (const f32x4*)A.in[4];
    for (size_t i = gt; i < (size_t)32 * 512 * 64; i += NT) { const size_t c = i & 63, r = (i >> 6) & 511, b = i >> 15;
        O4[O_SWIN / 4 + i] = (r < 504) ? SW4[(b * 512 + r + 8) * 64 + c] : P4[(NPR + b * 8 + (r - 504)) * 512 + C_KW / 4 + c]; }
    const f32x4* SP4 = (const f32x4*)A.in[5];
    for (size_t i = gt; i < (size_t)32 * 15 * 128; i += NT) { const size_t c = i & 127, r = (i >> 7) % 15, b = (i >> 7) / 15;
        O4[O_SPOOL / 4 + i] = (r < 7) ? SP4[(b * 15 + r + 8) * 128 + c] : P4[(NPR + b * 8 + (r - 7)) * 512 + C_U / 4 + c]; }
}
__device__ __forceinline__ void p2_cmp_gather(const Frame& F, const Args& A) {
    const int gw = F.bid * NWAVES + F.wave, NGW = F.G * NWAVES;
    constexpr int NBLK = 8192 + 256 + 32;
    const int lane = F.lane, gc = lane >> 4, g = gc >> 1, c = gc & 1, d0 = (lane & 15) * 4;
    for (int it = gw; it < NBLK * 64; it += NGW) {
        const int blk = it >> 6, l = it & 63;
        f32x4 v; int rsec;
        if (blk < 8192) { const int b = blk >> 8, n = blk & 255; const int page = ((const int*)A.in[6])[b * NPG + (n >> 1)];
            v = *(const f32x4*)(A.in[2] + ((size_t)page * 128 + (n & 1) * 64 + l) * 256 + lane * 4); rsec = (b * 256 + n) * 2 + g; }
        else if (blk < 8192 + 256) { const int q = blk - 8192, b = q >> 6, n = q & 63;
            v = *(const f32x4*)(((float*)(A.ws + WS_PROJ)) + ((size_t)b * SEQ + n * 64 + l) * PW + C_KC + lane * 4); rsec = CMP_R_PROMPT + (b * 64 + n) * 2 + g; }
        else { const int b = blk - 8192 - 256;
            v = (l < 8) ? *(const f32x4*)(((float*)(A.ws + WS_PROJ)) + ((size_t)NPR + b * 8 + l) * PW + C_KC + lane * 4) : (f32x4){0.f, 0.f, 0.f, 0.f}; rsec = CMP_R_NEW + b * 2 + g; }
        const f32x4 pe = *(const f32x4*)(A.in[9] + (l * 2 + c) * 64 + d0);
        v = v + pe;
        v2u o; o.x = pk2(v.x, v.y); o.y = pk2(v.z, v.w);
        *(v2u*)(((bf16*)(A.ws + WS_ACMP)) + ((size_t)c * CMP_SEC + rsec) * 4096 + l * 64 + d0) = o;
    }
}
__device__ __forceinline__ void p2_pool(const Frame& F, const Args& A) {
    LAS float* wl = (LAS float*)F.lds;
    LAS float* dl = (LAS float*)(F.lds + 65536 + F.wave * 2048);
    constexpr int NCH = MTOK / 32;
    const int lane = F.lane;
    for (int unit = F.bid; unit < 4 * NCH; unit += F.G) {
        const int gi = unit / NCH, ch = unit % NCH, w = 2 << gi;
        __syncthreads();
        for (int i = F.tid; i < 128 * 128 / 4; i += NTHR) ((LAS f32x4*)wl)[i] = ((const f32x4*)(A.in[12] + (size_t)gi * 16384))[i];
        const int tok0 = ch * 32 + F.wave * 4;
#pragma unroll
        for (int tk = 0; tk < 4; ++tk) {
            const int row = tok0 + tk;
#pragma unroll
            for (int hh = 0; hh < 2; ++hh) {
                const int cc = gi * 128 + lane + 64 * hh;
                float own, sum = 0.f, cnt;
                if (row < NPR) { const int t = row & (SEQ - 1);
                    own = ((float*)(A.ws + WS_PROJ))[(size_t)row * PW + C_U + cc];
                    for (int j = 0; j < w; ++j) if (t - j >= 0) sum += ((float*)(A.ws + WS_PROJ))[(size_t)(row - j) * PW + C_U + cc];
                    cnt = (float)((t + 1 < w) ? t + 1 : w);
                } else { const int q = row - NPR, b = q >> 3, i = q & 7;
                    own = ((float*)(A.ws + WS_PROJ))[(size_t)row * PW + C_U + cc];
                    for (int j = 0; j < w; ++j) { const int idx = 15 + i - j;
                        sum += (idx >= 15) ? ((float*)(A.ws + WS_PROJ))[(size_t)(NPR + b * 8 + idx - 15) * PW + C_U + cc] : A.in[5][((size_t)b * 15 + idx) * 512 + cc]; }
                    cnt = (float)w;
                }
                dl[(lane + 64 * hh) * 4 + tk] = sum / cnt - own;
            }
        }
        __syncthreads();
        float acc[4][2];
#pragma unroll
        for (int tk = 0; tk < 4; ++tk) { acc[tk][0] = 0.f; acc[tk][1] = 0.f; }
#pragma unroll 4
        for (int c = 0; c < 128; ++c) {
            const f32x4 dv = *(const LAS f32x4*)(dl + c * 4);
            const float w0 = wl[c * 128 + lane], w1 = wl[c * 128 + lane + 64];
            acc[0][0] += dv.x * w0; acc[0][1] += dv.x * w1; acc[1][0] += dv.y * w0; acc[1][1] += dv.y * w1;
            acc[2][0] += dv.z * w0; acc[2][1] += dv.z * w1; acc[3][0] += dv.w * w0; acc[3][1] += dv.w * w1;
        }
        const float s0 = A.in[13][gi * 128 + lane], s1 = A.in[13][gi * 128 + lane + 64];
#pragma unroll
        for (int tk = 0; tk < 4; ++tk) { bf16* o = ((bf16*)(A.ws + WS_MIX)) + (size_t)(tok0 + tk) * DM + 512 + gi * 128;
            o[lane] = (bf16)f2bf(acc[tk][0] * s0); o[lane + 64] = (bf16)f2bf(acc[tk][1] * s1); }
    }
    __syncthreads();
}

__device__ __forceinline__ void p4_cmp_w2(const Frame& F, const Args& A) {
    LAS float* w2l = (LAS float*)F.lds;
    LAS float* hl = (LAS float*)(F.lds + 65536 + F.wave * 512);
    for (int i = F.tid; i < 2 * 128 * 64 / 4; i += NTHR) ((LAS f32x4*)w2l)[i] = ((const f32x4*)A.in[11])[i];
    __syncthreads();
    const int gw = F.bid * NWAVES + F.wave, NGW = F.G * NWAVES, lane = F.lane;
    for (int it = gw; it < 2 * CMP_R_END; it += NGW) {
        const int c = it / CMP_R_END, r = it % CMP_R_END;
        const float* hrow = ((float*)(A.ws + WS_HID)) + ((size_t)c * CMP_SEC + r) * 128;
        hl[lane] = hrow[lane]; hl[lane + 64] = hrow[lane + 64];
        LDS_WAIT(); asm volatile("" ::: "memory");
        float a = 0.f;
#pragma unroll 8
        for (int h = 0; h < 128; ++h) a += hl[h] * w2l[(c * 128 + h) * 64 + lane];
        float* dst;
        if (r < CMP_R_PROMPT) { const int b = r >> 9, n = (r & 511) >> 1, g = r & 1; dst = ((float*)(A.ws + WS_COMPS)) + ((((size_t)b * NBS + n) * 2 + g) * 2 + c) * 64; }
        else if (r < CMP_R_NEW) { const int q = r - CMP_R_PROMPT, b = q >> 7, n = (q & 127) >> 1, g = q & 1; dst = ((float*)(A.ws + WS_COMPP)) + ((((size_t)b * NBP + n) * 2 + g) * 2 + c) * 64; }
        else { const int q = r - CMP_R_NEW, b = q >> 1, g = q & 1; dst = ((float*)(A.ws + WS_COMPS)) + ((((size_t)b * NBS + 256) * 2 + g) * 2 + c) * 64; }
        dst[lane] = a;
        LDS_WAIT(); asm volatile("" ::: "memory");
    }
    __syncthreads();
}

namespace att {
typedef short bf16x8 __attribute__((ext_vector_type(8)));
typedef short s16x4 __attribute__((ext_vector_type(4)));
typedef float f32x16 __attribute__((ext_vector_type(16)));
typedef float f32x2 __attribute__((ext_vector_type(2)));
typedef __bf16 bf16x2v __attribute__((ext_vector_type(2)));
constexpr int KP = 144, VP = 192, BUFB = 64 * KP + 64 * VP;
constexpr int AT_T = 2 * BUFB, T_WAVE = 8704, AT_ML = AT_T + 8 * T_WAVE, AT_SEL = AT_ML + 2048, AT_UNI = AT_SEL + 4096, AT_TILES = AT_UNI + 64, AT_MISC = AT_TILES + 4608, AT_KAUG = AT_MISC + 64, AT_END = AT_KAUG + 2048;
static_assert(AT_END <= LDSCTL_OFF, "attention LDS map");
constexpr int NUNITS = 576;
struct TileEnt { unsigned long long base; int pitch, kpos0, kind, blk, nrows, n0; };
static_assert(sizeof(TileEnt) == 32, "TileEnt");
__device__ __forceinline__ unsigned cvtpk(float lo, float hi) { f32x2 a = {lo, hi}; return __builtin_bit_cast(unsigned, __builtin_convertvector(a, bf16x2v)); }
__device__ __forceinline__ unsigned okey(float x) { const unsigned u = __builtin_bit_cast(unsigned, x); return (u & 0x80000000u) ? ~u : (u | 0x80000000u); }
#define ATT_KR(r) (((r) & 3) + 8 * ((r) >> 2))
#define ATT_MFMA(a, b, c) __builtin_amdgcn_mfma_f32_32x32x16_bf16((a), (b), (c), 0, 0, 0)

template <int VAR>
__device__ __forceinline__ void attn_phase(const Frame& F, const Args& A, int qslot) {
#if defined(__HIP_DEVICE_COMPILE__)
    LAS unsigned char* L = F.lds;
    const int tid = F.tid, lane = F.lane, wave = F.wave;
    const int r32 = lane & 31, h = lane >> 5, tl = r32 >> 2, p = r32 & 3;
    unsigned* qctr = (unsigned*)(A.ws + WS_CTL) + CW_QUEUE + 512 * qslot;
    const int myq = (int)(xb_xcc_id() & 7u);
    const float* PROJ = (const float*)(A.ws + WS_PROJ);
    LAS TileEnt* TILES = (LAS TileEnt*)(L + AT_TILES);
    volatile LAS int* MISC = (volatile LAS int*)(L + AT_MISC);
    LAS unsigned long long* UNI = (LAS unsigned long long*)(L + AT_UNI);
    LAS unsigned long long* SEL = (LAS unsigned long long*)(L + AT_SEL);
    LAS float* ML = (LAS float*)(L + AT_ML);
    constexpr float LOG2E = 1.4426950408889634f;
    if (tid < 64) { v4u z = {0u, 0u, 0u, 0u}; v4u w0 = z; w0.x = f2bf((float)tid); *(LAS v4u*)(L + AT_KAUG + tid * 32) = w0; *(LAS v4u*)(L + AT_KAUG + tid * 32 + 16) = z; }
    for (;;) {
        __syncthreads();
        if (tid == 0) {
            int unit = NUNITS;
            for (int k = 0; k < 8; ++k) { const int qi = (myq + k) & 7;
                if (__hip_atomic_load(qctr + 64 * qi, __ATOMIC_RELAXED, __HIP_MEMORY_SCOPE_AGENT) >= 72u) continue;
                const unsigned u = __hip_atomic_fetch_add(qctr + 64 * qi, 1u, __ATOMIC_RELAXED, __HIP_MEMORY_SCOPE_AGENT);
                if (u < 72u) { unit = (u < 8u) ? (qi * 8 + (int)u) : (64 + ((int)u - 8) * 8 + qi); break; } }
            MISC[0] = unit;
            for (int c = 0; c < 8; ++c) UNI[c] = 0ull;
        }
        __syncthreads();
        const int unit = MISC[0];
        if (unit >= NUNITS) break;
        const bool is_s = unit < 64;
        int b, g, qt;
        if (is_s) { b = unit >> 1; g = unit & 1; qt = 256; } else { const int u2 = unit - 64, rem = u2 & 7; qt = 63 - (u2 >> 3); b = rem >> 1; g = rem & 1; }
        const bool active = is_s ? (wave == 0) : true;
        const int cur = qt;
        const int tokrow = is_s ? (NPR + b * 8 + tl) : (b * SEQ + qt * 64 + wave * 8 + tl);
        const int qpos = is_s ? (PAST + tl) : (qt * 64 + wave * 8 + tl);
        const int mytok = is_s ? tl : (wave * 8 + tl);
        const int ncmp = is_s ? 4 : 1;
        const int nwin = is_s ? 9 : (qt < 8 ? qt + 1 : 9);
        const int TP = is_s ? 264 : 68;
        LAS float* Tm = (LAS float*)(L + AT_T + (is_s ? 0 : wave * T_WAVE));
        if (wave == 0 && lane < ncmp + nwin) {
            TileEnt e; e.blk = 0; e.n0 = 0; e.kpos0 = 0; e.nrows = 64; e.pitch = 256;
            if (lane < ncmp) { e.kind = 0; e.n0 = 64 * lane;
                e.base = is_s ? (unsigned long long)((const float*)(A.ws + WS_COMPS) + (((size_t)b * NBS + 64 * lane) * 2 + g) * 128) : (unsigned long long)((const float*)(A.ws + WS_COMPP) + (((size_t)b * NBP) * 2 + g) * 128); }
            else { const int w = lane - ncmp; e.kind = 2;
                if (!is_s) { const int tw = qt - w; e.kpos0 = tw * 64; e.base = (unsigned long long)(PROJ + ((size_t)b * SEQ + tw * 64) * PW + C_KW + g * 128); e.pitch = PW; }
                else if (w == 0) { e.kpos0 = PAST; e.base = (unsigned long long)(PROJ + ((size_t)NPR + b * 8) * PW + C_KW + g * 128); e.pitch = PW; e.nrows = 8; }
                else { const int ti = 8 - w; e.kpos0 = PAST - 512 + ti * 64; e.base = (unsigned long long)(A.in[4] + ((size_t)b * 512 + ti * 64) * 256 + g * 128); } }
            TILES[lane] = e;
        }
        bf16x8 Q[4];
        float gate0 = 0.f, gate1 = 0.f, gate2 = 0.f;
        const float slope = exp2f(-(float)(g * 4 + p + 1));
        if (active) {
            const float* prow = PROJ + (size_t)tokrow * PW;
            const float qs = 0.125f;
#pragma unroll
            for (int ks = 0; ks < 4; ++ks) { const f32x4 a = *(const f32x4*)(prow + C_Q + g * 256 + p * 64 + 16 * ks + 8 * h), c = *(const f32x4*)(prow + C_Q + g * 256 + p * 64 + 16 * ks + 8 * h + 4);
                v4u w; w.x = cvtpk(a.x * qs, a.y * qs); w.y = cvtpk(a.z * qs, a.w * qs); w.z = cvtpk(c.x * qs, c.y * qs); w.w = cvtpk(c.z * qs, c.w * qs);
                Q[ks] = __builtin_bit_cast(bf16x8, w); }
            gate0 = 1.0f / (1.0f + __expf(-prow[C_G + 0 + g * 4 + p])); gate1 = 1.0f / (1.0f + __expf(-prow[C_G + 8 + g * 4 + p])); gate2 = 1.0f / (1.0f + __expf(-prow[C_G + 16 + g * 4 + p]));
        } else {
#pragma unroll
            for (int ks = 0; ks < 4; ++ks) Q[ks] = (bf16x8){0, 0, 0, 0, 0, 0, 0, 0};
        }
        f32x16 O0, O1;
#pragma unroll
        for (int i = 0; i < 16; ++i) { O0[i] = 0.f; O1[i] = 0.f; }
        LAS f32x4* PA = (LAS f32x4*)(L + AT_T + (is_s ? 0 : wave * T_WAVE));
        float sc_c = 0.f;
#define ATT_CLOSE(scv, FIRST) do { _Pragma("unroll") for (int q4_ = 0; q4_ < 4; ++q4_) { \
            f32x4 a_ = (f32x4){O0[4 * q4_], O0[4 * q4_ + 1], O0[4 * q4_ + 2], O0[4 * q4_ + 3]} * (scv), b_ = (f32x4){O1[4 * q4_], O1[4 * q4_ + 1], O1[4 * q4_ + 2], O1[4 * q4_ + 3]} * (scv); \
            if (!(FIRST)) { a_ += PA[q4_ * 64 + lane]; b_ += PA[(4 + q4_) * 64 + lane]; } \
            PA[q4_ * 64 + lane] = a_; PA[(4 + q4_) * 64 + lane] = b_; } \
            _Pragma("unroll") for (int r_ = 0; r_ < 16; ++r_) { O0[r_] = 0.f; O1[r_] = 0.f; } } while (0)
        float m_run = -1e20f, l_run = 0.f;
        int curkind = 0;
        int ntiles = ncmp + nwin;
        f32x4 R0 = {0.f, 0.f, 0.f, 0.f}, R1 = R0, R2 = R0, R3 = R0;
#define ATT_LOAD(idx) do { if ((VAR == 2 || VAR == 3) && (idx) >= ncmp) break; const TileEnt e_ = TILES[(idx)]; const GAS float* bp_ = (const GAS float*)e_.base; const int nr_ = e_.nrows - 1; \
            { const int f_ = tid;        int row_ = f_ >> 5; row_ = row_ < nr_ ? row_ : nr_; R0 = *(const GAS f32x4*)(bp_ + (size_t)row_ * e_.pitch + (f_ & 31) * 4); } \
            { const int f_ = tid + 512;  int row_ = f_ >> 5; row_ = row_ < nr_ ? row_ : nr_; R1 = *(const GAS f32x4*)(bp_ + (size_t)row_ * e_.pitch + (f_ & 31) * 4); } \
            { const int f_ = tid + 1024; int row_ = f_ >> 5; row_ = row_ < nr_ ? row_ : nr_; R2 = *(const GAS f32x4*)(bp_ + (size_t)row_ * e_.pitch + (f_ & 31) * 4); } \
            { const int f_ = tid + 1536; int row_ = f_ >> 5; row_ = row_ < nr_ ? row_ : nr_; R3 = *(const GAS f32x4*)(bp_ + (size_t)row_ * e_.pitch + (f_ & 31) * 4); } } while (0)
#define ATT_ST1(buf, f_, Rv) do { const int row_ = (f_) >> 5, c4_ = (f_) & 31; v2u o_; o_.x = cvtpk(Rv.x, Rv.y); o_.y = cvtpk(Rv.z, Rv.w); \
            const int off_ = (buf) * BUFB + (c4_ < 16 ? row_ * KP + c4_ * 8 : 64 * KP + row_ * VP + (c4_ - 16) * 8); *(LAS v2u*)(L + off_) = o_; } while (0)
#define ATT_STORE(buf) do { ATT_ST1(buf, tid, R0); ATT_ST1(buf, tid + 512, R1); ATT_ST1(buf, tid + 1024, R2); ATT_ST1(buf, tid + 1536, R3); } while (0)
        __syncthreads();
        ATT_LOAD(0); ATT_STORE(0);
        __syncthreads();
        for (int i = 0; i < ntiles; ++i) {
            const int buf = i & 1;
            const bool has_next = (i + 1 < ntiles);
            if (has_next) ATT_LOAD(i + 1);
            if (active && ((VAR != 1 && VAR != 3) || i < ncmp)) {
                const TileEnt e = TILES[i];
                const int kind = __builtin_amdgcn_readfirstlane(e.kind), kpos0 = __builtin_amdgcn_readfirstlane(e.kpos0), blk = __builtin_amdgcn_readfirstlane(e.blk), n0 = __builtin_amdgcn_readfirstlane(e.n0);
                if (kind != curkind) {
                    if (curkind != 0) { const float sc = gate2 / fmaxf(l_run, 1e-30f); ATT_CLOSE(sc, false); m_run = -1e20f; l_run = 0.f; }
                    curkind = kind;
                }
                int dq_hi, dq_lo = -1; float rowc;
                if (kind == 0) { dq_hi = (qpos - 63 - 64 * n0) >> 6; rowc = slope * (float)(64 * n0 + 63 - qpos); }
                else if (kind == 1) { const unsigned long long w = SEL[mytok * 8 + (blk >> 6)]; const bool sb = (w >> (blk & 63)) & 1ull; dq_hi = sb ? (qpos - kpos0) : -1; rowc = slope * (float)(kpos0 - qpos); }
                else { dq_hi = qpos - kpos0; dq_lo = qpos - 512 - kpos0; rowc = slope * (float)(kpos0 - qpos); }
                const bool lane_any = (dq_hi >= 0) && (dq_lo < 63);
                if (kind == 0 || __any(lane_any)) {
                    const LAS unsigned char* Kb = L + buf * BUFB; const LAS unsigned char* Vb = Kb + 64 * KP;
                    f32x16 X0, X1;
#pragma unroll
                    for (int r = 0; r < 16; ++r) { X0[r] = 0.f; X1[r] = 0.f; }
#pragma unroll
                    for (int ks = 0; ks < 4; ++ks) {
                        const bf16x8 a0 = *(const LAS bf16x8*)(Kb + r32 * KP + (16 * ks + 8 * h) * 2);
                        const bf16x8 a1 = *(const LAS bf16x8*)(Kb + (32 + r32) * KP + (16 * ks + 8 * h) * 2);
                        X0 = ATT_MFMA(a0, Q[ks], X0); X1 = ATT_MFMA(a1, Q[ks], X1);
                    }
                    { v4u qa = {0u, 0u, 0u, 0u}; if (h == 0) qa.x = f2bf(kind == 0 ? slope * 64.f : slope);
                      const bf16x8 Qaug = __builtin_bit_cast(bf16x8, qa);
                      const bf16x8 ka0 = *(const LAS bf16x8*)(L + AT_KAUG + r32 * 32 + 16 * h), ka1 = *(const LAS bf16x8*)(L + AT_KAUG + (32 + r32) * 32 + 16 * h);
                      X0 = ATT_MFMA(ka0, Qaug, X0); X1 = ATT_MFMA(ka1, Qaug, X1); }
                    const float c0 = lane_any ? rowc * LOG2E : -1e30f;
#pragma unroll
                    for (int r = 0; r < 16; ++r) { X0[r] = fmaf(X0[r], LOG2E, c0); X1[r] = fmaf(X1[r], LOG2E, c0); }
                    const bool lane_edge = lane_any && !((dq_hi >= 63) && (dq_lo < 0));
                    if (__any(lane_edge)) {
                        const int hi2 = dq_hi - 4 * h, lo2 = dq_lo - 4 * h;
#pragma unroll
                        for (int r = 0; r < 16; ++r) { const int k0 = ATT_KR(r), k1 = 32 + ATT_KR(r);
                            X0[r] = (k0 <= hi2 && k0 > lo2) ? X0[r] : -1e30f; X1[r] = (k1 <= hi2 && k1 > lo2) ? X1[r] : -1e30f; }
                    }
                    if (kind == 0) {
#pragma unroll
                        for (int q4 = 0; q4 < 4; ++q4) {
                            *(LAS f32x4*)(Tm + r32 * TP + n0 + 8 * q4 + 4 * h) = (f32x4){X0[4 * q4], X0[4 * q4 + 1], X0[4 * q4 + 2], X0[4 * q4 + 3]};
                            *(LAS f32x4*)(Tm + r32 * TP + n0 + 32 + 8 * q4 + 4 * h) = (f32x4){X1[4 * q4], X1[4 * q4 + 1], X1[4 * q4 + 2], X1[4 * q4 + 3]}; }
                    }
                    float mx = -1e30f;
#pragma unroll
                    for (int r = 0; r < 16; r += 2) mx = fmaxf(fmaxf(mx, fmaxf(X0[r], X0[r + 1])), fmaxf(X1[r], X1[r + 1]));
                    mx = fmaxf(mx, __shfl_xor(mx, 32));
                    const float m_new = fmaxf(m_run, mx);
                    if (__any(m_new > m_run)) {
                        const float alpha = __builtin_amdgcn_exp2f(m_run - m_new);
#pragma unroll
                        for (int r = 0; r < 16; ++r) { O0[r] *= alpha; O1[r] *= alpha; }
                        l_run *= alpha; m_run = m_new;
                    }
                    float ls = 0.f;
#pragma unroll
                    for (int r = 0; r < 16; ++r) { X0[r] = __builtin_amdgcn_exp2f(X0[r] - m_run); X1[r] = __builtin_amdgcn_exp2f(X1[r] - m_run); ls += X0[r] + X1[r]; }
                    ls += __shfl_xor(ls, 32);
                    l_run += ls;
#pragma unroll
                    for (int kt = 0; kt < 2; ++kt) {
#pragma unroll
                        for (int s = 0; s < 2; ++s) {
                            v4u pw;
                            if (kt == 0) { pw.x = cvtpk(X0[8 * s], X0[8 * s + 1]); pw.y = cvtpk(X0[8 * s + 2], X0[8 * s + 3]); pw.z = cvtpk(X0[8 * s + 4], X0[8 * s + 5]); pw.w = cvtpk(X0[8 * s + 6], X0[8 * s + 7]); }
                            else         { pw.x = cvtpk(X1[8 * s], X1[8 * s + 1]); pw.y = cvtpk(X1[8 * s + 2], X1[8 * s + 3]); pw.z = cvtpk(X1[8 * s + 4], X1[8 * s + 5]); pw.w = cvtpk(X1[8 * s + 6], X1[8 * s + 7]); }
                            const bf16x8 pf = __builtin_bit_cast(bf16x8, pw);
                            const int key0 = kt * 32 + 16 * s + 4 * h, i16 = lane & 15, q = i16 >> 2, pp = i16 & 3, blk16 = (lane >> 4) & 1;
#pragma unroll
                            for (int dt = 0; dt < 2; ++dt) {
                                const LAS unsigned char* va = Vb + (key0 + q) * VP + (dt * 32 + 16 * blk16 + 4 * pp) * 2;
                                const s16x4 lo = __builtin_amdgcn_ds_read_tr16_b64_v4i16((LAS s16x4*)va);
                                const s16x4 hi = __builtin_amdgcn_ds_read_tr16_b64_v4i16((LAS s16x4*)(va + 8 * VP));
                                const bf16x8 vf = __builtin_shufflevector(lo, hi, 0, 1, 2, 3, 4, 5, 6, 7);
                                if (dt == 0) O0 = ATT_MFMA(vf, pf, O0); else O1 = ATT_MFMA(vf, pf, O1);
                            }
                        }
                    }
                }
                if (i + 1 == ncmp) {
                    const float il = 1.0f / fmaxf(l_run, 1e-30f); sc_c = gate0 * il;
                    if (h == 0) { ML[(wave * 32 + r32) * 2] = m_run; ML[(wave * 32 + r32) * 2 + 1] = il; }
                    m_run = -1e20f; l_run = 0.f;
                }
            }
            if (has_next) ATT_STORE(buf ^ 1);
            __syncthreads();
            if (i + 1 == ncmp) {
                if (!is_s) {
                    const LAS float* Tw = (const LAS float*)(L + AT_T + wave * T_WAVE);
                    for (int k = 0; k < 8; ++k) { const int tok = wave * 8 + k, n = lane; float imp = 0.f;
#pragma unroll
                        for (int pq = 0; pq < 4; ++pq) { const int row = k * 4 + pq; imp += __builtin_amdgcn_exp2f(Tw[row * 68 + n] - ML[(wave * 32 + row) * 2]) * ML[(wave * 32 + row) * 2 + 1]; }
                        float s = imp; if (n == 0 || n == cur || n == cur - 1) s = 5.0f; if (n > cur) s = -1.0f;
                        const unsigned key = okey(s); unsigned pre = 0u;
                        for (int bt = 31; bt >= 0; --bt) { const unsigned T = pre | (1u << bt); if (__popcll(__ballot(key >= T)) >= 16) pre = T; }
                        const unsigned long long gt = __ballot(key > pre), eq = __ballot(key == pre); const int need = 16 - __popcll(gt);
                        const bool pick = (key > pre) || (key == pre && __popcll(eq & ((1ull << lane) - 1ull)) < need);
                        const unsigned long long bal = __ballot(pick && n <= cur);
                        if (lane == 0) { SEL[tok * 8] = bal; __hip_atomic_fetch_or(&UNI[0], bal, __ATOMIC_RELAXED, __HIP_MEMORY_SCOPE_WORKGROUP); } }
                } else {
                    const LAS float* Tw = (const LAS float*)(L + AT_T);
                    const int tok = wave; unsigned key[5];
#pragma unroll
                    for (int c = 0; c < 5; ++c) { const int n = lane + 64 * c; float s = -2.0f;
                        if (n < 256) { float imp = 0.f;
#pragma unroll
                            for (int pq = 0; pq < 4; ++pq) { const int row = tok * 4 + pq; imp += __builtin_amdgcn_exp2f(Tw[row * 264 + n] - ML[row * 2]) * ML[row * 2 + 1]; }
                            s = imp; if (n == 0 || n == 255) s = 5.0f; }
                        else if (n == 256) s = 5.0f;
                        key[c] = okey(s); }
                    unsigned pre = 0u;
                    for (int bt = 31; bt >= 0; --bt) { const unsigned T = pre | (1u << bt); int cnt = 0;
#pragma unroll
                        for (int c = 0; c < 5; ++c) cnt += __popcll(__ballot(key[c] >= T));
                        if (cnt >= 16) pre = T; }
                    int ngt = 0;
#pragma unroll
                    for (int c = 0; c < 5; ++c) ngt += __popcll(__ballot(key[c] > pre));
                    int need = 16 - ngt;
#pragma unroll
                    for (int c = 0; c < 5; ++c) { const int n = lane + 64 * c; const unsigned long long eq = __ballot(key[c] == pre);
                        const bool pick = (key[c] > pre) || (key[c] == pre && __popcll(eq & ((1ull << lane) - 1ull)) < need);
                        need -= __popcll(eq);
                        const unsigned long long bal = __ballot(pick && n <= 256);
                        if (lane == 0) { SEL[tok * 8 + c] = bal; __hip_atomic_fetch_or(&UNI[c], bal, __ATOMIC_RELAXED, __HIP_MEMORY_SCOPE_WORKGROUP); } }
                }
                __syncthreads();
                if (active) ATT_CLOSE(sc_c, true);
                if (wave == 0) {
                    int base = ncmp + nwin;
                    for (int c = 4; c >= 0; --c) { const unsigned long long w = UNI[c];
                        if ((w >> lane) & 1ull) { const int j = c * 64 + lane; const int idx = base + (lane == 63 ? 0 : __popcll(w >> (lane + 1)));
                            TileEnt e; e.kind = 1; e.blk = j; e.kpos0 = j * 64; e.n0 = 0; e.nrows = 64; e.pitch = 256;
                            if (!is_s) { e.base = (unsigned long long)(PROJ + ((size_t)b * SEQ + j * 64) * PW + C_KS + g * 128); e.pitch = PW; }
                            else if (j < 256) { const int page = ((const int*)A.in[6])[b * NPG + (j >> 1)]; e.base = (unsigned long long)(A.in[3] + ((size_t)page * 128 + (j & 1) * 64) * 256 + g * 128); }
                            else { e.base = (unsigned long long)(PROJ + ((size_t)NPR + b * 8) * PW + C_KS + g * 128); e.pitch = PW; e.nrows = 8; }
                            TILES[idx] = e; }
                        base += __popcll(w); }
                    if (lane == 0) MISC[1] = base;
                }
                __syncthreads();
                ntiles = MISC[1];
            }
        }
        if (active) {
            const float sc = (curkind == 1 ? gate1 : gate2) / fmaxf(l_run, 1e-30f);
            bf16* orow = (bf16*)(A.ws + (VAR == 0 ? WS_MIX : WS_ACMP)) + (size_t)tokrow * DM + g * 256 + p * 64;
#pragma unroll
            for (int q4 = 0; q4 < 4; ++q4) {
                const f32x4 a = PA[q4 * 64 + lane] + (f32x4){O0[4 * q4], O0[4 * q4 + 1], O0[4 * q4 + 2], O0[4 * q4 + 3]} * sc, c = PA[(4 + q4) * 64 + lane] + (f32x4){O1[4 * q4], O1[4 * q4 + 1], O1[4 * q4 + 2], O1[4 * q4 + 3]} * sc;
                v2u o; o.x = cvtpk(a.x, a.y); o.y = cvtpk(a.z, a.w); *(v2u*)(orow + 8 * q4 + 4 * h) = o;
                v2u o2; o2.x = cvtpk(c.x, c.y); o2.y = cvtpk(c.z, c.w); *(v2u*)(orow + 32 + 8 * q4 + 4 * h) = o2; }
        }
    }
#undef ATT_CLOSE
#undef ATT_LOAD
#undef ATT_ST1
#undef ATT_STORE
#endif
}
#undef ATT_KR
#undef ATT_MFMA
}

namespace cmpk {
typedef short bf16x8 __attribute__((ext_vector_type(8)));
typedef float f32x16 __attribute__((ext_vector_type(16)));
constexpr int AP = 144, A_BYTES = 128 * AP, B_BYTES = 256 * AP, STG = A_BYTES + B_BYTES;
static_assert(2 * STG <= LDSCTL_OFF && 131072 <= LDSCTL_OFF, "compress LDS map");
constexpr int NUNITS_PAST = 256, NUNITS_ALL = 265;
__device__ __forceinline__ void cmp_unit(const Frame& F, const Args& A, int unit, int kq, int nkq) {
#if defined(__HIP_DEVICE_COMPILE__)
    LAS unsigned char* L = F.lds;
    const int tid = F.tid, lane = F.lane, wave = F.wave, r32 = lane & 31, h = lane >> 5;
    const float* PROJ = (const float*)(A.ws + WS_PROJ);
    const int* pt = (const int*)A.in[6];
    const float* bp0; const float* bp1; const float* bp2; const float* bp3; int pitch, nvalid;
    {
        const float* bpp[4];
#pragma unroll
        for (int i = 0; i < 4; ++i) { const int blk = wave + 8 * i;
            if (unit < 256) { const int b = unit >> 3, n = (unit & 7) * 32 + blk; const int page = pt[b * NPG + (n >> 1)]; bpp[i] = A.in[2] + ((size_t)page * 128 + (n & 1) * 64) * 256; }
            else if (unit < 264) { const int pu = unit - 256, b = pu >> 1, n = (pu & 1) * 32 + blk; bpp[i] = PROJ + ((size_t)b * SEQ + n * 64) * PW + C_KC; }
            else bpp[i] = PROJ + ((size_t)NPR + blk * 8) * PW + C_KC; }
        bp0 = bpp[0]; bp1 = bpp[1]; bp2 = bpp[2]; bp3 = bpp[3];
        pitch = unit < 256 ? 256 : PW; nvalid = unit < 264 ? 64 : 8;
    }
    const int gc = lane >> 4, g = gc >> 1, c = gc & 1, d0 = (lane & 15) * 4;
    const float* pep = A.in[9] + c * 64 + d0;
    const int a_off = (c * 64 + wave * 2 + g) * AP + d0 * 2;
    const bf16* bsrc = (const bf16*)(A.ws + WS_W1S) + (size_t)(tid >> 3) * 4096 + (tid & 7) * 8;
    const int b_off = A_BYTES + (tid >> 3) * AP + (tid & 7) * 16;
    const int cw = wave >> 2, rh = (wave >> 1) & 1, ch = wave & 1;
    const int fa_off = (cw * 64 + rh * 32 + r32) * AP + 16 * h, fb_off = A_BYTES + (cw * 128 + ch * 64 + r32) * AP + 16 * h;
    f32x16 acc0, acc1;
#pragma unroll
    for (int r = 0; r < 16; ++r) { acc0[r] = 0.f; acc1[r] = 0.f; }
    f32x4 RA0[4], RA1[4], RP0, RP1; v4u RB[4];
    const f32x4 z4 = {0.f, 0.f, 0.f, 0.f};
#define CK_LA(l, RA, RP) do { const size_t ro_ = (size_t)(l) * pitch + lane * 4; const bool ok_ = (l) < nvalid; \
        RA[0] = ok_ ? *(const f32x4*)(bp0 + ro_) : z4; RA[1] = ok_ ? *(const f32x4*)(bp1 + ro_) : z4; RA[2] = ok_ ? *(const f32x4*)(bp2 + ro_) : z4; RA[3] = ok_ ? *(const f32x4*)(bp3 + ro_) : z4; \
        RP = *(const f32x4*)(pep + (l) * 128); } while (0)
#define CK_LB(l) do { _Pragma("unroll") for (int i_ = 0; i_ < 4; ++i_) RB[i_] = *(const v4u*)(bsrc + (size_t)i_ * 64 * 4096 + (l) * 64); } while (0)
#define CK_SA(buf, RA, RP) do { _Pragma("unroll") for (int i_ = 0; i_ < 4; ++i_) { const f32x4 v_ = RA[i_] + RP; v2u o_; o_.x = att::cvtpk(v_.x, v_.y); o_.y = att::cvtpk(v_.z, v_.w); \
        *(LAS v2u*)(L + (buf) * STG + a_off + i_ * 16 * AP) = o_; } } while (0)
#define CK_SB(buf) do { _Pragma("unroll") for (int i_ = 0; i_ < 4; ++i_) *(LAS v4u*)(L + (buf) * STG + b_off + i_ * 64 * AP) = RB[i_]; } while (0)
#define CK_MMA(buf) do { _Pragma("unroll") for (int ks_ = 0; ks_ < 4; ++ks_) { \
        const bf16x8 a_ = *(const LAS bf16x8*)(L + (buf) * STG + fa_off + 32 * ks_); \
        const bf16x8 b0_ = *(const LAS bf16x8*)(L + (buf) * STG + fb_off + 32 * ks_); const bf16x8 b1_ = *(const LAS bf16x8*)(L + (buf) * STG + fb_off + 32 * AP + 32 * ks_); \
        acc0 = __builtin_amdgcn_mfma_f32_32x32x16_bf16(a_, b0_, acc0, 0, 0, 0); acc1 = __builtin_amdgcn_mfma_f32_32x32x16_bf16(a_, b1_, acc1, 0, 0, 0); } } while (0)
    const int nl = 64 / nkq, l0 = kq * nl, lend = l0 + nl;
    __syncthreads();
    CK_LA(l0, RA0, RP0); CK_LA(l0 + 1, RA1, RP1); CK_LB(l0);
    CK_SA(0, RA0, RP0); CK_SB(0); CK_LA(l0 + 2, RA0, RP0); CK_LB(l0 + 1);
    __syncthreads();
    for (int l = l0; l < lend; l += 2) {
        CK_MMA(0);
        CK_SA(1, RA1, RP1); CK_SB(1);
        if (l + 3 < lend) CK_LA(l + 3, RA1, RP1);
        if (l + 2 < lend) CK_LB(l + 2);
        __syncthreads();
        CK_MMA(1);
        if (l + 2 < lend) { CK_SA(0, RA0, RP0); CK_SB(0); }
        if (l + 4 < lend) CK_LA(l + 4, RA0, RP0);
        if (l + 3 < lend) CK_LB(l + 3);
        __syncthreads();
    }
    if (nkq > 1) {
        float* part = (float*)(A.ws + WS_HID) + ((size_t)(unit - 256) * 4) * 16384;
        float* mine = part + (size_t)kq * 16384 + wave * 2048 + lane;
#pragma unroll
        for (int r = 0; r < 16; ++r) { mine[r * 64] = acc0[r]; mine[(16 + r) * 64] = acc1[r]; }
        asm volatile("s_waitcnt vmcnt(0)" ::: "memory");
        __syncthreads();
        volatile LAS int* flag = (volatile LAS int*)(L + 2 * STG);
        if (tid == 0) {
            __builtin_amdgcn_fence(__ATOMIC_RELEASE, "agent");
            asm volatile("s_waitcnt vmcnt(0)" ::: "memory");
            const unsigned old = __hip_atomic_fetch_add((unsigned*)(A.ws + WS_CTL) + CW_CMPK + 64 * (unit - 256), 1u, __ATOMIC_RELAXED, __HIP_MEMORY_SCOPE_AGENT);
            const int last = (old == (unsigned)(nkq - 1)) ? 1 : 0;
            if (last) { __builtin_amdgcn_fence(__ATOMIC_ACQUIRE, "agent"); asm volatile("s_waitcnt vmcnt(0)" ::: "memory"); }
            flag[0] = last;
        }
        __syncthreads();
        if (flag[0] == 0) { __syncthreads(); return; }
#pragma unroll
        for (int r = 0; r < 16; ++r) { acc0[r] = 0.f; acc1[r] = 0.f; }
        for (int q = 0; q < nkq; ++q) { const float* src = part + (size_t)q * 16384 + wave * 2048 + lane;
#pragma unroll
            for (int r = 0; r < 16; ++r) { acc0[r] += src[r * 64]; acc1[r] += src[(16 + r) * 64]; } }
        __syncthreads();
    }
#undef CK_LA
#undef CK_LB
#undef CK_SA
#undef CK_SB
#undef CK_MMA
    LAS float* HL = (LAS float*)L; LAS float* W2L = (LAS float*)(L + 65536);
#pragma unroll
    for (int r = 0; r < 16; ++r) { const int row = rh * 32 + (r & 3) + 8 * (r >> 2) + 4 * h;
        HL[(cw * 64 + row) * 128 + ch * 64 + r32] = pg8::gelu_tanh(acc0[r]); HL[(cw * 64 + row) * 128 + ch * 64 + 32 + r32] = pg8::gelu_tanh(acc1[r]); }
    for (int i = tid; i < 2 * 128 * 64 / 4; i += NTHR) ((LAS f32x4*)W2L)[i] = ((const f32x4*)A.in[11])[i];
    __syncthreads();
    {
        const int c2 = wave >> 2, row0 = (wave & 3) * 16;
        float o[16];
#pragma unroll
        for (int rr = 0; rr < 16; ++rr) o[rr] = 0.f;
        for (int h4 = 0; h4 < 32; ++h4) {
            const float w0 = W2L[(c2 * 128 + 4 * h4) * 64 + lane], w1 = W2L[(c2 * 128 + 4 * h4 + 1) * 64 + lane], w2 = W2L[(c2 * 128 + 4 * h4 + 2) * 64 + lane], w3 = W2L[(c2 * 128 + 4 * h4 + 3) * 64 + lane];
#pragma unroll
            for (int rr = 0; rr < 16; ++rr) { const f32x4 hv = *(const LAS f32x4*)(HL + (c2 * 64 + row0 + rr) * 128 + 4 * h4); o[rr] += (hv.x * w0 + hv.y * w1) + (hv.z * w2 + hv.w * w3); }
        }
#pragma unroll
        for (int rr = 0; rr < 16; ++rr) { const int row = row0 + rr, blk = row >> 1, gg = row & 1; float* dst;
            if (unit < 256) { const int b = unit >> 3, n = (unit & 7) * 32 + blk; dst = (float*)(A.ws + WS_COMPS) + ((((size_t)b * NBS + n) * 2 + gg) * 2 + c2) * 64; }
            else if (unit < 264) { const int pu = unit - 256, b = pu >> 1, n = (pu & 1) * 32 + blk; dst = (float*)(A.ws + WS_COMPP) + ((((size_t)b * NBP + n) * 2 + gg) * 2 + c2) * 64; }
            else dst = (float*)(A.ws + WS_COMPS) + ((((size_t)blk * NBS + 256) * 2 + gg) * 2 + c2) * 64;
            dst[lane] = o[rr]; }
    }
    __syncthreads();
#endif
}
}

namespace poolk {
typedef short bf16x8 __attribute__((ext_vector_type(8)));
typedef float f32x16 __attribute__((ext_vector_type(16)));
typedef float f32x2 __attribute__((ext_vector_type(2)));
constexpr int DP = 272;
constexpr int WAVE_LDS = 32 * DP;
constexpr int NITEMS = 4 * 512 + 4 * 32;
template <int W>
__device__ __forceinline__ void pool_d(const f32x2 (&C)[48], int ntok, int pos0, bool is_s, LAS unsigned char* dl, int lane) {
#pragma unroll
    for (int tk = 0; tk < 32; ++tk) {
        f32x2 d = {0.f, 0.f};
        if (tk < ntok) {
            const float cnt = is_s ? (float)W : (float)((pos0 + tk + 1 < W) ? pos0 + tk + 1 : W);
            const f32x2 win = C[16 + tk] - C[16 + tk - W], own = C[16 + tk] - C[15 + tk];
            d = win / cnt - own;
        }
        *(LAS unsigned*)(dl + tk * DP + lane * 4) = att::cvtpk(d.x, d.y);
    }
}
__device__ __forceinline__ void pool_phase(const Frame& F, const Args& A, int vbid, int vG) {
#if defined(__HIP_DEVICE_COMPILE__)
    const int lane = F.lane, wave = F.wave, r32 = lane & 31, h = lane >> 5;
    LAS unsigned char* dl = F.lds + wave * WAVE_LDS;
    const float* PROJ = (const float*)(A.ws + WS_PROJ);
    const int gw = vbid * NWAVES + wave, NGW = vG * NWAVES;
    for (int it = gw; it < NITEMS; it += NGW) {
        int gi, row0, ntok, pos0; bool is_s; int sb = 0;
        if (it < 2048) { gi = it >> 9; const int ch = it & 511; row0 = ch * 32; ntok = 32; pos0 = row0 & (SEQ - 1); is_s = false; }
        else { const int q = it - 2048; gi = q >> 5; sb = q & 31; row0 = NPR + sb * 8; ntok = 8; pos0 = PAST; is_s = true; }
        f32x2 C[48];
        {
            f32x2 R[47];
            const int coff = C_U + gi * 128 + lane * 2;
#pragma unroll
            for (int i = 0; i < 47; ++i) {
                f32x2 v = {0.f, 0.f};
                if (!is_s) { const int t = pos0 - 15 + i; if (t >= 0) v = *(const f32x2*)(PROJ + (size_t)(row0 - 15 + i) * PW + coff); }
                else if (i < 15) v = *(const f32x2*)(A.in[5] + ((size_t)sb * 15 + i) * 512 + gi * 128 + lane * 2);
                else if (i < 23) v = *(const f32x2*)(PROJ + (size_t)(row0 + i - 15) * PW + coff);
                R[i] = v;
            }
            C[0] = (f32x2){0.f, 0.f};
#pragma unroll
            for (int i = 0; i < 47; ++i) C[i + 1] = C[i] + R[i];
        }
        switch (gi) { case 0: pool_d<2>(C, ntok, pos0, is_s, dl, lane); break; case 1: pool_d<4>(C, ntok, pos0, is_s, dl, lane); break;
                      case 2: pool_d<8>(C, ntok, pos0, is_s, dl, lane); break; default: pool_d<16>(C, ntok, pos0, is_s, dl, lane); break; }
        LDS_WAIT(); asm volatile("" ::: "memory");
        f32x16 acc[4];
#pragma unroll
        for (int t = 0; t < 4; ++t)
#pragma unroll
            for (int r = 0; r < 16; ++r) acc[t][r] = 0.f;
        const bf16* wp = (const bf16*)(A.ws + WS_WPOOL) + (size_t)gi * 16384;
#pragma unroll
        for (int ks = 0; ks < 8; ++ks) {
            const bf16x8 bfr = *(const LAS bf16x8*)(dl + r32 * DP + (16 * ks + 8 * h) * 2);
#pragma unroll
            for (int t = 0; t < 4; ++t) { const bf16x8 afr = *(const bf16x8*)(wp + (size_t)(t * 32 + r32) * 128 + 16 * ks + 8 * h);
                acc[t] = __builtin_amdgcn_mfma_f32_32x32x16_bf16(afr, bfr, acc[t], 0, 0, 0); }
        }
        if (r32 < ntok) {
            bf16* orow = (bf16*)(A.ws + WS_MIX) + (size_t)(row0 + r32) * DM + 512 + gi * 128;
            const float* ps = A.in[13] + gi * 128;
#pragma unroll
            for (int t = 0; t < 4; ++t)
#pragma unroll
                for (int q4 = 0; q4 < 4; ++q4) { const int dd = t * 32 + 8 * q4 + 4 * h; const f32x4 sc = *(const f32x4*)(ps + dd);
                    v2u o; o.x = att::cvtpk(acc[t][4 * q4] * sc.x, acc[t][4 * q4 + 1] * sc.y); o.y = att::cvtpk(acc[t][4 * q4 + 2] * sc.z, acc[t][4 * q4 + 3] * sc.w);
                    *(v2u*)(orow + dd) = o; }
        }
        LDS_WAIT(); asm volatile("" ::: "memory");
    }
#endif
}
}

namespace sg {
typedef short bf16x8 __attribute__((ext_vector_type(8)));
typedef float f32x16 __attribute__((ext_vector_type(16)));
struct EpiF32 { float* C; int ldc; __device__ __forceinline__ void operator()(int row, int col, float v) const { C[(size_t)row * ldc + col] = v; } };
struct EpiRes { const float* base; float* out; int ldc; __device__ __forceinline__ void operator()(int row, int col, float v) const { out[(size_t)row * ldc + col] = base[(size_t)row * ldc + col] + v; } };
struct EpiRelu2 { bf16* O; int ldc; __device__ __forceinline__ void operator()(int row, int col, float v) const { const float a = fmaxf(v, 0.f); O[(size_t)row * ldc + col] = (bf16)f2bf(a * a); } };
template <int KSPLIT, int NK, class Epi>
__device__ __forceinline__ void sgemm(const Frame& F, const bf16* Arows, const bf16* Bt, int K, int N, const Epi& E) {
#if defined(__HIP_DEVICE_COMPILE__)
    constexpr int TPI = 8 / KSPLIT;
    const int lane = F.lane, wave = F.wave, r32 = lane & 31, h = lane >> 5, split = wave % KSPLIT, tsel = wave / KSPLIT;
    LAS float* red = (LAS float*)F.lds;
    const int nitems = 8 * (N / 32) / TPI, kq = K / KSPLIT;
    for (int it = F.bid; it < nitems; it += F.G) {
        const int tile = it * TPI + tsel, tm = tile & 7, tn = tile >> 3;
        const bf16* ap = Arows + (size_t)(tm * 32 + r32) * K + split * kq + 8 * h;
        const bf16* bp = Bt + (size_t)(tn * 32 + r32) * K + split * kq + 8 * h;
        f32x16 acc;
#pragma unroll
        for (int r = 0; r < 16; ++r) acc[r] = 0.f;
#pragma unroll
        for (int k0 = 0; k0 < NK; k0 += 16) {
            bf16x8 a[16], b[16];
#pragma unroll
            for (int j = 0; j < 16; ++j) { a[j] = *(const bf16x8*)(ap + 16 * (k0 + j)); b[j] = *(const bf16x8*)(bp + 16 * (k0 + j)); }
#pragma unroll
            for (int j = 0; j < 16; ++j) acc = __builtin_amdgcn_mfma_f32_32x32x16_bf16(a[j], b[j], acc, 0, 0, 0);
        }
        __syncthreads();
        if (split != 0) {
#pragma unroll
            for (int r = 0; r < 16; ++r) red[wave * 1024 + r * 64 + lane] = acc[r]; }
        __syncthreads();
        if (split == 0) {
#pragma unroll
            for (int s = 1; s < KSPLIT; ++s)
#pragma unroll
                for (int r = 0; r < 16; ++r) acc[r] += red[(wave + s) * 1024 + r * 64 + lane];
#pragma unroll
            for (int r = 0; r < 16; ++r) E(tm * 32 + (r & 3) + 8 * (r >> 2) + 4 * h, tn * 32 + r32, acc[r]);
        }
    }
    __syncthreads();
#endif
}
}


__device__ __forceinline__ void p7_hb(const Frame& F, const Args& A) {
    const int gw = F.bid * NWAVES + F.wave, NGW = F.G * NWAVES;
    for (int m = gw; m < MTOK; m += NGW) rms_row_to_bf16(((float*)(A.ws + WS_H)) + (size_t)m * DM, A.in[15], ((bf16*)(A.ws + WS_HB)) + (size_t)m * DM, F.lane);
}
__device__ __forceinline__ void p10_final(const Frame& F, const Args& A) {
    const int gw = F.bid * NWAVES + F.wave, NGW = F.G * NWAVES, lane = F.lane;
    for (int m = gw; m < MTOK; m += NGW) {
        f32x4* xr = (f32x4*)(A.out + (size_t)m * DM) + lane; const f32x4* gr = (const f32x4*)A.in[18] + lane;
        f32x4 v[4]; float s = 0.f;
#pragma unroll
        for (int j = 0; j < 4; ++j) { v[j] = xr[64 * j]; s += (v[j].x * v[j].x + v[j].y * v[j].y) + (v[j].z * v[j].z + v[j].w * v[j].w); }
        const float rstd = 1.0f / sqrtf(wave_sum(s) * (1.f / DM) + 1e-6f);
#pragma unroll
        for (int j = 0; j < 4; ++j) xr[64 * j] = v[j] * rstd * gr[64 * j];
    }
}

__global__ void __launch_bounds__(NTHR, 2) fwd_kernel(Args A) {
    extern __shared__ __attribute__((aligned(16))) unsigned char lds_raw[];
    Frame F;
    F.lds = (LAS unsigned char*)lds_raw;
    F.tid = threadIdx.x; F.lane = F.tid & 63; F.wave = __builtin_amdgcn_readfirstlane(F.tid >> 6); F.G = gridDim.x; F.bid = blockIdx.x;
    unsigned char* ws = A.ws;
    for (int u = F.tid; u < (LDS_BYTES - LDSCTL_OFF) / 4; u += NTHR) ((LAS unsigned*)(F.lds + LDSCTL_OFF))[u] = 0u;
    __syncthreads();
    const int lo = A.ph_lo, hi = A.ph_hi;
    const bool multi = (hi - lo) > 1;
    XcdBarrier bar; bar.bar = (unsigned*)(ws + WS_CTL) + CW_BAR; bar.x = 0; bar.st = nullptr;
    if (multi) bar = xcd_barrier_post((unsigned*)(ws + WS_CTL) + CW_BAR, (volatile LAS unsigned*)(F.lds + MISC_OFF));
#define IN(k) (lo <= (k) && (k) < hi)
#define SEAM(k) do { if (IN(k) && IN((k) + 1)) xcd_barrier(bar); } while (0)

#ifndef REP_PHASE
#define REP_PHASE -1
#endif
#define RUN(k, ...) if (IN(k)) { __VA_ARGS__; if (REP_PHASE == (k)) { xcd_barrier(bar); __VA_ARGS__; } } SEAM(k)
#define GEMM_BODY(EPI, Aptr, Bptr, M_, N_, K_, ...) do { pg8::Gemm g{Aptr, Bptr, M_, N_, K_}; pg8::StaticOrder S; S.init(M_, N_, F.G, F.bid); pg8::EPI E{__VA_ARGS__}; pg8::gemm_phase<pg8::EPI, pg8::StaticOrder>(F.lds, g, S, E, nullptr); } while (0)
    RUN(0, p0_prologue(F, A));
    RUN(1, do { const bool cfirst = ((F.bid >> 3) & 1) == 0;
                if (cfirst) for (int u = F.bid; u < cmpk::NUNITS_PAST; u += F.G) cmpk::cmp_unit(F, A, u, 0, 1);
                sg::sgemm<4, 16>(F, ((const bf16*)(A.ws + WS_XN)) + (size_t)NPR * DM, ((const bf16*)(A.ws + WS_WIN)), DM, PW, sg::EpiF32{((float*)(A.ws + WS_PROJ)) + (size_t)NPR * PW, PW});
                GEMM_BODY(EpiF32, ((bf16*)(A.ws + WS_XN)), ((bf16*)(A.ws + WS_WIN)), NPR, PW, DM, ((float*)(A.ws + WS_PROJ)), PW);
                if (!cfirst) for (int u = F.bid; u < cmpk::NUNITS_PAST; u += F.G) cmpk::cmp_unit(F, A, u, 0, 1); } while (0));
    RUN(2, do { for (int it = F.bid; it < 4 * (cmpk::NUNITS_ALL - cmpk::NUNITS_PAST); it += F.G) cmpk::cmp_unit(F, A, cmpk::NUNITS_PAST + (it >> 2), it & 3, 4);
                { const int ncu = 4 * (cmpk::NUNITS_ALL - cmpk::NUNITS_PAST);
                  if (F.G > 2 * ncu) { if (F.bid >= ncu) { p2_copies(F, A, F.bid - ncu, F.G - ncu); poolk::pool_phase(F, A, F.bid - ncu, F.G - ncu); } }
                  else { p2_copies(F, A, F.bid, F.G); poolk::pool_phase(F, A, F.bid, F.G); } } } while (0));
    if (IN(3)) { att::attn_phase<0>(F, A, 0); if (REP_PHASE == 3) { xcd_barrier(bar); att::attn_phase<0>(F, A, 1); } if (REP_PHASE == 31) { xcd_barrier(bar); att::attn_phase<1>(F, A, 1); } if (REP_PHASE == 32) { xcd_barrier(bar); att::attn_phase<2>(F, A, 1); } if (REP_PHASE == 33) { xcd_barrier(bar); att::attn_phase<3>(F, A, 1); } } SEAM(3);
    RUN(4, do { sg::sgemm<4, 16>(F, ((const bf16*)(A.ws + WS_MIX)) + (size_t)NPR * DM, ((const bf16*)(A.ws + WS_WOUT)), DM, DM, sg::EpiRes{A.in[1], ((float*)(A.ws + WS_H)) + (size_t)NPR * DM, DM});
                GEMM_BODY(EpiResF32, ((bf16*)(A.ws + WS_MIX)), ((bf16*)(A.ws + WS_WOUT)), NPR, DM, DM, A.in[0], A.in[0], 1 << 20, ((float*)(A.ws + WS_H)), DM); } while (0));
    RUN(5, p7_hb(F, A));
    RUN(6, do { if (REP_PHASE == 60) sg::sgemm<4, 16>(F, ((const bf16*)(A.ws + WS_HB)) + (size_t)NPR * DM, ((const bf16*)(A.ws + WS_WUP)), DM, DFF, sg::EpiRelu2{((bf16*)(A.ws + WS_ACT)) + (size_t)NPR * DFF, DFF});
                sg::sgemm<4, 16>(F, ((const bf16*)(A.ws + WS_HB)) + (size_t)NPR * DM, ((const bf16*)(A.ws + WS_WUP)), DM, DFF, sg::EpiRelu2{((bf16*)(A.ws + WS_ACT)) + (size_t)NPR * DFF, DFF});
                GEMM_BODY(EpiRelu2Bf16, ((bf16*)(A.ws + WS_HB)), ((bf16*)(A.ws + WS_WUP)), NPR, DFF, DM, ((bf16*)(A.ws + WS_ACT)), DFF); } while (0));
    RUN(7, do { if (REP_PHASE == 70) sg::sgemm<8, 32>(F, ((const bf16*)(A.ws + WS_ACT)) + (size_t)NPR * DFF, ((const bf16*)(A.ws + WS_WDN)), DFF, DM, sg::EpiRes{((const float*)(A.ws + WS_H)) + (size_t)NPR * DM, A.out + (size_t)NPR * DM, DM});
                sg::sgemm<8, 32>(F, ((const bf16*)(A.ws + WS_ACT)) + (size_t)NPR * DFF, ((const bf16*)(A.ws + WS_WDN)), DFF, DM, sg::EpiRes{((const float*)(A.ws + WS_H)) + (size_t)NPR * DM, A.out + (size_t)NPR * DM, DM});
                GEMM_BODY(EpiResF32, ((bf16*)(A.ws + WS_ACT)), ((bf16*)(A.ws + WS_WDN)), NPR, DM, DFF, ((float*)(A.ws + WS_H)), ((float*)(A.ws + WS_H)), 1 << 20, A.out, DM); } while (0));
    if (IN(8)) { p10_final(F, A); }
#undef IN
#undef SEAM
}

#ifndef MK_ONE_LAUNCH
#define MK_ONE_LAUNCH 1
#endif
extern "C" void kernel_launch(void* const* d_in, const int* in_sizes, int n_in, void* d_out, int out_size, void* d_ws, size_t ws_size, hipStream_t stream) {
    static int grid = 0;
    if (grid == 0) {
        if (n_in != 19 || (size_t)out_size != O_END || ws_size < WS_END) { fprintf(stderr, "kernel_launch: unexpected shapes n_in %d out %d ws %zu\n", n_in, out_size, ws_size); grid = -1; return; }
        int dev = 0, cus = 0, per_cu = 0;
        if (hipGetDevice(&dev) != hipSuccess || hipDeviceGetAttribute(&cus, hipDeviceAttributeMultiprocessorCount, dev) != hipSuccess) { grid = -1; return; }
        if (hipFuncSetAttribute((const void*)fwd_kernel, hipFuncAttributeMaxDynamicSharedMemorySize, LDS_BYTES) != hipSuccess) { fprintf(stderr, "kernel_launch: hipFuncSetAttribute failed\n"); grid = -1; return; }
        if (hipOccupancyMaxActiveBlocksPerMultiprocessor(&per_cu, (const void*)fwd_kernel, NTHR, LDS_BYTES) != hipSuccess || per_cu < 1) fprintf(stderr, "kernel_launch: occupancy query says %d\n", per_cu);
        (void)hipGetLastError();
        grid = cus;
    }
    if (grid < 0) return;
    if (hipMemsetAsync((char*)d_ws + WS_CTL, 0, CTL_ZERO_BYTES, stream) != hipSuccess) return;
    Args a{};
    for (int i = 0; i < 19; ++i) a.in[i] = (const float*)d_in[i];
    a.out = (float*)d_out; a.ws = (unsigned char*)d_ws;
#if MK_ONE_LAUNCH
    a.ph_lo = 0; a.ph_hi = NPHASES;
    hipLaunchKernelGGL(fwd_kernel, dim3(grid), dim3(NTHR), LDS_BYTES, stream, a);
#else
    for (int p = 0; p < NPHASES; ++p) { a.ph_lo = p; a.ph_hi = p + 1; hipLaunchKernelGGL(fwd_kernel, dim3(grid), dim3(NTHR), LDS_BYTES, stream, a); }
#endif
}
```

```cpp
#include <hip/hip_runtime.h>
#include <cstdio>
#include <cstdint>
namespace pg8 {
#define PG8_LAS __attribute__((address_space(3)))
typedef unsigned short bf16_t;
typedef short bf16x8 __attribute__((ext_vector_type(8)));
typedef float f32x4 __attribute__((ext_vector_type(4)));
typedef unsigned u32x4 __attribute__((ext_vector_type(4)));
constexpr int BM = 256, BK = 64, HALF = 128, HTB = HALF * BK * 2  , STAGE_BYTES = 8 * HTB, NXCD = 8, WGM = 8;

__host__ __device__ __forceinline__ int lds_byte(int r, int c) { const int st = (r >> 4) * 2 + (c >> 5), rr = r & 15, cc = c & 31, ob = rr * 64 + cc * 2; return st * 1024 + (ob ^ (((ob >> 9) & 1) << 5)); }
__host__ __device__ __forceinline__ void stage_rc(int b, int& R, int& C) { const int st = b / 1024, sb = b % 1024, swz = sb ^ (((sb >> 9) & 1) << 5); R = (st >> 1) * 16 + swz / 64; C = (st & 1) * 32 + (swz % 64) / 2; }
__host__ __device__ __forceinline__ int perm32(int rho) { const int n = rho >> 4, i = rho & 15; return 8 * (i >> 2) + 4 * n + (i & 3); }

struct Unit { int pm, pn; };
struct Gemm { const bf16_t* A; const bf16_t* Bt; int M, N, K; };

struct StaticOrder {
    int nM, nN, nwg, G, c;
    __host__ __device__ void init(int M, int N, int G_, int c_) { nM = M / BM; nN = N / BM; nwg = nM * nN; G = G_; c = c_; }
    __host__ __device__ bool next(int i, Unit& u) const {
        const long L = (long)i * G + c; if (L >= nwg) return false;
        int wgid = (int)L; { const int q = nwg / NXCD, r = nwg % NXCD, xcd = wgid % NXCD, off = wgid / NXCD; wgid = (xcd < r ? xcd * (q + 1) : r * (q + 1) + (xcd - r) * q) + off; }
        const int nig = WGM * nN, gid = wgid / nig, fm = gid * WGM, gsz = (nM - fm) < WGM ? (nM - fm) : WGM;
        u.pm = fm + ((wgid % nig) % gsz); u.pn = (wgid % nig) / gsz; return true;
    }
    __device__ __forceinline__ void a_ready(const Unit&) const {}
    __device__ __forceinline__ void done(const Unit&) const {}
};
struct CountedOrder : StaticOrder {
    const unsigned* ready; unsigned need; unsigned* tmo;
    __device__ __forceinline__ void a_ready(const Unit& u) const {
        if (threadIdx.x < 64) {
            const unsigned long long t0 = __builtin_amdgcn_s_memrealtime(); unsigned polls = 0;
            while ((unsigned)__builtin_amdgcn_readfirstlane(__hip_atomic_load(ready + 64 * u.pm, __ATOMIC_RELAXED, __HIP_MEMORY_SCOPE_AGENT)) < need) {
                if ((++polls & 255u) == 0u && __builtin_amdgcn_readfirstlane(__hip_atomic_load(tmo, __ATOMIC_RELAXED, __HIP_MEMORY_SCOPE_AGENT)) != 0u) break;
                if (__builtin_amdgcn_s_memrealtime() - t0 > 2000000ull) {
                    if (threadIdx.x == 0) { unsigned expect = 0u; __hip_atomic_compare_exchange_strong(tmo + 1, &expect, 0x600u | (unsigned)(u.pm & 0xff), __ATOMIC_RELAXED, __ATOMIC_RELAXED, __HIP_MEMORY_SCOPE_AGENT); __hip_atomic_store(tmo, 1u, __ATOMIC_RELAXED, __HIP_MEMORY_SCOPE_AGENT); }
                    break; }
                __builtin_amdgcn_s_sleep(2); }
            __builtin_amdgcn_fence(__ATOMIC_ACQUIRE, "agent");
            asm volatile("s_waitcnt vmcnt(0)" ::: "memory");
        }
#if !defined(BROKEN_HOOK_NO_BARRIER)
        asm volatile("" ::: "memory"); __builtin_amdgcn_s_barrier(); asm volatile("" ::: "memory");
#endif
    }
};

__device__ __forceinline__ unsigned cvt_pk_bf16(float lo, float hi) { unsigned r; asm volatile("v_cvt_pk_bf16_f32 %0, %1, %2" : "=v"(r) : "v"(lo), "v"(hi)); return r; }
struct EpiF32 {
    static constexpr bool PERM = false, AFTER_DRAIN = false;
    float* C; int ldc;
    __device__ __forceinline__ void operator()(const f32x4 (&acc)[2][2][4][2], const Unit& u, int wr, int wc, int fr, int fq) const {
        const int row0 = u.pm * BM + wr * 64 + fr, col0 = u.pn * BM + wc * 32 + 4 * fq;
#pragma unroll
        for (int ai = 0; ai < 2; ++ai)
#pragma unroll
            for (int m = 0; m < 4; ++m) { float* rowp = C + (size_t)(row0 + ai * HALF + m * 16) * ldc + col0;
#pragma unroll
                for (int bj = 0; bj < 2; ++bj)
#pragma unroll
                    for (int n = 0; n < 2; ++n) *(f32x4*)(rowp + bj * HALF + n * 16) = acc[ai][bj][m][n]; }
    }
};
struct EpiResF32 {
    static constexpr bool PERM = false, AFTER_DRAIN = false;
    const float* base0; const float* base1; int split; float* out; int ldc;
    __device__ __forceinline__ void operator()(const f32x4 (&acc)[2][2][4][2], const Unit& u, int wr, int wc, int fr, int fq) const {
        const int row0 = u.pm * BM + wr * 64 + fr, col0 = u.pn * BM + wc * 32 + 4 * fq;
        const float* bb = (u.pm < split) ? base0 : (base1 - (size_t)split * BM * ldc);
#pragma unroll
        for (int ai = 0; ai < 2; ++ai)
#pragma unroll
            for (int m = 0; m < 4; ++m) { const size_t off = (size_t)(row0 + ai * HALF + m * 16) * ldc + col0;
#pragma unroll
                for (int bj = 0; bj < 2; ++bj)
#pragma unroll
                    for (int n = 0; n < 2; ++n) { const f32x4 b = *(const f32x4*)(bb + off + bj * HALF + n * 16); *(f32x4*)(out + off + bj * HALF + n * 16) = acc[ai][bj][m][n] + b; } }
    }
};
struct EpiRelu2Bf16 {
    static constexpr bool PERM = true, AFTER_DRAIN = false;
    bf16_t* O; int ldc;
    __device__ __forceinline__ void operator()(const f32x4 (&acc)[2][2][4][2], const Unit& u, int wr, int wc, int fr, int fq) const {
        const int row0 = u.pm * BM + wr * 64 + fr, col0 = u.pn * BM + wc * 32 + 8 * fq;
#pragma unroll
        for (int ai = 0; ai < 2; ++ai)
#pragma unroll
            for (int m = 0; m < 4; ++m) { bf16_t* rowp = O + (size_t)(row0 + ai * HALF + m * 16) * ldc + col0;
#pragma unroll
                for (int bj = 0; bj < 2; ++bj) { f32x4 v0 = acc[ai][bj][m][0], v1 = acc[ai][bj][m][1];
#pragma unroll
                    for (int j = 0; j < 4; ++j) { const float a = fmaxf(v0[j], 0.f), b = fmaxf(v1[j], 0.f); v0[j] = a * a; v1[j] = b * b; }
                    u32x4 w; w.x = cvt_pk_bf16(v0[0], v0[1]); w.y = cvt_pk_bf16(v0[2], v0[3]); w.z = cvt_pk_bf16(v1[0], v1[1]); w.w = cvt_pk_bf16(v1[2], v1[3]);
                    *(u32x4*)(rowp + bj * HALF) = w; } }
    }
};
__device__ __forceinline__ float gelu_tanh(float x) {
    const float y = 0.7978845608028654f * (x + 0.044715f * x * x * x);
    const float t = 1.0f - 2.0f / (__expf(2.0f * y) + 1.0f);
    return 0.5f * x * (1.0f + t);
}
struct EpiCmpHid {
    static constexpr bool PERM = false, AFTER_DRAIN = false;
    float* H; int csplit;
    __device__ __forceinline__ void operator()(const f32x4 (&acc)[2][2][4][2], const Unit& u, int wr, int wc, int fr, int fq) const {
        const int row0 = u.pm * BM + wr * 64 + fr, col0 = wc * 32 + 4 * fq;
        const bool c1 = u.pm >= csplit;
#pragma unroll
        for (int ai = 0; ai < 2; ++ai)
#pragma unroll
            for (int m = 0; m < 4; ++m) { float* rowp = H + (size_t)(row0 + ai * HALF + m * 16) * 128 + col0;
#pragma unroll
                for (int n = 0; n < 2; ++n) { f32x4 v = c1 ? acc[ai][1][m][n] : acc[ai][0][m][n];
#pragma unroll
                    for (int j = 0; j < 4; ++j) v[j] = gelu_tanh(v[j]);
                    *(f32x4*)(rowp + n * 16) = v; } }
    }
};

struct EpiResSS {
    static constexpr bool PERM = false, AFTER_DRAIN = true;
    const float* base; float* H; bf16_t* HBu; const float* gvec; float* SS; int ldc;
    __device__ __forceinline__ void fused(f32x4 (&acc)[2][2][4][2], const Unit& u, int wr, int wc, int fr, int fq, PG8_LAS unsigned char* lds, int wid, int lane) const {
        const int row0 = u.pm * BM + wr * 64 + fr, col0 = u.pn * BM + wc * 32 + 4 * fq;
        PG8_LAS float* P = (PG8_LAS float*)lds;
        f32x4 gv[2][2];
#pragma unroll
        for (int bj = 0; bj < 2; ++bj)
#pragma unroll
            for (int n = 0; n < 2; ++n) gv[bj][n] = *(const f32x4*)(gvec + col0 + bj * HALF + n * 16);
#pragma unroll
        for (int ai = 0; ai < 2; ++ai)
#pragma unroll
            for (int m = 0; m < 4; ++m) { const size_t off = (size_t)(row0 + ai * HALF + m * 16) * ldc + col0; float s = 0.f;
#pragma unroll
                for (int bj = 0; bj < 2; ++bj)
#pragma unroll
                    for (int n = 0; n < 2; ++n) { const f32x4 hv = acc[ai][bj][m][n] + *(const f32x4*)(base + off + bj * HALF + n * 16);
                        *(f32x4*)(H + off + bj * HALF + n * 16) = hv;
                        s += (hv[0] * hv[0] + hv[1] * hv[1]) + (hv[2] * hv[2] + hv[3] * hv[3]);
                        const f32x4 hg = hv * gv[bj][n];
                        typedef unsigned u32x2v __attribute__((ext_vector_type(2)));
                        u32x2v w; w.x = cvt_pk_bf16(hg[0], hg[1]); w.y = cvt_pk_bf16(hg[2], hg[3]);
                        *(u32x2v*)(HBu + off + bj * HALF + n * 16) = w; }
                s += __shfl_xor(s, 16); s += __shfl_xor(s, 32);
                if (fq == 0) P[(ai * HALF + wr * 64 + m * 16 + fr) * 4 + wc] = s; }
        asm volatile("s_waitcnt lgkmcnt(0)" ::: "memory"); __builtin_amdgcn_s_barrier(); asm volatile("" ::: "memory");
        const int t = wid * 64 + lane;
        if (t < 256) { const f32x4 pv = *(const PG8_LAS f32x4*)(P + t * 4); SS[(size_t)(u.pm * BM + t) * 4 + u.pn] = (pv[0] + pv[1]) + (pv[2] + pv[3]); }
    }
};
struct EpiRelu2RstdBf16 {
    static constexpr bool PERM = true, AFTER_DRAIN = false;
    bf16_t* O; int ldc; const float* SS; float inv_n, eps;
    __device__ __forceinline__ void operator()(const f32x4 (&acc)[2][2][4][2], const Unit& u, int wr, int wc, int fr, int fq) const {
        const int row0 = u.pm * BM + wr * 64 + fr, col0 = u.pn * BM + wc * 32 + 8 * fq;
#pragma unroll
        for (int ai = 0; ai < 2; ++ai)
#pragma unroll
            for (int m = 0; m < 4; ++m) { const int row = row0 + ai * HALF + m * 16; bf16_t* rowp = O + (size_t)row * ldc + col0;
                const f32x4 pv = *(const f32x4*)(SS + (size_t)row * 4);
                const float rstd = 1.0f / sqrtf(((pv[0] + pv[1]) + (pv[2] + pv[3])) * inv_n + eps);
#pragma unroll
                for (int bj = 0; bj < 2; ++bj) { f32x4 v0 = acc[ai][bj][m][0], v1 = acc[ai][bj][m][1];
#pragma unroll
                    for (int j = 0; j < 4; ++j) { const float a = fmaxf(v0[j] * rstd, 0.f), b = fmaxf(v1[j] * rstd, 0.f); v0[j] = a * a; v1[j] = b * b; }
                    u32x4 w; w.x = cvt_pk_bf16(v0[0], v0[1]); w.y = cvt_pk_bf16(v0[2], v0[3]); w.z = cvt_pk_bf16(v1[0], v1[1]); w.w = cvt_pk_bf16(v1[2], v1[3]);
                    *(u32x4*)(rowp + bj * HALF) = w; } }
    }
};
template <class Epi, class Sched, bool ALIGN_EPI = false, bool SP2 = false>
__device__ __forceinline__ void gemm_phase(PG8_LAS unsigned char* lds, const Gemm g, const Sched& S, const Epi& E) {
    const int tid = threadIdx.x, wid = __builtin_amdgcn_readfirstlane(tid >> 6), lane = tid & 63, wr = wid >> 2, wc = wid & 3, fr = lane & 15, fq = lane >> 4;
    const int K = g.K, nt = K / BK;
    unsigned voffA[2], voffB[2];
#pragma unroll
    for (int i = 0; i < 2; ++i) { int R, C; stage_rc(tid * 16 + i * 8192, R, C); const int Rb = Epi::PERM ? ((R & ~31) + perm32(R & 31)) : R;
        voffA[i] = (unsigned)(R * K + C) * 2u; voffB[i] = (unsigned)(Rb * K + C) * 2u; }
    const size_t kstep = (size_t)(BK * 2);
    const size_t hstep = (size_t)HALF * K * 2;
    const size_t tstep = 2 * hstep;
    const unsigned ldsw = (unsigned)wid * 1024u;
    const int aoff = lds_byte(wr * 64 + fr, fq * 8), boff = lds_byte(wc * 32 + fr, fq * 8);
#define PG8_SA(b, h) (((b) * 2 + (h)) * HTB)
#define PG8_SB(b, h) ((4 + (b) * 2 + (h)) * HTB)
#define PG8_STAGE(bufoff, gbase, voff) do { _Pragma("unroll") for (int _i = 0; _i < 2; ++_i) \
        __builtin_amdgcn_global_load_lds((const unsigned*)((const char*)(gbase) + (voff)[_i]), (PG8_LAS unsigned*)(lds + (bufoff) + ldsw + _i * 8192), 16, 0, 0); } while (0)
#define PG8_LDA(dst, b, h) do { _Pragma("unroll") for (int m = 0; m < 4; ++m) _Pragma("unroll") for (int k = 0; k < 2; ++k) dst[m][k] = *(const PG8_LAS bf16x8*)(lds + PG8_SA(b, h) + aoff + m * 2048 + k * 1024); } while (0)
#define PG8_LDB(dst, b, h) do { _Pragma("unroll") for (int n = 0; n < 2; ++n) _Pragma("unroll") for (int k = 0; k < 2; ++k) dst[n][k] = *(const PG8_LAS bf16x8*)(lds + PG8_SB(b, h) + boff + n * 2048 + k * 1024); } while (0)
#define PG8_MMA(ai, bj, At, Bt) do { __builtin_amdgcn_s_setprio(1); _Pragma("unroll") for (int m = 0; m < 4; ++m) _Pragma("unroll") for (int n = 0; n < 2; ++n) _Pragma("unroll") for (int k = 0; k < 2; ++k) \
        acc[ai][bj][m][n] = __builtin_amdgcn_mfma_f32_16x16x32_bf16(Bt[n][k], At[m][k], acc[ai][bj][m][n], 0, 0, 0); __builtin_amdgcn_s_setprio(0); } while (0)
#define PG8_WAIT_V(n) asm volatile("s_waitcnt vmcnt(" #n ")" ::: "memory")
#define PG8_WAIT_L(n) asm volatile("s_waitcnt lgkmcnt(" #n ")" ::: "memory")
#define PG8_BAR __builtin_amdgcn_s_barrier()
#define PG8_SCHED __builtin_amdgcn_sched_barrier(0)
    Unit cur, nxt; int ui = 0;
    if (!S.next(0, cur)) return;
    f32x4 acc[2][2][4][2];
#pragma unroll
    for (int a = 0; a < 2; ++a)
#pragma unroll
        for (int b = 0; b < 2; ++b)
#pragma unroll
            for (int m = 0; m < 4; ++m)
#pragma unroll
                for (int n = 0; n < 2; ++n) acc[a][b][m][n] = (f32x4){0.f, 0.f, 0.f, 0.f};
    bf16x8 At[4][2], B0[2][2], B1[2][2];
    const char* cA = (const char*)g.A + (size_t)cur.pm * tstep; const char* cB = (const char*)g.Bt + (size_t)cur.pn * tstep;
    S.a_ready(cur);
    if constexpr (SP2) {
        PG8_STAGE(PG8_SB(0, 0), cB, voffB); PG8_STAGE(PG8_SB(0, 1), cB + hstep, voffB); PG8_STAGE(PG8_SA(0, 0), cA, voffA); PG8_STAGE(PG8_SA(0, 1), cA + hstep, voffA);
        if (wr == 1) PG8_BAR;
        PG8_WAIT_V(2); PG8_BAR;
        PG8_STAGE(PG8_SB(1, 0), cB + kstep, voffB); PG8_STAGE(PG8_SA(1, 0), cA + kstep, voffA); PG8_STAGE(PG8_SB(1, 1), cB + hstep + kstep, voffB);
        PG8_WAIT_V(6); PG8_BAR;
    } else {
        PG8_STAGE(PG8_SB(0, 0), cB, voffB); PG8_STAGE(PG8_SA(0, 0), cA, voffA); PG8_STAGE(PG8_SB(0, 1), cB + hstep, voffB); PG8_STAGE(PG8_SA(0, 1), cA + hstep, voffA);
        if (wr == 1) PG8_BAR;
        PG8_WAIT_V(4); PG8_BAR;
        PG8_STAGE(PG8_SB(1, 0), cB + kstep, voffB); PG8_STAGE(PG8_SA(1, 0), cA + kstep, voffA); PG8_STAGE(PG8_SB(1, 1), cB + hstep + kstep, voffB);
        PG8_WAIT_V(6); PG8_BAR;
    }
    for (;;) {
        const bool has_next = S.next(ui + 1, nxt);
        const char* nA = has_next ? (const char*)g.A + (size_t)nxt.pm * tstep : cA; const char* nB = has_next ? (const char*)g.Bt + (size_t)nxt.pn * tstep : cB;
        for (int t = 0; t < nt; t += 2) {
            const bool last = (t == nt - 2);
            const char* a1 = cA + (size_t)(t + 1) * kstep;
            const char* a2 = last ? nA : cA + (size_t)(t + 2) * kstep; const char* b2 = last ? nB : cB + (size_t)(t + 2) * kstep;
            const char* a3 = a2 + kstep; const char* b3 = b2 + kstep;
            if (last && has_next) S.a_ready(nxt);
            if constexpr (SP2) {
            PG8_LDB(B0, 0, 0); PG8_LDB(B1, 0, 1); PG8_SCHED; PG8_LDA(At, 0, 0); PG8_STAGE(PG8_SA(1, 1), a1 + hstep, voffA);
            PG8_WAIT_V(8); PG8_WAIT_L(0); PG8_BAR; PG8_MMA(0, 0, At, B0); PG8_MMA(0, 1, At, B1); PG8_BAR; PG8_SCHED;
            PG8_LDA(At, 0, 1); PG8_STAGE(PG8_SB(0, 0), b2, voffB); PG8_STAGE(PG8_SB(0, 1), b2 + hstep, voffB); PG8_STAGE(PG8_SA(0, 0), a2, voffA);
            PG8_WAIT_V(8); PG8_WAIT_L(0); PG8_BAR; PG8_MMA(1, 0, At, B0); PG8_MMA(1, 1, At, B1); PG8_BAR; PG8_SCHED;
            PG8_LDB(B0, 1, 0); PG8_LDB(B1, 1, 1); PG8_SCHED; PG8_LDA(At, 1, 0); PG8_STAGE(PG8_SA(0, 1), a2 + hstep, voffA);
            PG8_WAIT_V(8); PG8_WAIT_L(0); PG8_BAR; PG8_MMA(0, 0, At, B0); PG8_MMA(0, 1, At, B1); PG8_BAR; PG8_SCHED;
            PG8_LDA(At, 1, 1); PG8_STAGE(PG8_SB(1, 0), b3, voffB); PG8_STAGE(PG8_SB(1, 1), b3 + hstep, voffB); PG8_STAGE(PG8_SA(1, 0), a3, voffA);
            PG8_WAIT_V(8); PG8_WAIT_L(0); PG8_BAR; PG8_MMA(1, 0, At, B0); PG8_MMA(1, 1, At, B1); PG8_BAR; PG8_SCHED;
            } else {
            PG8_LDB(B0, 0, 0); PG8_SCHED; PG8_LDA(At, 0, 0); PG8_STAGE(PG8_SA(1, 1), a1 + hstep, voffA);
            PG8_WAIT_L(8); PG8_BAR; PG8_WAIT_L(0); PG8_MMA(0, 0, At, B0); PG8_BAR; PG8_SCHED;
            PG8_LDB(B1, 0, 1); PG8_STAGE(PG8_SB(0, 0), b2, voffB);
            PG8_BAR; PG8_WAIT_L(0); PG8_MMA(0, 1, At, B1); PG8_BAR;
            PG8_LDA(At, 0, 1); PG8_STAGE(PG8_SA(0, 0), a2, voffA);
            PG8_BAR; PG8_WAIT_L(0); PG8_MMA(1, 0, At, B0); PG8_BAR; PG8_SCHED;
            PG8_STAGE(PG8_SB(0, 1), b2 + hstep, voffB);
            PG8_WAIT_V(6); PG8_BAR; PG8_MMA(1, 1, At, B1); PG8_BAR;
            PG8_LDB(B0, 1, 0); PG8_SCHED; PG8_LDA(At, 1, 0); PG8_STAGE(PG8_SA(0, 1), a2 + hstep, voffA);
            PG8_WAIT_L(8); PG8_BAR; PG8_WAIT_L(0); PG8_MMA(0, 0, At, B0); PG8_BAR; PG8_SCHED;
            PG8_LDB(B1, 1, 1); PG8_STAGE(PG8_SB(1, 0), b3, voffB);
            PG8_BAR; PG8_WAIT_L(0); PG8_MMA(0, 1, At, B1); PG8_BAR;
            PG8_LDA(At, 1, 1); PG8_STAGE(PG8_SA(1, 0), a3, voffA);
            PG8_BAR; PG8_WAIT_L(0); PG8_MMA(1, 0, At, B0); PG8_BAR; PG8_SCHED;
            PG8_STAGE(PG8_SB(1, 1), b3 + hstep, voffB);
            PG8_WAIT_V(6); PG8_BAR; PG8_MMA(1, 1, At, B1); PG8_BAR;
            }
        }
        if constexpr (ALIGN_EPI) { if (wr == 0) PG8_BAR; }
        if constexpr (!Epi::AFTER_DRAIN) { E(acc, cur, wr, wc, fr, fq); S.done(cur); }
        if (!has_next) break;
#pragma unroll
        for (int a = 0; a < 2; ++a)
#pragma unroll
            for (int b = 0; b < 2; ++b)
#pragma unroll
                for (int m = 0; m < 4; ++m)
#pragma unroll
                    for (int n = 0; n < 2; ++n) acc[a][b][m][n] = (f32x4){0.f, 0.f, 0.f, 0.f};
        cur = nxt; cA = nA; cB = nB; ++ui;
        if constexpr (ALIGN_EPI) { if (wr == 1) PG8_BAR; }
    }
    PG8_WAIT_V(0);
    if constexpr (!ALIGN_EPI) { if (wr == 0) PG8_BAR; }
    PG8_BAR;
    if constexpr (Epi::AFTER_DRAIN) { E.fused(acc, cur, wr, wc, fr, fq, lds, wid, lane); S.done(cur); }
#undef PG8_SA
#undef PG8_SB
#undef PG8_STAGE
#undef PG8_LDA
#undef PG8_LDB
#undef PG8_MMA
#undef PG8_WAIT_V
#undef PG8_WAIT_L
#undef PG8_BAR
#undef PG8_SCHED
}
}

constexpr int DM = 1024, NPR = 16384, NSM = 256, MTOK = NPR + NSM, SEQ = 4096, NBP = 64, PAST = 16384, NBS = 257, NPG = 128, DFF = 4096;
constexpr int PW = 2048;
constexpr int C_Q = 0, C_KC = 512, C_KS = 768, C_KW = 1024, C_U = 1280, C_G = 1792;
constexpr int CMP_SEC = 17152, CMP_ROWS = 2 * CMP_SEC;
constexpr int CMP_R_PROMPT = 16384, CMP_R_NEW = 16896, CMP_R_END = 16960;
constexpr size_t O_YP = 0, O_YS = 16777216, O_PCMP = 17039360, O_PSLC = 21233664, O_PWIN = 25427968, O_PPOOL = 25952256,
                 O_SCMP = 25982976, O_SSLC = 26048512, O_SWIN = 26114048, O_SPOOL = 30308352, O_END = 30554112;
constexpr size_t MiB = 1u << 20;
constexpr size_t WS_CTL = 0, CTL_ZERO_BYTES = 1 * MiB;
constexpr size_t WS_WIN = 2 * MiB, WS_WOUT = 6 * MiB, WS_WUP = 8 * MiB, WS_WDN = 16 * MiB, WS_W1S = 24 * MiB, WS_WPOOL = 26 * MiB, WS_SS = 27 * MiB;
constexpr size_t WS_XN = 32 * MiB, WS_PROJ = 66 * MiB, WS_ACMP = 200 * MiB, WS_HID = 470 * MiB, WS_COMPS = 490 * MiB, WS_COMPP = 500 * MiB;
constexpr size_t WS_MIX = 502 * MiB, WS_H = 536 * MiB, WS_HB = 602 * MiB, WS_ACT = 636 * MiB, WS_END = 768 * MiB;
static_assert(WS_XN + (size_t)MTOK * DM * 2 <= WS_PROJ && WS_PROJ + (size_t)MTOK * PW * 4 <= WS_ACMP && WS_ACMP + (size_t)CMP_ROWS * 4096 * 2 <= WS_HID, "ws map 1");
static_assert(WS_HID + (size_t)CMP_ROWS * 128 * 4 <= WS_COMPS && WS_COMPS + (size_t)32 * NBS * 256 * 4 <= WS_COMPP && WS_COMPP + (size_t)4 * NBP * 256 * 4 <= WS_MIX, "ws map 2");
static_assert(WS_MIX + (size_t)MTOK * DM * 2 <= WS_H && WS_H + (size_t)MTOK * DM * 4 <= WS_HB && WS_HB + (size_t)MTOK * DM * 2 <= WS_ACT && WS_ACT + (size_t)MTOK * DFF * 2 <= WS_END, "ws map 3");
constexpr int CW_BAR = 4096, CW_QUEUE = 8192, CW_CMPK = 12288;

constexpr int NWAVES = 8, NTHR = NWAVES * 64;
constexpr int RING_BYTES = 131072, LDSCTL_OFF = 143360, MISC_OFF = LDSCTL_OFF + 320, LDS_BYTES = 147456;
constexpr int NPHASES = 8;

#define GAS __attribute__((address_space(1)))
#define LAS __attribute__((address_space(3)))
typedef unsigned short bf16;
typedef unsigned v4u __attribute__((ext_vector_type(4)));
typedef unsigned v2u __attribute__((ext_vector_type(2)));
typedef float f32x4 __attribute__((ext_vector_type(4)));
#define LDS_WAIT() asm volatile("s_waitcnt lgkmcnt(0)" ::: "memory")
__device__ __forceinline__ unsigned f2bf(float f) { unsigned u = __builtin_bit_cast(unsigned, f); return (u + 0x7fffu + ((u >> 16) & 1u)) >> 16; }
__device__ __forceinline__ unsigned pk2(float lo, float hi) { return f2bf(lo) | (f2bf(hi) << 16); }
__device__ __forceinline__ float wave_sum(float v) {
#pragma unroll
    for (int o = 1; o < 64; o <<= 1) v += __shfl_xor(v, o);
    return v;
}
__device__ __forceinline__ float wave_max(float v) {
#pragma unroll
    for (int o = 1; o < 64; o <<= 1) v = fmaxf(v, __shfl_xor(v, o));
    return v;
}

#define XB_TMO      128
#define XB_XCNT(j)  (256  + 64 * (j))
#define XB_XSUB(j)  (1280 + 64 * (j))
#define XB_XGEN(j)  (2304 + 64 * (j))
#define XB_TOP      3328
#define XB_TOPGEN   3392
#define XCD_BAR_WORDS 3456
#define XB_SPIN_CAP (1u << 18)
__device__ __forceinline__ unsigned xb_ld(unsigned* p)              { return __hip_atomic_load(p, __ATOMIC_RELAXED, __HIP_MEMORY_SCOPE_AGENT); }
__device__ __forceinline__ unsigned xb_add(unsigned* p, unsigned v) { return __hip_atomic_fetch_add(p, v, __ATOMIC_RELAXED, __HIP_MEMORY_SCOPE_AGENT); }
__device__ __forceinline__ unsigned xb_xcc_id() { return (unsigned)__builtin_amdgcn_s_getreg((3 << 11) | 20) & 0xFu; }
#define XB_SPIN(cond, bar) do { unsigned _sp = 0; while (cond) { __builtin_amdgcn_s_sleep(1); \
    if ((++_sp & 255u) == 0u) { if (xb_ld(&(bar)[XB_TMO])) break; if (_sp > XB_SPIN_CAP) { atomicAdd(&(bar)[XB_TMO], 1u); break; } } } } while (0)
struct XcdBarrier { unsigned* bar; unsigned x; volatile LAS unsigned* st; };
__device__ __forceinline__ XcdBarrier xcd_barrier_post(unsigned* bar, volatile LAS unsigned* st) {
    XcdBarrier b; b.bar = bar; b.x = xb_xcc_id(); b.st = st;
    if (threadIdx.x == 0) (void)xb_add(&bar[XB_XCNT(b.x)], 1u);
    return b;
}
__device__ __forceinline__ void xcd_barrier_complete(unsigned* bar, unsigned x, unsigned& nloc, unsigned& nx) {
    const unsigned G = gridDim.x * gridDim.y * gridDim.z;
    unsigned sum, cnt, mine, sp = 0u;
    for (;;) {
        sum = 0u; cnt = 0u; mine = 0u;
#pragma unroll
        for (unsigned j = 0; j < 16; ++j) { const unsigned c = xb_ld(&bar[XB_XCNT(j)]); sum += c; cnt += (c > 0u) ? 1u : 0u; mine = (j == x) ? c : mine; }
        if (sum == G) break;
        __builtin_amdgcn_s_sleep(1);
        if ((++sp & 255u) == 0u) { if (xb_ld(&bar[XB_TMO])) break; if (sp > XB_SPIN_CAP) { atomicAdd(&bar[XB_TMO], 1u); break; } }
    }
    nloc = mine > 0u ? mine : 1u; nx = cnt > 0u ? cnt : 1u;
}
__device__ __forceinline__ void xcd_barrier(const XcdBarrier& b) {
    asm volatile("s_waitcnt vmcnt(0)" ::: "memory");
    __syncthreads();
    if (threadIdx.x == 0) {
        unsigned* bar = b.bar;
        __builtin_amdgcn_s_waitcnt(0);
        unsigned nloc = b.st[0], nx = b.st[1];
        if (nloc == 0u) { xcd_barrier_complete(bar, b.x, nloc, nx); b.st[0] = nloc; b.st[1] = nx; }
        const unsigned old = xb_add(&bar[XB_XSUB(b.x)], 1u);
        const unsigned gen = old / nloc;
        if (old + 1u == (gen + 1u) * nloc) {
            __builtin_amdgcn_fence(__ATOMIC_RELEASE, "agent");
            asm volatile("s_waitcnt vmcnt(0)" ::: "memory");
            const unsigned og = xb_add(&bar[XB_TOP], 1u);
            const unsigned tg = og / nx;
            if (og + 1u == (tg + 1u) * nx) xb_add(&bar[XB_TOPGEN], 1u);
            else XB_SPIN(xb_ld(&bar[XB_TOPGEN]) == tg, bar);
            __builtin_amdgcn_fence(__ATOMIC_ACQUIRE, "agent");
            xb_add(&bar[XB_XGEN(b.x)], 1u);
            asm volatile("s_waitcnt vmcnt(0)" ::: "memory");
        } else {
            XB_SPIN(xb_ld(&bar[XB_XGEN(b.x)]) == gen, bar);
            __builtin_amdgcn_fence(__ATOMIC_ACQUIRE, "agent");
            asm volatile("s_waitcnt vmcnt(0)" ::: "memory");
        }
    }
    __syncthreads();
}

struct Args { const float* in[19]; float* out; unsigned char* ws; int ph_lo, ph_hi; };
struct Frame {
    LAS unsigned char* lds;
    int tid, lane, wave, G, bid;
};

template <int MAP>
__device__ __forceinline__ void p0_transpose_item(const float* W, int K, int ldw, int nblk, bf16* WT, int row_off, LAS float* scr, int item, int lane) {
    const int kb = item / nblk, nb = item % nblk, k0 = 64 * kb, n0 = 32 * nb;
    const int nd = n0 + (lane & 31);
    int sc = nd;
    if (MAP == 1) { if (nd < 1280) sc = nd; else if (nd < 1792) sc = nd + 24; else if (nd < 1816) sc = nd - 512; else sc = -1; }
#pragma unroll 8
    for (int i = 0; i < 32; ++i) { const int kk = 2 * i + (lane >> 5); scr[kk * 33 + (lane & 31)] = (sc >= 0) ? W[(size_t)(k0 + kk) * ldw + sc] : 0.f; }
    LDS_WAIT(); asm volatile("" ::: "memory");
    const int c = lane & 7;
#pragma unroll
    for (int j = 0; j < 4; ++j) { const int n = (lane >> 3) + 8 * j; const LAS float* s = scr + (8 * c) * 33 + n;
        v4u o; o.x = pk2(s[0 * 33], s[1 * 33]); o.y = pk2(s[2 * 33], s[3 * 33]); o.z = pk2(s[4 * 33], s[5 * 33]); o.w = pk2(s[6 * 33], s[7 * 33]);
        *(v4u*)(WT + (size_t)(row_off + n0 + n) * K + k0 + 8 * c) = o; }
    LDS_WAIT(); asm volatile("" ::: "memory");
}
__device__ __forceinline__ void rms_row_to_bf16(const float* xrow, const float* g, bf16* orow, int lane) {
    const f32x4* xr = (const f32x4*)xrow + lane; const f32x4* gr = (const f32x4*)g + lane;
    f32x4 v[4]; float s = 0.f;
#pragma unroll
    for (int j = 0; j < 4; ++j) { v[j] = xr[64 * j]; s += (v[j].x * v[j].x + v[j].y * v[j].y) + (v[j].z * v[j].z + v[j].w * v[j].w); }
    const float rstd = 1.0f / sqrtf(wave_sum(s) * (1.f / DM) + 1e-6f);
    unsigned long long* o8 = (unsigned long long*)orow + lane;
#pragma unroll
    for (int j = 0; j < 4; ++j) { const f32x4 gg = gr[64 * j];
        o8[64 * j] = (unsigned long long)pk2(v[j].x * rstd * gg.x, v[j].y * rstd * gg.y) | ((unsigned long long)pk2(v[j].z * rstd * gg.z, v[j].w * rstd * gg.w) << 32); }
}

__device__ __forceinline__ void p0_prologue(const Frame& F, const Args& A) {
    LAS float* scr = (LAS float*)(F.lds + F.wave * 16384);
    const int gw = F.bid * NWAVES + F.wave, NGW = F.G * NWAVES;
    constexpr int I_IN = (DM / 64) * (PW / 32), I_OUT = (DM / 64) * (DM / 32), I_UP = (DM / 64) * (DFF / 32), I_DN = (DFF / 64) * (DM / 32), I_W1 = (4096 / 64) * (128 / 32);
    constexpr int I_WP = 32;
    constexpr int NITEMS = I_IN + I_OUT + I_UP + I_DN + 2 * I_W1 + I_WP;
    for (int it = gw; it < NITEMS; it += NGW) {
        int r = it;
        if (r < I_IN) { p0_transpose_item<1>(A.in[8], DM, 1816, PW / 32, ((bf16*)(A.ws + WS_WIN)), 0, scr, r, F.lane); continue; } r -= I_IN;
        if (r < I_OUT) { p0_transpose_item<0>(A.in[14], DM, DM, DM / 32, ((bf16*)(A.ws + WS_WOUT)), 0, scr, r, F.lane); continue; } r -= I_OUT;
        if (r < I_UP) { p0_transpose_item<0>(A.in[16], DM, DFF, DFF / 32, ((bf16*)(A.ws + WS_WUP)), 0, scr, r, F.lane); continue; } r -= I_UP;
        if (r < I_DN) { p0_transpose_item<0>(A.in[17], DFF, DM, DM / 32, ((bf16*)(A.ws + WS_WDN)), 0, scr, r, F.lane); continue; } r -= I_DN;
        if (r < I_W1) { p0_transpose_item<0>(A.in[10], 4096, 128, 4, ((bf16*)(A.ws + WS_W1S)), 0, scr, r, F.lane); continue; } r -= I_W1;
        if (r < I_W1) { p0_transpose_item<0>(A.in[10] + (size_t)4096 * 128, 4096, 128, 4, ((bf16*)(A.ws + WS_W1S)), 128, scr, r, F.lane); continue; } r -= I_W1;
        p0_transpose_item<0>(A.in[12] + (size_t)(r >> 3) * 16384, 128, 128, 4, ((bf16*)(A.ws + WS_WPOOL)), (r >> 3) * 128, scr, r & 7, F.lane);
    }
    for (int m = gw; m < MTOK; m += NGW) {
        const float* xr = m < NPR ? A.in[0] + (size_t)m * DM : A.in[1] + (size_t)(m - NPR) * DM;
        rms_row_to_bf16(xr, A.in[7], ((bf16*)(A.ws + WS_XN)) + (size_t)m * DM, F.lane);
    }
}

__device__ __forceinline__ void p2_copies(const Frame& F, const Args& A, int vbid, int vG) {
    const size_t gt = (size_t)vbid * NTHR + F.tid, NT = (size_t)vG * NTHR;
    const f32x4* P4 = (const f32x4*)((float*)(A.ws + WS_PROJ));
    f32x4* O4 = (f32x4*)A.out;
    for (size_t i = gt; i < (size_t)NPR * 64; i += NT) { const size_t r = i >> 6, c = i & 63;
        O4[O_PCMP / 4 + i] = P4[r * 512 + C_KC / 4 + c]; O4[O_PSLC / 4 + i] = P4[r * 512 + C_KS / 4 + c]; }
    for (size_t i = gt; i < (size_t)4 * 512 * 64; i += NT) { const size_t c = i & 63, r = (i >> 6) & 511, b = i >> 15;
        O4[O_PWIN / 4 + i] = P4[(b * SEQ + SEQ - 512 + r) * 512 + C_KW / 4 + c]; }
    for (size_t i = gt; i < (size_t)4 * 15 * 128; i += NT) { const size_t c = i & 127, r = (i >> 7) % 15, b = (i >> 7) / 15;
        O4[O_PPOOL / 4 + i] = P4[(b * SEQ + SEQ - 15 + r) * 512 + C_U / 4 + c]; }
    for (size_t i = gt; i < (size_t)NSM * 64; i += NT) { const size_t r = i >> 6, c = i & 63;
        O4[O_SCMP / 4 + i] = P4[(NPR + r) * 512 + C_KC / 4 + c]; O4[O_SSLC / 4 + i] = P4[(NPR + r) * 512 + C_KS / 4 + c]; }
    const f32x4* SW4 = (const f32x4*)A.in[4];
    for (size_t i = gt; i < (size_t)32 * 512 * 64; i += NT) { const size_t c = i & 63, r = (i >> 6) & 511, b = i >> 15;
        O4[O_SWIN / 4 + i] = (r < 504) ? SW4[(b * 512 + r + 8) * 64 + c] : P4[(NPR + b * 8 + (r - 504)) * 512 + C_KW / 4 + c]; }
    const f32x4* SP4 = (const f32x4*)A.in[5];
    for (size_t i = gt; i < (size_t)32 * 15 * 128; i += NT) { const size_t c = i & 127, r = (i >> 7) % 15, b = (i >> 7) / 15;
        O4[O_SPOOL / 4 + i] = (r < 7) ? SP4[(b * 15 + r + 8) * 128 + c] : P4[(NPR + b * 8 + (r - 7)) * 512 + C_U / 4 + c]; }
}
__device__ __forceinline__ void p2_cmp_gather(const Frame& F, const Args& A) {
    const int gw = F.bid * NWAVES + F.wave, NGW = F.G * NWAVES;
    constexpr int NBLK = 8192 + 256 + 32;
    const int lane = F.lane, gc = lane >> 4, g = gc >> 1, c = gc & 1, d0 = (lane & 15) * 4;
    for (int it = gw; it < NBLK * 64; it += NGW) {
        const int blk = it >> 6, l = it & 63;
        f32x4 v; int rsec;
        if (blk < 8192) { const int b = blk >> 8, n = blk & 255; const int page = ((const int*)A.in[6])[b * NPG + (n >> 1)];
            v = *(const f32x4*)(A.in[2] + ((size_t)page * 128 + (n & 1) * 64 + l) * 256 + lane * 4); rsec = (b * 256 + n) * 2 + g; }
        else if (blk < 8192 + 256) { const int q = blk - 8192, b = q >> 6, n = q & 63;
            v = *(const f32x4*)(((float*)(A.ws + WS_PROJ)) + ((size_t)b * SEQ + n * 64 + l) * PW + C_KC + lane * 4); rsec = CMP_R_PROMPT + (b * 64 + n) * 2 + g; }
        else { const int b = blk - 8192 - 256;
            v = (l < 8) ? *(const f32x4*)(((float*)(A.ws + WS_PROJ)) + ((size_t)NPR + b * 8 + l) * PW + C_KC + lane * 4) : (f32x4){0.f, 0.f, 0.f, 0.f}; rsec = CMP_R_NEW + b * 2 + g; }
        const f32x4 pe = *(const f32x4*)(A.in[9] + (l * 2 + c) * 64 + d0);
        v = v + pe;
        v2u o; o.x = pk2(v.x, v.y); o.y = pk2(v.z, v.w);
        *(v2u*)(((bf16*)(A.ws + WS_ACMP)) + ((size_t)c * CMP_SEC + rsec) * 4096 + l * 64 + d0) = o;
    }
}
__device__ __forceinline__ void p2_pool(const Frame& F, const Args& A) {
    LAS float* wl = (LAS float*)F.lds;
    LAS float* dl = (LAS float*)(F.lds + 65536 + F.wave * 2048);
    constexpr int NCH = MTOK / 32;
    const int lane = F.lane;
    for (int unit = F.bid; unit < 4 * NCH; unit += F.G) {
        const int gi = unit / NCH, ch = unit % NCH, w = 2 << gi;
        __syncthreads();
        for (int i = F.tid; i < 128 * 128 / 4; i += NTHR) ((LAS f32x4*)wl)[i] = ((const f32x4*)(A.in[12] + (size_t)gi * 16384))[i];
        const int tok0 = ch * 32 + F.wave * 4;
#pragma unroll
        for (int tk = 0; tk < 4; ++tk) {
            const int row = tok0 + tk;
#pragma unroll
            for (int hh = 0; hh < 2; ++hh) {
                const int cc = gi * 128 + lane + 64 * hh;
                float own, sum = 0.f, cnt;
                if (row < NPR) { const int t = row & (SEQ - 1);
                    own = ((float*)(A.ws + WS_PROJ))[(size_t)row * PW + C_U + cc];
                    for (int j = 0; j < w; ++j) if (t - j >= 0) sum += ((float*)(A.ws + WS_PROJ))[(size_t)(row - j) * PW + C_U + cc];
                    cnt = (float)((t + 1 < w) ? t + 1 : w);
                } else { const int q = row - NPR, b = q >> 3, i = q & 7;
                    own = ((float*)(A.ws + WS_PROJ))[(size_t)row * PW + C_U + cc];
                    for (int j = 0; j < w; ++j) { const int idx = 15 + i - j;
                        sum += (idx >= 15) ? ((float*)(A.ws + WS_PROJ))[(size_t)(NPR + b * 8 + idx - 15) * PW + C_U + cc] : A.in[5][((size_t)b * 15 + idx) * 512 + cc]; }
                    cnt = (float)w;
                }
                dl[(lane + 64 * hh) * 4 + tk] = sum / cnt - own;
            }
        }
        __syncthreads();
        float acc[4][2];
#pragma unroll
        for (int tk = 0; tk < 4; ++tk) { acc[tk][0] = 0.f; acc[tk][1] = 0.f; }
#pragma unroll 4
        for (int c = 0; c < 128; ++c) {
            const f32x4 dv = *(const LAS f32x4*)(dl + c * 4);
            const float w0 = wl[c * 128 + lane], w1 = wl[c * 128 + lane + 64];
            acc[0][0] += dv.x * w0; acc[0][1] += dv.x * w1; acc[1][0] += dv.y * w0; acc[1][1] += dv.y * w1;
            acc[2][0] += dv.z * w0; acc[2][1] += dv.z * w1; acc[3][0] += dv.w * w0; acc[3][1] += dv.w * w1;
        }
        const float s0 = A.in[13][gi * 128 + lane], s1 = A.in[13][gi * 128 + lane + 64];
#pragma unroll
        for (int tk = 0; tk < 4; ++tk) { bf16* o = ((bf16*)(A.ws + WS_MIX)) + (size_t)(tok0 + tk) * DM + 512 + gi * 128;
            o[lane] = (bf16)f2bf(acc[tk][0] * s0); o[lane + 64] = (bf16)f2bf(acc[tk][1] * s1); }
    }
    __syncthreads();
}

__device__ __forceinline__ void p4_cmp_w2(const Frame& F, const Args& A) {
    LAS float* w2l = (LAS float*)F.lds;
    LAS float* hl = (LAS float*)(F.lds + 65536 + F.wave * 512);
    for (int i = F.tid; i < 2 * 128 * 64 / 4; i += NTHR) ((LAS f32x4*)w2l)[i] = ((const f32x4*)A.in[11])[i];
    __syncthreads();
    const int gw = F.bid * NWAVES + F.wave, NGW = F.G * NWAVES, lane = F.lane;
    for (int it = gw; it < 2 * CMP_R_END; it += NGW) {
        const int c = it / CMP_R_END, r = it % CMP_R_END;
        const float* hrow = ((float*)(A.ws + WS_HID)) + ((size_t)c * CMP_SEC + r) * 128;
        hl[lane] = hrow[lane]; hl[lane + 64] = hrow[lane + 64];
        LDS_WAIT(); asm volatile("" ::: "memory");
        float a = 0.f;
#pragma unroll 8
        for (int h = 0; h < 128; ++h) a += hl[h] * w2l[(c * 128 + h) * 64 + lane];
        float* dst;
        if (r < CMP_R_PROMPT) { const int b = r >> 9, n = (r & 511) >> 1, g = r & 1; dst = ((float*)(A.ws + WS_COMPS)) + ((((size_t)b * NBS + n) * 2 + g) * 2 + c) * 64; }
        else if (r < CMP_R_NEW) { const int q = r - CMP_R_PROMPT, b = q >> 7, n = (q & 127) >> 1, g = q & 1; dst = ((float*)(A.ws + WS_COMPP)) + ((((size_t)b * NBP + n) * 2 + g) * 2 + c) * 64; }
        else { const int q = r - CMP_R_NEW, b = q >> 1, g = q & 1; dst = ((float*)(A.ws + WS_COMPS)) + ((((size_t)b * NBS + 256) * 2 + g) * 2 + c) * 64; }
        dst[lane] = a;
        LDS_WAIT(); asm volatile("" ::: "memory");
    }
    __syncthreads();
}

namespace att {
typedef short bf16x8 __attribute__((ext_vector_type(8)));
typedef short s16x4 __attribute__((ext_vector_type(4)));
typedef float f32x16 __attribute__((ext_vector_type(16)));
typedef float f32x2 __attribute__((ext_vector_type(2)));
typedef __bf16 bf16x2v __attribute__((ext_vector_type(2)));
constexpr int KP = 144, VP = 192, BUFB = 64 * KP + 64 * VP;
constexpr int AT_T = 2 * BUFB, T_WAVE = 8704, AT_ML = AT_T + 8 * T_WAVE, AT_SEL = AT_ML + 2048, AT_UNI = AT_SEL + 4096, AT_TILES = AT_UNI + 64, AT_MISC = AT_TILES + 4608, AT_KAUG = AT_MISC + 64, AT_END = AT_KAUG + 2048;
static_assert(AT_END <= LDSCTL_OFF, "attention LDS map");
constexpr int NUNITS = 576;
struct TileEnt { unsigned long long base; int pitch, kpos0, kind, blk, nrows, n0; };
static_assert(sizeof(TileEnt) == 32, "TileEnt");
__device__ __forceinline__ unsigned cvtpk(float lo, float hi) { f32x2 a = {lo, hi}; return __builtin_bit_cast(unsigned, __builtin_convertvector(a, bf16x2v)); }
__device__ __forceinline__ unsigned okey(float x) { const unsigned u = __builtin_bit_cast(unsigned, x); return (u & 0x80000000u) ? ~u : (u | 0x80000000u); }
#define ATT_KR(r) (((r) & 3) + 8 * ((r) >> 2))
#define ATT_MFMA(a, b, c) __builtin_amdgcn_mfma_f32_32x32x16_bf16((a), (b), (c), 0, 0, 0)

template <int VAR>
__device__ __forceinline__ void attn_phase(const Frame& F, const Args& A, int qslot) {
#if defined(__HIP_DEVICE_COMPILE__)
    LAS unsigned char* L = F.lds;
    const int tid = F.tid, lane = F.lane, wave = F.wave;
    const int r32 = lane & 31, h = lane >> 5, tl = r32 >> 2, p = r32 & 3;
    unsigned* qctr = (unsigned*)(A.ws + WS_CTL) + CW_QUEUE + 512 * qslot;
    const int myq = (int)(xb_xcc_id() & 7u);
    const float* PROJ = (const float*)(A.ws + WS_PROJ);
    LAS TileEnt* TILES = (LAS TileEnt*)(L + AT_TILES);
    volatile LAS int* MISC = (volatile LAS int*)(L + AT_MISC);
    LAS unsigned long long* UNI = (LAS unsigned long long*)(L + AT_UNI);
    LAS unsigned long long* SEL = (LAS unsigned long long*)(L + AT_SEL);
    LAS float* ML = (LAS float*)(L + AT_ML);
    constexpr float LOG2E = 1.4426950408889634f;
    if (tid < 64) { v4u z = {0u, 0u, 0u, 0u}; v4u w0 = z; w0.x = f2bf((float)tid); *(LAS v4u*)(L + AT_KAUG + tid * 32) = w0; *(LAS v4u*)(L + AT_KAUG + tid * 32 + 16) = z; }
    for (;;) {
        __syncthreads();
        if (tid == 0) {
            int unit = NUNITS;
            for (int k = 0; k < 8; ++k) { const int qi = (myq + k) & 7;
                if (__hip_atomic_load(qctr + 64 * qi, __ATOMIC_RELAXED, __HIP_MEMORY_SCOPE_AGENT) >= 72u) continue;
                const unsigned u = __hip_atomic_fetch_add(qctr + 64 * qi, 1u, __ATOMIC_RELAXED, __HIP_MEMORY_SCOPE_AGENT);
                if (u < 72u) { unit = (u < 8u) ? (qi * 8 + (int)u) : (64 + ((int)u - 8) * 8 + qi); break; } }
            MISC[0] = unit;
            for (int c = 0; c < 8; ++c) UNI[c] = 0ull;
        }
        __syncthreads();
        const int unit = MISC[0];
        if (unit >= NUNITS) break;
        const bool is_s = unit < 64;
        int b, g, qt;
        if (is_s) { b = unit >> 1; g = unit & 1; qt = 256; } else { const int u2 = unit - 64, rem = u2 & 7; qt = 63 - (u2 >> 3); b = rem >> 1; g = rem & 1; }
        const bool active = is_s ? (wave == 0) : true;
        const int cur = qt;
        const int tokrow = is_s ? (NPR + b * 8 + tl) : (b * SEQ + qt * 64 + wave * 8 + tl);
        const int qpos = is_s ? (PAST + tl) : (qt * 64 + wave * 8 + tl);
        const int mytok = is_s ? tl : (wave * 8 + tl);
        const int ncmp = is_s ? 4 : 1;
        const int nwin = is_s ? 9 : (qt < 8 ? qt + 1 : 9);
        const int TP = is_s ? 264 : 68;
        LAS float* Tm = (LAS float*)(L + AT_T + (is_s ? 0 : wave * T_WAVE));
        if (wave == 0 && lane < ncmp + nwin) {
            TileEnt e; e.blk = 0; e.n0 = 0; e.kpos0 = 0; e.nrows = 64; e.pitch = 256;
            if (lane < ncmp) { e.kind = 0; e.n0 = 64 * lane;
                e.base = is_s ? (unsigned long long)((const float*)(A.ws + WS_COMPS) + (((size_t)b * NBS + 64 * lane) * 2 + g) * 128) : (unsigned long long)((const float*)(A.ws + WS_COMPP) + (((size_t)b * NBP) * 2 + g) * 128); }
            else { const int w = lane - ncmp; e.kind = 2;
                if (!is_s) { const int tw = qt - w; e.kpos0 = tw * 64; e.base = (unsigned long long)(PROJ + ((size_t)b * SEQ + tw * 64) * PW + C_KW + g * 128); e.pitch = PW; }
                else if (w == 0) { e.kpos0 = PAST; e.base = (unsigned long long)(PROJ + ((size_t)NPR + b * 8) * PW + C_KW + g * 128); e.pitch = PW; e.nrows = 8; }
                else { const int ti = 8 - w; e.kpos0 = PAST - 512 + ti * 64; e.base = (unsigned long long)(A.in[4] + ((size_t)b * 512 + ti * 64) * 256 + g * 128); } }
            TILES[lane] = e;
        }
        bf16x8 Q[4];
        float gate0 = 0.f, gate1 = 0.f, gate2 = 0.f;
        const float slope = exp2f(-(float)(g * 4 + p + 1));
        if (active) {
            const float* prow = PROJ + (size_t)tokrow * PW;
            const float qs = 0.125f;
#pragma unroll
            for (int ks = 0; ks < 4; ++ks) { const f32x4 a = *(const f32x4*)(prow + C_Q + g * 256 + p * 64 + 16 * ks + 8 * h), c = *(const f32x4*)(prow + C_Q + g * 256 + p * 64 + 16 * ks + 8 * h + 4);
                v4u w; w.x = cvtpk(a.x * qs, a.y * qs); w.y = cvtpk(a.z * qs, a.w * qs); w.z = cvtpk(c.x * qs, c.y * qs); w.w = cvtpk(c.z * qs, c.w * qs);
                Q[ks] = __builtin_bit_cast(bf16x8, w); }
            gate0 = 1.0f / (1.0f + __expf(-prow[C_G + 0 + g * 4 + p])); gate1 = 1.0f / (1.0f + __expf(-prow[C_G + 8 + g * 4 + p])); gate2 = 1.0f / (1.0f + __expf(-prow[C_G + 16 + g * 4 + p]));
        } else {
#pragma unroll
            for (int ks = 0; ks < 4; ++ks) Q[ks] = (bf16x8){0, 0, 0, 0, 0, 0, 0, 0};
        }
        f32x16 O0, O1;
#pragma unroll
        for (int i = 0; i < 16; ++i) { O0[i] = 0.f; O1[i] = 0.f; }
        LAS f32x4* PA = (LAS f32x4*)(L + AT_T + (is_s ? 0 : wave * T_WAVE));
        float sc_c = 0.f;
#define ATT_CLOSE(scv, FIRST) do { _Pragma("unroll") for (int q4_ = 0; q4_ < 4; ++q4_) { \
            f32x4 a_ = (f32x4){O0[4 * q4_], O0[4 * q4_ + 1], O0[4 * q4_ + 2], O0[4 * q4_ + 3]} * (scv), b_ = (f32x4){O1[4 * q4_], O1[4 * q4_ + 1], O1[4 * q4_ + 2], O1[4 * q4_ + 3]} * (scv); \
            if (!(FIRST)) { a_ += PA[q4_ * 64 + lane]; b_ += PA[(4 + q4_) * 64 + lane]; } \
            PA[q4_ * 64 + lane] = a_; PA[(4 + q4_) * 64 + lane] = b_; } \
            _Pragma("unroll") for (int r_ = 0; r_ < 16; ++r_) { O0[r_] = 0.f; O1[r_] = 0.f; } } while (0)
        float m_run = -1e20f, l_run = 0.f;
        int curkind = 0;
        int ntiles = ncmp + nwin;
        f32x4 R0 = {0.f, 0.f, 0.f, 0.f}, R1 = R0, R2 = R0, R3 = R0;
#define ATT_LOAD(idx) do { if ((VAR == 2 || VAR == 3) && (idx) >= ncmp) break; const TileEnt e_ = TILES[(idx)]; const GAS float* bp_ = (const GAS float*)e_.base; const int nr_ = e_.nrows - 1; \
            { const int f_ = tid;        int row_ = f_ >> 5; row_ = row_ < nr_ ? row_ : nr_; R0 = *(const GAS f32x4*)(bp_ + (size_t)row_ * e_.pitch + (f_ & 31) * 4); } \
            { const int f_ = tid + 512;  int row_ = f_ >> 5; row_ = row_ < nr_ ? row_ : nr_; R1 = *(const GAS f32x4*)(bp_ + (size_t)row_ * e_.pitch + (f_ & 31) * 4); } \
            { const int f_ = tid + 1024; int row_ = f_ >> 5; row_ = row_ < nr_ ? row_ : nr_; R2 = *(const GAS f32x4*)(bp_ + (size_t)row_ * e_.pitch + (f_ & 31) * 4); } \
            { const int f_ = tid + 1536; int row_ = f_ >> 5; row_ = row_ < nr_ ? row_ : nr_; R3 = *(const GAS f32x4*)(bp_ + (size_t)row_ * e_.pitch + (f_ & 31) * 4); } } while (0)
#define ATT_ST1(buf, f_, Rv) do { const int row_ = (f_) >> 5, c4_ = (f_) & 31; v2u o_; o_.x = cvtpk(Rv.x, Rv.y); o_.y = cvtpk(Rv.z, Rv.w); \
            const int off_ = (buf) * BUFB + (c4_ < 16 ? row_ * KP + c4_ * 8 : 64 * KP + row_ * VP + (c4_ - 16) * 8); *(LAS v2u*)(L + off_) = o_; } while (0)
#define ATT_STORE(buf) do { ATT_ST1(buf, tid, R0); ATT_ST1(buf, tid + 512, R1); ATT_ST1(buf, tid + 1024, R2); ATT_ST1(buf, tid + 1536, R3); } while (0)
        __syncthreads();
        ATT_LOAD(0); ATT_STORE(0);
        __syncthreads();
        for (int i = 0; i < ntiles; ++i) {
            const int buf = i & 1;
            const bool has_next = (i + 1 < ntiles);
            if (has_next) ATT_LOAD(i + 1);
            if (active && ((VAR != 1 && VAR != 3) || i < ncmp)) {
                const TileEnt e = TILES[i];
                const int kind = __builtin_amdgcn_readfirstlane(e.kind), kpos0 = __builtin_amdgcn_readfirstlane(e.kpos0), blk = __builtin_amdgcn_readfirstlane(e.blk), n0 = __builtin_amdgcn_readfirstlane(e.n0);
                if (kind != curkind) {
                    if (curkind != 0) { const float sc = gate2 / fmaxf(l_run, 1e-30f); ATT_CLOSE(sc, false); m_run = -1e20f; l_run = 0.f; }
                    curkind = kind;
                }
                int dq_hi, dq_lo = -1; float rowc;
                if (kind == 0) { dq_hi = (qpos - 63 - 64 * n0) >> 6; rowc = slope * (float)(64 * n0 + 63 - qpos); }
                else if (kind == 1) { const unsigned long long w = SEL[mytok * 8 + (blk >> 6)]; const bool sb = (w >> (blk & 63)) & 1ull; dq_hi = sb ? (qpos - kpos0) : -1; rowc = slope * (float)(kpos0 - qpos); }
                else { dq_hi = qpos - kpos0; dq_lo = qpos - 512 - kpos0; rowc = slope * (float)(kpos0 - qpos); }
                const bool lane_any = (dq_hi >= 0) && (dq_lo < 63);
                if (kind == 0 || __any(lane_any)) {
                    const LAS unsigned char* Kb = L + buf * BUFB; const LAS unsigned char* Vb = Kb + 64 * KP;
                    f32x16 X0, X1;
#pragma unroll
                    for (int r = 0; r < 16; ++r) { X0[r] = 0.f; X1[r] = 0.f; }
#pragma unroll
                    for (int ks = 0; ks < 4; ++ks) {
                        const bf16x8 a0 = *(const LAS bf16x8*)(Kb + r32 * KP + (16 * ks + 8 * h) * 2);
                        const bf16x8 a1 = *(const LAS bf16x8*)(Kb + (32 + r32) * KP + (16 * ks + 8 * h) * 2);
                        X0 = ATT_MFMA(a0, Q[ks], X0); X1 = ATT_MFMA(a1, Q[ks], X1);
                    }
                    { v4u qa = {0u, 0u, 0u, 0u}; if (h == 0) qa.x = f2bf(kind == 0 ? slope * 64.f : slope);
                      const bf16x8 Qaug = __builtin_bit_cast(bf16x8, qa);
                      const bf16x8 ka0 = *(const LAS bf16x8*)(L + AT_KAUG + r32 * 32 + 16 * h), ka1 = *(const LAS bf16x8*)(L + AT_KAUG + (32 + r32) * 32 + 16 * h);
                      X0 = ATT_MFMA(ka0, Qaug, X0); X1 = ATT_MFMA(ka1, Qaug, X1); }
                    const float c0 = lane_any ? rowc * LOG2E : -1e30f;
#pragma unroll
                    for (int r = 0; r < 16; ++r) { X0[r] = fmaf(X0[r], LOG2E, c0); X1[r] = fmaf(X1[r], LOG2E, c0); }
                    const bool lane_edge = lane_any && !((dq_hi >= 63) && (dq_lo < 0));
                    if (__any(lane_edge)) {
                        const int hi2 = dq_hi - 4 * h, lo2 = dq_lo - 4 * h;
#pragma unroll
                        for (int r = 0; r < 16; ++r) { const int k0 = ATT_KR(r), k1 = 32 + ATT_KR(r);
                            X0[r] = (k0 <= hi2 && k0 > lo2) ? X0[r] : -1e30f; X1[r] = (k1 <= hi2 && k1 > lo2) ? X1[r] : -1e30f; }
                    }
                    if (kind == 0) {
#pragma unroll
                        for (int q4 = 0; q4 < 4; ++q4) {
                            *(LAS f32x4*)(Tm + r32 * TP + n0 + 8 * q4 + 4 * h) = (f32x4){X0[4 * q4], X0[4 * q4 + 1], X0[4 * q4 + 2], X0[4 * q4 + 3]};
                            *(LAS f32x4*)(Tm + r32 * TP + n0 + 32 + 8 * q4 + 4 * h) = (f32x4){X1[4 * q4], X1[4 * q4 + 1], X1[4 * q4 + 2], X1[4 * q4 + 3]}; }
                    }
                    float mx = -1e30f;
#pragma unroll
                    for (int r = 0; r < 16; r += 2) mx = fmaxf(fmaxf(mx, fmaxf(X0[r], X0[r + 1])), fmaxf(X1[r], X1[r + 1]));
                    mx = fmaxf(mx, __shfl_xor(mx, 32));
                    const float m_new = fmaxf(m_run, mx);
                    if (__any(m_new > m_run)) {
                        const float alpha = __builtin_amdgcn_exp2f(m_run - m_new);
#pragma unroll
                        for (int r = 0; r < 16; ++r) { O0[r] *= alpha; O1[r] *= alpha; }
                        l_run *= alpha; m_run = m_new;
                    }
                    float ls = 0.f;
#pragma unroll
                    for (int r = 0; r < 16; ++r) { X0[r] = __builtin_amdgcn_exp2f(X0[r] - m_run); X1[r] = __builtin_amdgcn_exp2f(X1[r] - m_run); ls += X0[r] + X1[r]; }
                    ls += __shfl_xor(ls, 32);
                    l_run += ls;
#pragma unroll
                    for (int kt = 0; kt < 2; ++kt) {
#pragma unroll
                        for (int s = 0; s < 2; ++s) {
                            v4u pw;
                            if (kt == 0) { pw.x = cvtpk(X0[8 * s], X0[8 * s + 1]); pw.y = cvtpk(X0[8 * s + 2], X0[8 * s + 3]); pw.z = cvtpk(X0[8 * s + 4], X0[8 * s + 5]); pw.w = cvtpk(X0[8 * s + 6], X0[8 * s + 7]); }
                            else         { pw.x = cvtpk(X1[8 * s], X1[8 * s + 1]); pw.y = cvtpk(X1[8 * s + 2], X1[8 * s + 3]); pw.z = cvtpk(X1[8 * s + 4], X1[8 * s + 5]); pw.w = cvtpk(X1[8 * s + 6], X1[8 * s + 7]); }
                            const bf16x8 pf = __builtin_bit_cast(bf16x8, pw);
                            const int key0 = kt * 32 + 16 * s + 4 * h, i16 = lane & 15, q = i16 >> 2, pp = i16 & 3, blk16 = (lane >> 4) & 1;
#pragma unroll
                            for (int dt = 0; dt < 2; ++dt) {
                                const LAS unsigned char* va = Vb + (key0 + q) * VP + (dt * 32 + 16 * blk16 + 4 * pp) * 2;
                                const s16x4 lo = __builtin_amdgcn_ds_read_tr16_b64_v4i16((LAS s16x4*)va);
                                const s16x4 hi = __builtin_amdgcn_ds_read_tr16_b64_v4i16((LAS s16x4*)(va + 8 * VP));
                                const bf16x8 vf = __builtin_shufflevector(lo, hi, 0, 1, 2, 3, 4, 5, 6, 7);
                                if (dt == 0) O0 = ATT_MFMA(vf, pf, O0); else O1 = ATT_MFMA(vf, pf, O1);
                            }
                        }
                    }
                }
                if (i + 1 == ncmp) {
                    const float il = 1.0f / fmaxf(l_run, 1e-30f); sc_c = gate0 * il;
                    if (h == 0) { ML[(wave * 32 + r32) * 2] = m_run; ML[(wave * 32 + r32) * 2 + 1] = il; }
                    m_run = -1e20f; l_run = 0.f;
                }
            }
            if (has_next) ATT_STORE(buf ^ 1);
            __syncthreads();
            if (i + 1 == ncmp) {
                if (!is_s) {
                    const LAS float* Tw = (const LAS float*)(L + AT_T + wave * T_WAVE);
                    for (int k = 0; k < 8; ++k) { const int tok = wave * 8 + k, n = lane; float imp = 0.f;
#pragma unroll
                        for (int pq = 0; pq < 4; ++pq) { const int row = k * 4 + pq; imp += __builtin_amdgcn_exp2f(Tw[row * 68 + n] - ML[(wave * 32 + row) * 2]) * ML[(wave * 32 + row) * 2 + 1]; }
                        float s = imp; if (n == 0 || n == cur || n == cur - 1) s = 5.0f; if (n > cur) s = -1.0f;
                        const unsigned key = okey(s); unsigned pre = 0u;
                        for (int bt = 31; bt >= 0; --bt) { const unsigned T = pre | (1u << bt); if (__popcll(__ballot(key >= T)) >= 16) pre = T; }
                        const unsigned long long gt = __ballot(key > pre), eq = __ballot(key == pre); const int need = 16 - __popcll(gt);
                        const bool pick = (key > pre) || (key == pre && __popcll(eq & ((1ull << lane) - 1ull)) < need);
                        const unsigned long long bal = __ballot(pick && n <= cur);
                        if (lane == 0) { SEL[tok * 8] = bal; __hip_atomic_fetch_or(&UNI[0], bal, __ATOMIC_RELAXED, __HIP_MEMORY_SCOPE_WORKGROUP); } }
                } else {
                    const LAS float* Tw = (const LAS float*)(L + AT_T);
                    const int tok = wave; unsigned key[5];
#pragma unroll
                    for (int c = 0; c < 5; ++c) { const int n = lane + 64 * c; float s = -2.0f;
                        if (n < 256) { float imp = 0.f;
#pragma unroll
                            for (int pq = 0; pq < 4; ++pq) { const int row = tok * 4 + pq; imp += __builtin_amdgcn_exp2f(Tw[row * 264 + n] - ML[row * 2]) * ML[row * 2 + 1]; }
                            s = imp; if (n == 0 || n == 255) s = 5.0f; }
                        else if (n == 256) s = 5.0f;
                        key[c] = okey(s); }
                    unsigned pre = 0u;
                    for (int bt = 31; bt >= 0; --bt) { const unsigned T = pre | (1u << bt); int cnt = 0;
#pragma unroll
                        for (int c = 0; c < 5; ++c) cnt += __popcll(__ballot(key[c] >= T));
                        if (cnt >= 16) pre = T; }
                    int ngt = 0;
#pragma unroll
                    for (int c = 0; c < 5; ++c) ngt += __popcll(__ballot(key[c] > pre));
                    int need = 16 - ngt;
#pragma unroll
                    for (int c = 0; c < 5; ++c) { const int n = lane + 64 * c; const unsigned long long eq = __ballot(key[c] == pre);
                        const bool pick = (key[c] > pre) || (key[c] == pre && __popcll(eq & ((1ull << lane) - 1ull)) < need);
                        need -= __popcll(eq);
                        const unsigned long long bal = __ballot(pick && n <= 256);
                        if (lane == 0) { SEL[tok * 8 + c] = bal; __hip_atomic_fetch_or(&UNI[c], bal, __ATOMIC_RELAXED, __HIP_MEMORY_SCOPE_WORKGROUP); } }
                }
                __syncthreads();
                if (active) ATT_CLOSE(sc_c, true);
                if (wave == 0) {
                    int base = ncmp + nwin;
                    for (int c = 4; c >= 0; --c) { const unsigned long long w = UNI[c];
                        if ((w >> lane) & 1ull) { const int j = c * 64 + lane; const int idx = base + (lane == 63 ? 0 : __popcll(w >> (lane + 1)));
                            TileEnt e; e.kind = 1; e.blk = j; e.kpos0 = j * 64; e.n0 = 0; e.nrows = 64; e.pitch = 256;
                            if (!is_s) { e.base = (unsigned long long)(PROJ + ((size_t)b * SEQ + j * 64) * PW + C_KS + g * 128); e.pitch = PW; }
                            else if (j < 256) { const int page = ((const int*)A.in[6])[b * NPG + (j >> 1)]; e.base = (unsigned long long)(A.in[3] + ((size_t)page * 128 + (j & 1) * 64) * 256 + g * 128); }
                            else { e.base = (unsigned long long)(PROJ + ((size_t)NPR + b * 8) * PW + C_KS + g * 128); e.pitch = PW; e.nrows = 8; }
                            TILES[idx] = e; }
                        base += __popcll(w); }
                    if (lane == 0) MISC[1] = base;
                }
                __syncthreads();
                ntiles = MISC[1];
            }
        }
        if (active) {
            const float sc = (curkind == 1 ? gate1 : gate2) / fmaxf(l_run, 1e-30f);
            bf16* orow = (bf16*)(A.ws + (VAR == 0 ? WS_MIX : WS_ACMP)) + (size_t)tokrow * DM + g * 256 + p * 64;
#pragma unroll
            for (int q4 = 0; q4 < 4; ++q4) {
                const f32x4 a = PA[q4 * 64 + lane] + (f32x4){O0[4 * q4], O0[4 * q4 + 1], O0[4 * q4 + 2], O0[4 * q4 + 3]} * sc, c = PA[(4 + q4) * 64 + lane] + (f32x4){O1[4 * q4], O1[4 * q4 + 1], O1[4 * q4 + 2], O1[4 * q4 + 3]} * sc;
                v2u o; o.x = cvtpk(a.x, a.y); o.y = cvtpk(a.z, a.w); *(v2u*)(orow + 8 * q4 + 4 * h) = o;
                v2u o2; o2.x = cvtpk(c.x, c.y); o2.y = cvtpk(c.z, c.w); *(v2u*)(orow + 32 + 8 * q4 + 4 * h) = o2; }
        }
    }
#undef ATT_CLOSE
#undef ATT_LOAD
#undef ATT_ST1
#undef ATT_STORE
#endif
}
#undef ATT_KR
#undef ATT_MFMA
}

namespace cmpk {
typedef short bf16x8 __attribute__((ext_vector_type(8)));
typedef float f32x16 __attribute__((ext_vector_type(16)));
constexpr int AP = 144, A_BYTES = 128 * AP, B_BYTES = 256 * AP, STG = A_BYTES + B_BYTES;
static_assert(2 * STG <= LDSCTL_OFF && 131072 <= LDSCTL_OFF, "compress LDS map");
constexpr int NUNITS_PAST = 256, NUNITS_ALL = 265;
__device__ __forceinline__ void cmp_unit(const Frame& F, const Args& A, int unit, int kq, int nkq) {
#if defined(__HIP_DEVICE_COMPILE__)
    LAS unsigned char* L = F.lds;
    const int tid = F.tid, lane = F.lane, wave = F.wave, r32 = lane & 31, h = lane >> 5;
    const float* PROJ = (const float*)(A.ws + WS_PROJ);
    const int* pt = (const int*)A.in[6];
    const float* bp0; const float* bp1; const float* bp2; const float* bp3; int pitch, nvalid;
    {
        const float* bpp[4];
#pragma unroll
        for (int i = 0; i < 4; ++i) { const int blk = wave + 8 * i;
            if (unit < 256) { const int b = unit >> 3, n = (unit & 7) * 32 + blk; const int page = pt[b * NPG + (n >> 1)]; bpp[i] = A.in[2] + ((size_t)page * 128 + (n & 1) * 64) * 256; }
            else if (unit < 264) { const int pu = unit - 256, b = pu >> 1, n = (pu & 1) * 32 + blk; bpp[i] = PROJ + ((size_t)b * SEQ + n * 64) * PW + C_KC; }
            else bpp[i] = PROJ + ((size_t)NPR + blk * 8) * PW + C_KC; }
        bp0 = bpp[0]; bp1 = bpp[1]; bp2 = bpp[2]; bp3 = bpp[3];
        pitch = unit < 256 ? 256 : PW; nvalid = unit < 264 ? 64 : 8;
    }
    const int gc = lane >> 4, g = gc >> 1, c = gc & 1, d0 = (lane & 15) * 4;
    const float* pep = A.in[9] + c * 64 + d0;
    const int a_off = (c * 64 + wave * 2 + g) * AP + d0 * 2;
    const bf16* bsrc = (const bf16*)(A.ws + WS_W1S) + (size_t)(tid >> 3) * 4096 + (tid & 7) * 8;
    const int b_off = A_BYTES + (tid >> 3) * AP + (tid & 7) * 16;
    const int cw = wave >> 2, rh = (wave >> 1) & 1, ch = wave & 1;
    const int fa_off = (cw * 64 + rh * 32 + r32) * AP + 16 * h, fb_off = A_BYTES + (cw * 128 + ch * 64 + r32) * AP + 16 * h;
    f32x16 acc0, acc1;
#pragma unroll
    for (int r = 0; r < 16; ++r) { acc0[r] = 0.f; acc1[r] = 0.f; }
    f32x4 RA0[4], RA1[4], RA2[4], RA3[4], RP0, RP1, RP2, RP3; v4u RB[4];
    const f32x4 z4 = {0.f, 0.f, 0.f, 0.f};
#define CK_LA(l, RA, RP) do { const size_t ro_ = (size_t)(l) * pitch + lane * 4; const bool ok_ = (l) < nvalid; \
        RA[0] = ok_ ? *(const f32x4*)(bp0 + ro_) : z4; RA[1] = ok_ ? *(const f32x4*)(bp1 + ro_) : z4; RA[2] = ok_ ? *(const f32x4*)(bp2 + ro_) : z4; RA[3] = ok_ ? *(const f32x4*)(bp3 + ro_) : z4; \
        RP = *(const f32x4*)(pep + (l) * 128); } while (0)
#define CK_LB(l) do { _Pragma("unroll") for (int i_ = 0; i_ < 4; ++i_) RB[i_] = *(const v4u*)(bsrc + (size_t)i_ * 64 * 4096 + (l) * 64); __builtin_amdgcn_sched_barrier(0); } while (0)
#define CK_SA(buf, RA, RP) do { _Pragma("unroll") for (int i_ = 0; i_ < 4; ++i_) { const f32x4 v_ = RA[i_] + RP; v2u o_; o_.x = att::cvtpk(v_.x, v_.y); o_.y = att::cvtpk(v_.z, v_.w); \
        *(LAS v2u*)(L + (buf) * STG + a_off + i_ * 16 * AP) = o_; } } while (0)
#define CK_SB(buf) do { _Pragma("unroll") for (int i_ = 0; i_ < 4; ++i_) *(LAS v4u*)(L + (buf) * STG + b_off + i_ * 64 * AP) = RB[i_]; } while (0)
#define CK_MMA(buf) do { _Pragma("unroll") for (int ks_ = 0; ks_ < 4; ++ks_) { \
        const bf16x8 a_ = *(const LAS bf16x8*)(L + (buf) * STG + fa_off + 32 * ks_); \
        const bf16x8 b0_ = *(const LAS bf16x8*)(L + (buf) * STG + fb_off + 32 * ks_); const bf16x8 b1_ = *(const LAS bf16x8*)(L + (buf) * STG + fb_off + 32 * AP + 32 * ks_); \
        acc0 = __builtin_amdgcn_mfma_f32_32x32x16_bf16(a_, b0_, acc0, 0, 0, 0); acc1 = __builtin_amdgcn_mfma_f32_32x32x16_bf16(a_, b1_, acc1, 0, 0, 0); } } while (0)
    const int nl = 64 / nkq, l0 = kq * nl, lend = l0 + nl;
    __syncthreads();
    CK_LA(l0, RA0, RP0); CK_LA(l0 + 1, RA1, RP1); CK_LA(l0 + 2, RA2, RP2); CK_LA(l0 + 3, RA3, RP3); CK_LB(l0);
    CK_SA(0, RA0, RP0); CK_SB(0); CK_LB(l0 + 1); CK_LA(l0 + 4, RA0, RP0);
    __syncthreads();
    for (int lr = 0; lr < nl; lr += 4) {
        const int l = l0 + lr;
        CK_MMA(0);
        CK_SA(1, RA1, RP1); CK_SB(1);
        CK_LB(min(l + 2, lend - 1));
        CK_LA(min(l + 5, lend - 1), RA1, RP1);
        __syncthreads();
        CK_MMA(1);
        CK_SA(0, RA2, RP2); CK_SB(0);
        CK_LB(min(l + 3, lend - 1));
        CK_LA(min(l + 6, lend - 1), RA2, RP2);
        __syncthreads();
        CK_MMA(0);
        CK_SA(1, RA3, RP3); CK_SB(1);
        CK_LB(min(l + 4, lend - 1));
        CK_LA(min(l + 7, lend - 1), RA3, RP3);
        __syncthreads();
        CK_MMA(1);
        CK_SA(0, RA0, RP0); CK_SB(0);
        CK_LB(min(l + 5, lend - 1));
        CK_LA(min(l + 8, lend - 1), RA0, RP0);
        __syncthreads();
    }
    if (nkq > 1) {
        float* part = (float*)(A.ws + WS_HID) + ((size_t)(unit - 256) * 4) * 16384;
        float* mine = part + (size_t)kq * 16384 + wave * 2048 + lane;
#pragma unroll
        for (int r = 0; r < 16; ++r) { mine[r * 64] = acc0[r]; mine[(16 + r) * 64] = acc1[r]; }
        asm volatile("s_waitcnt vmcnt(0)" ::: "memory");
        __syncthreads();
        volatile LAS int* flag = (volatile LAS int*)(L + 2 * STG);
        if (tid == 0) {
            __builtin_amdgcn_fence(__ATOMIC_RELEASE, "agent");
            asm volatile("s_waitcnt vmcnt(0)" ::: "memory");
            const unsigned old = __hip_atomic_fetch_add((unsigned*)(A.ws + WS_CTL) + CW_CMPK + 64 * (unit - 256), 1u, __ATOMIC_RELAXED, __HIP_MEMORY_SCOPE_AGENT);
            const int last = (old == (unsigned)(nkq - 1)) ? 1 : 0;
            if (last) { __builtin_amdgcn_fence(__ATOMIC_ACQUIRE, "agent"); asm volatile("s_waitcnt vmcnt(0)" ::: "memory"); }
            flag[0] = last;
        }
        __syncthreads();
        if (flag[0] == 0) { __syncthreads(); return; }
#pragma unroll
        for (int r = 0; r < 16; ++r) { acc0[r] = 0.f; acc1[r] = 0.f; }
        for (int q = 0; q < nkq; ++q) { const float* src = part + (size_t)q * 16384 + wave * 2048 + lane;
#pragma unroll
            for (int r = 0; r < 16; ++r) { acc0[r] += src[r * 64]; acc1[r] += src[(16 + r) * 64]; } }
        __syncthreads();
    }
#undef CK_LA
#undef CK_LB
#undef CK_SA
#undef CK_SB
#undef CK_MMA
    LAS float* HL = (LAS float*)L; LAS float* W2L = (LAS float*)(L + 65536);
#pragma unroll
    for (int r = 0; r < 16; ++r) { const int row = rh * 32 + (r & 3) + 8 * (r >> 2) + 4 * h;
        HL[(cw * 64 + row) * 128 + ch * 64 + r32] = pg8::gelu_tanh(acc0[r]); HL[(cw * 64 + row) * 128 + ch * 64 + 32 + r32] = pg8::gelu_tanh(acc1[r]); }
    for (int i = tid; i < 2 * 128 * 64 / 4; i += NTHR) ((LAS f32x4*)W2L)[i] = ((const f32x4*)A.in[11])[i];
    __syncthreads();
    {
        const int c2 = wave >> 2, row0 = (wave & 3) * 16;
        float o[16];
#pragma unroll
        for (int rr = 0; rr < 16; ++rr) o[rr] = 0.f;
        for (int h4 = 0; h4 < 32; ++h4) {
            const float w0 = W2L[(c2 * 128 + 4 * h4) * 64 + lane], w1 = W2L[(c2 * 128 + 4 * h4 + 1) * 64 + lane], w2 = W2L[(c2 * 128 + 4 * h4 + 2) * 64 + lane], w3 = W2L[(c2 * 128 + 4 * h4 + 3) * 64 + lane];
#pragma unroll
            for (int rr = 0; rr < 16; ++rr) { const f32x4 hv = *(const LAS f32x4*)(HL + (c2 * 64 + row0 + rr) * 128 + 4 * h4); o[rr] += (hv.x * w0 + hv.y * w1) + (hv.z * w2 + hv.w * w3); }
        }
#pragma unroll
        for (int rr = 0; rr < 16; ++rr) { const int row = row0 + rr, blk = row >> 1, gg = row & 1; float* dst;
            if (unit < 256) { const int b = unit >> 3, n = (unit & 7) * 32 + blk; dst = (float*)(A.ws + WS_COMPS) + ((((size_t)b * NBS + n) * 2 + gg) * 2 + c2) * 64; }
            else if (unit < 264) { const int pu = unit - 256, b = pu >> 1, n = (pu & 1) * 32 + blk; dst = (float*)(A.ws + WS_COMPP) + ((((size_t)b * NBP + n) * 2 + gg) * 2 + c2) * 64; }
            else dst = (float*)(A.ws + WS_COMPS) + ((((size_t)blk * NBS + 256) * 2 + gg) * 2 + c2) * 64;
            dst[lane] = o[rr]; }
    }
    __syncthreads();
#endif
}
}

namespace poolk {
typedef short bf16x8 __attribute__((ext_vector_type(8)));
typedef float f32x16 __attribute__((ext_vector_type(16)));
typedef float f32x2 __attribute__((ext_vector_type(2)));
constexpr int DP = 272;
constexpr int WAVE_LDS = 32 * DP;
constexpr int NITEMS = 4 * 512 + 4 * 32;
template <int W>
__device__ __forceinline__ void pool_d(const f32x2 (&C)[48], int ntok, int pos0, bool is_s, LAS unsigned char* dl, int lane) {
#pragma unroll
    for (int tk = 0; tk < 32; ++tk) {
        f32x2 d = {0.f, 0.f};
        if (tk < ntok) {
            const float cnt = is_s ? (float)W : (float)((pos0 + tk + 1 < W) ? pos0 + tk + 1 : W);
            const f32x2 win = C[16 + tk] - C[16 + tk - W], own = C[16 + tk] - C[15 + tk];
            d = win / cnt - own;
        }
        *(LAS unsigned*)(dl + tk * DP + lane * 4) = att::cvtpk(d.x, d.y);
    }
}
__device__ __forceinline__ void pool_phase(const Frame& F, const Args& A, int vbid, int vG) {
#if defined(__HIP_DEVICE_COMPILE__)
    const int lane = F.lane, wave = F.wave, r32 = lane & 31, h = lane >> 5;
    LAS unsigned char* dl = F.lds + wave * WAVE_LDS;
    const float* PROJ = (const float*)(A.ws + WS_PROJ);
    const int gw = vbid * NWAVES + wave, NGW = vG * NWAVES;
    for (int it = gw; it < NITEMS; it += NGW) {
        int gi, row0, ntok, pos0; bool is_s; int sb = 0;
        if (it < 2048) { gi = it >> 9; const int ch = it & 511; row0 = ch * 32; ntok = 32; pos0 = row0 & (SEQ - 1); is_s = false; }
        else { const int q = it - 2048; gi = q >> 5; sb = q & 31; row0 = NPR + sb * 8; ntok = 8; pos0 = PAST; is_s = true; }
        f32x2 C[48];
        {
            f32x2 R[47];
            const int coff = C_U + gi * 128 + lane * 2;
#pragma unroll
            for (int i = 0; i < 47; ++i) {
                f32x2 v = {0.f, 0.f};
                if (!is_s) { const int t = pos0 - 15 + i; if (t >= 0) v = *(const f32x2*)(PROJ + (size_t)(row0 - 15 + i) * PW + coff); }
                else if (i < 15) v = *(const f32x2*)(A.in[5] + ((size_t)sb * 15 + i) * 512 + gi * 128 + lane * 2);
                else if (i < 23) v = *(const f32x2*)(PROJ + (size_t)(row0 + i - 15) * PW + coff);
                R[i] = v;
            }
            C[0] = (f32x2){0.f, 0.f};
#pragma unroll
            for (int i = 0; i < 47; ++i) C[i + 1] = C[i] + R[i];
        }
        switch (gi) { case 0: pool_d<2>(C, ntok, pos0, is_s, dl, lane); break; case 1: pool_d<4>(C, ntok, pos0, is_s, dl, lane); break;
                      case 2: pool_d<8>(C, ntok, pos0, is_s, dl, lane); break; default: pool_d<16>(C, ntok, pos0, is_s, dl, lane); break; }
        LDS_WAIT(); asm volatile("" ::: "memory");
        f32x16 acc[4];
#pragma unroll
        for (int t = 0; t < 4; ++t)
#pragma unroll
            for (int r = 0; r < 16; ++r) acc[t][r] = 0.f;
        const bf16* wp = (const bf16*)(A.ws + WS_WPOOL) + (size_t)gi * 16384;
#pragma unroll
        for (int ks = 0; ks < 8; ++ks) {
            const bf16x8 bfr = *(const LAS bf16x8*)(dl + r32 * DP + (16 * ks + 8 * h) * 2);
#pragma unroll
            for (int t = 0; t < 4; ++t) { const bf16x8 afr = *(const bf16x8*)(wp + (size_t)(t * 32 + r32) * 128 + 16 * ks + 8 * h);
                acc[t] = __builtin_amdgcn_mfma_f32_32x32x16_bf16(afr, bfr, acc[t], 0, 0, 0); }
        }
        if (r32 < ntok) {
            bf16* orow = (bf16*)(A.ws + WS_MIX) + (size_t)(row0 + r32) * DM + 512 + gi * 128;
            const float* ps = A.in[13] + gi * 128;
#pragma unroll
            for (int t = 0; t < 4; ++t)
#pragma unroll
                for (int q4 = 0; q4 < 4; ++q4) { const int dd = t * 32 + 8 * q4 + 4 * h; const f32x4 sc = *(const f32x4*)(ps + dd);
                    v2u o; o.x = att::cvtpk(acc[t][4 * q4] * sc.x, acc[t][4 * q4 + 1] * sc.y); o.y = att::cvtpk(acc[t][4 * q4 + 2] * sc.z, acc[t][4 * q4 + 3] * sc.w);
                    *(v2u*)(orow + dd) = o; }
        }
        LDS_WAIT(); asm volatile("" ::: "memory");
    }
#endif
}
}

namespace sg {
typedef short bf16x8 __attribute__((ext_vector_type(8)));
typedef float f32x16 __attribute__((ext_vector_type(16)));
#define SG_TILE_BY_ELEMENT __device__ __forceinline__ void tile(const f32x16& acc, int tm, int tn, int r32, int h) const { _Pragma("unroll") for (int r = 0; r < 16; ++r) (*this)(tm * 32 + (r & 3) + 8 * (r >> 2) + 4 * h, tn * 32 + r32, acc[r]); }
struct EpiF32 { float* C; int ldc; __device__ __forceinline__ void operator()(int row, int col, float v) const { C[(size_t)row * ldc + col] = v; } SG_TILE_BY_ELEMENT };
struct EpiRes { const float* base; float* out; int ldc; __device__ __forceinline__ void operator()(int row, int col, float v) const { out[(size_t)row * ldc + col] = base[(size_t)row * ldc + col] + v; } SG_TILE_BY_ELEMENT };
struct EpiRelu2 { bf16* O; int ldc; __device__ __forceinline__ void operator()(int row, int col, float v) const { const float a = fmaxf(v, 0.f); O[(size_t)row * ldc + col] = (bf16)f2bf(a * a); } SG_TILE_BY_ELEMENT };
struct EpiResSS { const float* base; float* H; bf16* HBu; const float* gvec; float* SSs; int ldc;
    __device__ __forceinline__ void tile(const f32x16& acc, int tm, int tn, int r32, int h) const {
        const int col = tn * 32 + r32; const float gc = gvec[col];
#pragma unroll
        for (int r = 0; r < 16; ++r) { const int row = tm * 32 + (r & 3) + 8 * (r >> 2) + 4 * h; const float hv = base[(size_t)row * ldc + col] + acc[r];
            H[(size_t)row * ldc + col] = hv; HBu[(size_t)row * ldc + col] = (bf16)f2bf(hv * gc);
            float s2 = hv * hv;
#pragma unroll
            for (int o = 1; o < 32; o <<= 1) s2 += __shfl_xor(s2, o);
            if (r32 == 0) SSs[row * 32 + tn] = s2; } } };
struct EpiRelu2Rstd { bf16* O; int ldc; const LAS float* rstd;
    __device__ __forceinline__ void tile(const f32x16& acc, int tm, int tn, int r32, int h) const {
#pragma unroll
        for (int r = 0; r < 16; ++r) { const int row = tm * 32 + (r & 3) + 8 * (r >> 2) + 4 * h; const float a = fmaxf(acc[r] * rstd[row], 0.f); O[(size_t)row * ldc + tn * 32 + r32] = (bf16)f2bf(a * a); } } };
template <int KSPLIT, int NK, class Epi>
__device__ __forceinline__ void sgemm(const Frame& F, const bf16* Arows, const bf16* Bt, int K, int N, const Epi& E) {
#if defined(__HIP_DEVICE_COMPILE__)
    constexpr int TPI = 8 / KSPLIT;
    const int lane = F.lane, wave = F.wave, r32 = lane & 31, h = lane >> 5, split = wave % KSPLIT, tsel = wave / KSPLIT;
    LAS float* red = (LAS float*)F.lds;
    const int nitems = 8 * (N / 32) / TPI, kq = K / KSPLIT;
    for (int it = F.bid; it < nitems; it += F.G) {
        const int tile = it * TPI + tsel, tm = tile & 7, tn = tile >> 3;
        const bf16* ap = Arows + (size_t)(tm * 32 + r32) * K + split * kq + 8 * h;
        const bf16* bp = Bt + (size_t)(tn * 32 + r32) * K + split * kq + 8 * h;
        f32x16 acc;
#pragma unroll
        for (int r = 0; r < 16; ++r) acc[r] = 0.f;
#pragma unroll
        for (int k0 = 0; k0 < NK; k0 += 16) {
            bf16x8 a[16], b[16];
#pragma unroll
            for (int j = 0; j < 16; ++j) { a[j] = *(const bf16x8*)(ap + 16 * (k0 + j)); b[j] = *(const bf16x8*)(bp + 16 * (k0 + j)); }
            __builtin_amdgcn_sched_barrier(0);
#pragma unroll
            for (int j = 0; j < 16; ++j) acc = __builtin_amdgcn_mfma_f32_32x32x16_bf16(a[j], b[j], acc, 0, 0, 0);
        }
        __syncthreads();
        if (split != 0) {
#pragma unroll
            for (int r = 0; r < 16; ++r) red[wave * 1024 + r * 64 + lane] = acc[r]; }
        __syncthreads();
        if (split == 0) {
#pragma unroll
            for (int s = 1; s < KSPLIT; ++s)
#pragma unroll
                for (int r = 0; r < 16; ++r) acc[r] += red[(wave + s) * 1024 + r * 64 + lane];
            E.tile(acc, tm, tn, r32, h);
        }
    }
    __syncthreads();
#endif
}
}


__device__ __forceinline__ void p7_hb(const Frame& F, const Args& A) {
    const int gw = F.bid * NWAVES + F.wave, NGW = F.G * NWAVES;
    for (int m = gw; m < MTOK; m += NGW) rms_row_to_bf16(((float*)(A.ws + WS_H)) + (size_t)m * DM, A.in[15], ((bf16*)(A.ws + WS_HB)) + (size_t)m * DM, F.lane);
}
__device__ __forceinline__ void p10_final(const Frame& F, const Args& A) {
    const int gw = F.bid * NWAVES + F.wave, NGW = F.G * NWAVES, lane = F.lane;
    for (int m = gw; m < MTOK; m += NGW) {
        f32x4* xr = (f32x4*)(A.out + (size_t)m * DM) + lane; const f32x4* gr = (const f32x4*)A.in[18] + lane;
        f32x4 v[4]; float s = 0.f;
#pragma unroll
        for (int j = 0; j < 4; ++j) { v[j] = xr[64 * j]; s += (v[j].x * v[j].x + v[j].y * v[j].y) + (v[j].z * v[j].z + v[j].w * v[j].w); }
        const float rstd = 1.0f / sqrtf(wave_sum(s) * (1.f / DM) + 1e-6f);
#pragma unroll
        for (int j = 0; j < 4; ++j) xr[64 * j] = v[j] * rstd * gr[64 * j];
    }
}

__global__ void __launch_bounds__(NTHR, 2) fwd_kernel(Args A) {
    extern __shared__ __attribute__((aligned(16))) unsigned char lds_raw[];
    Frame F;
    F.lds = (LAS unsigned char*)lds_raw;
    F.tid = threadIdx.x; F.lane = F.tid & 63; F.wave = __builtin_amdgcn_readfirstlane(F.tid >> 6); F.G = gridDim.x; F.bid = blockIdx.x;
    unsigned char* ws = A.ws;
    for (int u = F.tid; u < (LDS_BYTES - LDSCTL_OFF) / 4; u += NTHR) ((LAS unsigned*)(F.lds + LDSCTL_OFF))[u] = 0u;
    __syncthreads();
    const int lo = A.ph_lo, hi = A.ph_hi;
    const bool multi = (hi - lo) > 1;
    XcdBarrier bar; bar.bar = (unsigned*)(ws + WS_CTL) + CW_BAR; bar.x = 0; bar.st = nullptr;
    if (multi) bar = xcd_barrier_post((unsigned*)(ws + WS_CTL) + CW_BAR, (volatile LAS unsigned*)(F.lds + MISC_OFF));
#define IN(k) (lo <= (k) && (k) < hi)
#define SEAM(k) do { if (IN(k) && IN((k) + 1)) xcd_barrier(bar); } while (0)

#ifndef REP_PHASE
#define REP_PHASE -1
#endif
#define RUN(k, ...) if (IN(k)) { __VA_ARGS__; if (REP_PHASE == (k)) { xcd_barrier(bar); __VA_ARGS__; } } SEAM(k)
#define GEMM_BODY(EPI, ALIGN_, Aptr, Bptr, M_, N_, K_, ...) do { pg8::Gemm g{Aptr, Bptr, M_, N_, K_}; pg8::StaticOrder S; S.init(M_, N_, F.G, F.bid); pg8::EPI E{__VA_ARGS__}; pg8::gemm_phase<pg8::EPI, pg8::StaticOrder, ALIGN_, true>(F.lds, g, S, E); } while (0)
    RUN(0, p0_prologue(F, A));
    RUN(1, do { const bool cfirst = ((F.bid >> 3) & 1) == 0;
                if (cfirst) for (int u = F.bid; u < cmpk::NUNITS_PAST; u += F.G) cmpk::cmp_unit(F, A, u, 0, 1);
                sg::sgemm<4, 16>(F, ((const bf16*)(A.ws + WS_XN)) + (size_t)NPR * DM, ((const bf16*)(A.ws + WS_WIN)), DM, PW, sg::EpiF32{((float*)(A.ws + WS_PROJ)) + (size_t)NPR * PW, PW});
                GEMM_BODY(EpiF32, true, ((bf16*)(A.ws + WS_XN)), ((bf16*)(A.ws + WS_WIN)), NPR, PW, DM, ((float*)(A.ws + WS_PROJ)), PW);
                if (!cfirst) for (int u = F.bid; u < cmpk::NUNITS_PAST; u += F.G) cmpk::cmp_unit(F, A, u, 0, 1); } while (0));
    RUN(2, do { for (int it = F.bid; it < 4 * (cmpk::NUNITS_ALL - cmpk::NUNITS_PAST); it += F.G) cmpk::cmp_unit(F, A, cmpk::NUNITS_PAST + (it >> 2), it & 3, 4);
                { const int ncu = 4 * (cmpk::NUNITS_ALL - cmpk::NUNITS_PAST);
                  if (F.G > 2 * ncu) { if (F.bid >= ncu) { p2_copies(F, A, F.bid - ncu, F.G - ncu); poolk::pool_phase(F, A, F.bid - ncu, F.G - ncu); } }
                  else { p2_copies(F, A, F.bid, F.G); poolk::pool_phase(F, A, F.bid, F.G); } } } while (0));
    if (IN(3)) { att::attn_phase<0>(F, A, 0); if (REP_PHASE == 3) { xcd_barrier(bar); att::attn_phase<0>(F, A, 1); } if (REP_PHASE == 31) { xcd_barrier(bar); att::attn_phase<1>(F, A, 1); } if (REP_PHASE == 32) { xcd_barrier(bar); att::attn_phase<2>(F, A, 1); } if (REP_PHASE == 33) { xcd_barrier(bar); att::attn_phase<3>(F, A, 1); } } SEAM(3);
    RUN(4, do { sg::sgemm<4, 16>(F, ((const bf16*)(A.ws + WS_MIX)) + (size_t)NPR * DM, ((const bf16*)(A.ws + WS_WOUT)), DM, DM,
                                 sg::EpiResSS{A.in[1], ((float*)(A.ws + WS_H)) + (size_t)NPR * DM, ((bf16*)(A.ws + WS_HB)) + (size_t)NPR * DM, A.in[15], ((float*)(A.ws + WS_SS)) + (size_t)NPR * 4, DM});
                GEMM_BODY(EpiResSS, false, ((bf16*)(A.ws + WS_MIX)), ((bf16*)(A.ws + WS_WOUT)), NPR, DM, DM, A.in[0], ((float*)(A.ws + WS_H)), ((bf16*)(A.ws + WS_HB)), A.in[15], ((float*)(A.ws + WS_SS)), DM); } while (0));
    RUN(5, do { { LAS float* rt = (LAS float*)(F.lds + 32768); const float* sp = ((const float*)(A.ws + WS_SS)) + (size_t)NPR * 4;
                  if (F.tid < 256) { float a = 0.f; for (int k = 0; k < 32; ++k) a += sp[F.tid * 32 + k]; rt[F.tid] = 1.0f / sqrtf(a * (1.f / DM) + 1e-6f); }
                  __syncthreads();
                  sg::sgemm<4, 16>(F, ((const bf16*)(A.ws + WS_HB)) + (size_t)NPR * DM, ((const bf16*)(A.ws + WS_WUP)), DM, DFF, sg::EpiRelu2Rstd{((bf16*)(A.ws + WS_ACT)) + (size_t)NPR * DFF, DFF, rt}); }
                GEMM_BODY(EpiRelu2RstdBf16, true, ((bf16*)(A.ws + WS_HB)), ((bf16*)(A.ws + WS_WUP)), NPR, DFF, DM, ((bf16*)(A.ws + WS_ACT)), DFF, ((const float*)(A.ws + WS_SS)), 1.f / DM, 1e-6f); } while (0));
    RUN(6, do { if (REP_PHASE == 60) sg::sgemm<8, 32>(F, ((const bf16*)(A.ws + WS_ACT)) + (size_t)NPR * DFF, ((const bf16*)(A.ws + WS_WDN)), DFF, DM, sg::EpiRes{((const float*)(A.ws + WS_H)) + (size_t)NPR * DM, A.out + (size_t)NPR * DM, DM});
                sg::sgemm<8, 32>(F, ((const bf16*)(A.ws + WS_ACT)) + (size_t)NPR * DFF, ((const bf16*)(A.ws + WS_WDN)), DFF, DM, sg::EpiRes{((const float*)(A.ws + WS_H)) + (size_t)NPR * DM, A.out + (size_t)NPR * DM, DM});
                GEMM_BODY(EpiResF32, false, ((bf16*)(A.ws + WS_ACT)), ((bf16*)(A.ws + WS_WDN)), NPR, DM, DFF, ((float*)(A.ws + WS_H)), ((float*)(A.ws + WS_H)), 1 << 20, A.out, DM); } while (0));
    if (IN(7)) { p10_final(F, A); }
#undef IN
#undef SEAM
}

#ifndef MK_ONE_LAUNCH
#define MK_ONE_LAUNCH 1
#endif
extern "C" void kernel_launch(void* const* d_in, const int* in_sizes, int n_in, void* d_out, int out_size, void* d_ws, size_t ws_size, hipStream_t stream) {
    static int grid = 0;
    if (grid == 0) {
        if (n_in != 19 || (size_t)out_size != O_END || ws_size < WS_END) { fprintf(stderr, "kernel_launch: unexpected shapes n_in %d out %d ws %zu\n", n_in, out_size, ws_size); grid = -1; return; }
        int dev = 0, cus = 0, per_cu = 0;
        if (hipGetDevice(&dev) != hipSuccess || hipDeviceGetAttribute(&cus, hipDeviceAttributeMultiprocessorCount, dev) != hipSuccess) { grid = -1; return; }
        if (hipFuncSetAttribute((const void*)fwd_kernel, hipFuncAttributeMaxDynamicSharedMemorySize, LDS_BYTES) != hipSuccess) { fprintf(stderr, "kernel_launch: hipFuncSetAttribute failed\n"); grid = -1; return; }
        if (hipOccupancyMaxActiveBlocksPerMultiprocessor(&per_cu, (const void*)fwd_kernel, NTHR, LDS_BYTES) != hipSuccess || per_cu < 1) fprintf(stderr, "kernel_launch: occupancy query says %d\n", per_cu);
        (void)hipGetLastError();
        grid = cus;
    }
    if (grid < 0) return;
    if (hipMemsetAsync((char*)d_ws + WS_CTL, 0, CTL_ZERO_BYTES, stream) != hipSuccess) return;
    Args a{};
    for (int i = 0; i < 19; ++i) a.in[i] = (const float*)d_in[i];
    a.out = (float*)d_out; a.ws = (unsigned char*)d_ws;
#if MK_ONE_LAUNCH
    a.ph_lo = 0; a.ph_hi = NPHASES;
    hipLaunchKernelGGL(fwd_kernel, dim3(grid), dim3(NTHR), LDS_BYTES, stream, a);
#else
    for (int p = 0; p < NPHASES; ++p) { a.ph_lo = p; a.ph_hi = p + 1; hipLaunchKernelGGL(fwd_kernel, dim3(grid), dim3(NTHR), LDS_BYTES, stream, a); }
#endif
}
```
